# Optimizing an MI355X kernel written in HIP

```python
import math
import jax, jax.numpy as jnp
from jax import lax
import numpy as np

D_MODEL = 1024
BATCH = 8
SEQ = 2048
DEPTH = 4
DEC_BATCH = 128
DEC_SEQ = 1
PAST_LEN = 8192
PAGE_SIZE = 128

D_MIX = 2 * D_MODEL
ATT_HEADS = 8
ATT_KV_HEADS = 2
ATT_GROUP = ATT_HEADS // ATT_KV_HEADS
ATT_HEAD_DIM = 64
ATT_WIDTH = ATT_HEADS * ATT_HEAD_DIM
ATT_KV_WIDTH = ATT_KV_HEADS * ATT_HEAD_DIM
ATT_SCALE = ATT_HEAD_DIM ** -0.5
WINDOW = 128
ROPE_THETA = 500000.0
ROPE_DIM = ATT_HEAD_DIM // 4
LRU_WIDTH = 3 * D_MIX // 8
LRU_BLOCKS = 8
LRU_BLOCK = LRU_WIDTH // LRU_BLOCKS
LRU_C = 8.0
CONV_W = 4
SSD_WIDTH = D_MIX - ATT_WIDTH - LRU_WIDTH
SSD_HEAD_DIM = 64
SSD_HEADS = SSD_WIDTH // SSD_HEAD_DIM
SSD_GROUPS = 2
SSD_HPG = SSD_HEADS // SSD_GROUPS
SSD_STATE = 128
SSD_CHUNK = 128
SSD_CONV_CH = SSD_WIDTH + 2 * SSD_GROUPS * SSD_STATE
SPLIT_SIZES = (ATT_WIDTH, ATT_KV_WIDTH, ATT_KV_WIDTH, ATT_WIDTH,
               LRU_WIDTH, LRU_WIDTH,
               SSD_WIDTH, SSD_CONV_CH, SSD_HEADS)
SPLIT_POINTS = tuple(int(s) for s in np.cumsum(SPLIT_SIZES)[:-1])
D_IN_PROJ = int(sum(SPLIT_SIZES))
DEEPNORM_ALPHA = (2.0 * DEPTH) ** 0.25
DEEPNORM_BETA = (8.0 * DEPTH) ** -0.25
NORM_EPS = 1e-5
F32 = jnp.float32

kernel_name = 'hybrid_swa_rglru_ssd_step'


def layer_norm(x, g, b):
    xf = x.astype(F32)
    mu = jnp.mean(xf, -1, keepdims=True)
    var = jnp.mean(jnp.square(xf - mu), -1, keepdims=True)
    return ((xf - mu) * lax.rsqrt(var + NORM_EPS) * g + b).astype(x.dtype)


def partial_rope(x, pos):
    half = ROPE_DIM // 2
    inv = ROPE_THETA ** (-jnp.arange(half, dtype=F32) / half)
    ang = pos.astype(F32)[:, None] * inv[None, :]
    cos = jnp.cos(ang)[None, :, None, :]
    sin = jnp.sin(ang)[None, :, None, :]
    xr = x[..., :ROPE_DIM].astype(F32)
    x1, x2 = xr[..., :half], xr[..., half:]
    rot = jnp.concatenate([x1 * cos - x2 * sin, x2 * cos + x1 * sin], -1).astype(x.dtype)
    return jnp.concatenate([rot, x[..., ROPE_DIM:]], -1)


def sink_softmax(s, mask, sink):
    s = jnp.where(mask, s, -jnp.inf)
    sink = sink.astype(F32)
    m = jnp.maximum(jnp.max(s, -1, keepdims=True), sink)
    e = jnp.exp(s - m)
    return e / (jnp.sum(e, -1, keepdims=True) + jnp.exp(sink - m))


def swa_prompt(q, k, v, sinks):
    B, S = q.shape[:2]
    nb = S // WINDOW
    qb = q.reshape(B, nb, WINDOW, ATT_KV_HEADS, ATT_GROUP, ATT_HEAD_DIM)

    def band_keys(t):
        tb = t.reshape(B, nb, WINDOW, ATT_KV_HEADS, ATT_HEAD_DIM)
        prev = jnp.pad(tb[:, :-1], ((0, 0), (1, 0), (0, 0), (0, 0), (0, 0)))
        return jnp.concatenate([prev, tb], axis=2)

    kk, vv = band_keys(k), band_keys(v)
    i = jnp.arange(WINDOW)[:, None]
    j = jnp.arange(2 * WINDOW)[None, :]
    band = (j >= i) & (j <= i + WINDOW)
    blk = jnp.arange(nb)[:, None, None]
    mask = band[None] & ((blk > 0) | (j[None] >= WINDOW))
    s = jnp.einsum('bnqhgd,bnkhd->bnhgqk', qb, kk, preferred_element_type=F32) * ATT_SCALE
    p = sink_softmax(s, mask[None, :, None, None],
                     sinks.reshape(ATT_KV_HEADS, ATT_GROUP)[None, None, :, :, None, None])
    o = jnp.einsum('bnhgqk,bnkhd->bnqhgd', p.astype(v.dtype), vv)
    return o.reshape(B, S, ATT_WIDTH)


def swa_sample(q, k, v, ck, cv, sinks):
    B, L = q.shape[:2]
    kk = jnp.concatenate([ck.astype(k.dtype), k], 1)
    vv = jnp.concatenate([cv.astype(v.dtype), v], 1)
    qpos = WINDOW + jnp.arange(L)[:, None]
    kpos = jnp.arange(WINDOW + L)[None, :]
    mask = (kpos <= qpos) & (kpos >= qpos - WINDOW)
    qg = q.reshape(B, L, ATT_KV_HEADS, ATT_GROUP, ATT_HEAD_DIM)
    s = jnp.einsum('bqhgd,bkhd->bhgqk', qg, kk, preferred_element_type=F32) * ATT_SCALE
    p = sink_softmax(s, mask[None, None, None],
                     sinks.reshape(ATT_KV_HEADS, ATT_GROUP)[None, :, :, None, None])
    o = jnp.einsum('bhgqk,bkhd->bqhgd', p.astype(vv.dtype), vv).reshape(B, L, ATT_WIDTH)
    return o, kk[:, -WINDOW:].astype(ck.dtype), vv[:, -WINDOW:].astype(cv.dtype)


def causal_conv(x, buf, w, b):
    L = x.shape[1]
    xp = jnp.concatenate([buf.astype(x.dtype), x], 1)
    y = xp[:, 0:L] * w[0]
    for t in range(1, CONV_W):
        y = y + xp[:, t:t + L] * w[t]
    return y + b, xp[:, -(CONV_W - 1):].astype(buf.dtype)


def rglru(x, h0, w_a, b_a, w_x, b_x, lam):
    B, L, W = x.shape
    xb = x.reshape(B, L, LRU_BLOCKS, LRU_BLOCK)
    r = jax.nn.sigmoid(jnp.einsum('blnc,ncd->blnd', xb, w_a).reshape(B, L, W).astype(F32) + b_a)
    ig = jax.nn.sigmoid(jnp.einsum('blnc,ncd->blnd', xb, w_x).reshape(B, L, W).astype(F32) + b_x)
    log_a = (-LRU_C * jax.nn.softplus(-lam.astype(F32))) * r
    a = jnp.exp(log_a)
    bterm = jnp.sqrt(-jnp.expm1(2.0 * log_a)) * (ig * x.astype(F32))
    bterm = bterm.at[:, 0].add(a[:, 0] * h0.astype(F32))

    def combine(left, right):
        a1, b1 = left
        a2, b2 = right
        return a1 * a2, a2 * b1 + b2

    _, h = lax.associative_scan(combine, (a, bterm), axis=1)
    return h.astype(x.dtype), h[:, -1].astype(h0.dtype)


def ssd_scan(xh, dt, a_head, bm, cm, h0):
    Bsz, L = xh.shape[:2]
    q = min(SSD_CHUNK, L)
    lp = -(-L // q) * q
    pad = lp - L
    if pad:
        xh = jnp.pad(xh, ((0, 0), (0, pad), (0, 0), (0, 0)))
        dt = jnp.pad(dt, ((0, 0), (0, pad), (0, 0)))
        bm = jnp.pad(bm, ((0, 0), (0, pad), (0, 0), (0, 0)))
        cm = jnp.pad(cm, ((0, 0), (0, pad), (0, 0), (0, 0)))
    nc = lp // q
    x = (xh.astype(F32) * dt[..., None]).reshape(Bsz, nc, q, SSD_GROUPS, SSD_HPG, SSD_HEAD_DIM)
    a = (dt * a_head).reshape(Bsz, nc, q, SSD_GROUPS, SSD_HPG)
    bc = bm.astype(F32).reshape(Bsz, nc, q, SSD_GROUPS, SSD_STATE)
    cc = cm.astype(F32).reshape(Bsz, nc, q, SSD_GROUPS, SSD_STATE)
    a_cs = jnp.cumsum(a, axis=2)
    diff = a_cs[:, :, :, None] - a_cs[:, :, None, :]
    causal = jnp.tril(jnp.ones((q, q), dtype=bool))[None, None, :, :, None, None]
    lmat = jnp.exp(jnp.where(causal, diff, -jnp.inf))
    cb = jnp.einsum('bcqgn,bcsgn->bcqsg', cc, bc)
    y_diag = jnp.einsum('bcqsg,bcqsge,bcsgep->bcqgep', cb, lmat, x)
    decay_to_end = jnp.exp(a_cs[:, :, -1:] - a_cs)
    states = jnp.einsum('bcqgn,bcqge,bcqgep->bcgepn', bc, decay_to_end, x)
    chunk_decay = jnp.exp(a_cs[:, :, -1])
    hg0 = h0.astype(F32).reshape(Bsz, SSD_GROUPS, SSD_HPG, SSD_HEAD_DIM, SSD_STATE)

    def step(h, inp):
        dec, st = inp
        return dec[..., None, None] * h + st, h

    h_last, h_in = lax.scan(step, hg0, (jnp.swapaxes(chunk_decay, 0, 1), jnp.swapaxes(states, 0, 1)))
    h_in = jnp.swapaxes(h_in, 0, 1)
    y_off = jnp.einsum('bcqgn,bcgepn,bcqge->bcqgep', cc, h_in, jnp.exp(a_cs))
    y = (y_diag + y_off).reshape(Bsz, lp, SSD_HEADS, SSD_HEAD_DIM)[:, :L]
    return y, h_last.reshape(Bsz, SSD_HEADS, SSD_HEAD_DIM, SSD_STATE).astype(h0.dtype)


def mixer_layer(x, pos, att_cache, lru_conv0, lru_h0, ssd_conv0, ssd_h0, p):
    B, L, _ = x.shape
    proj = jnp.einsum('bld,de->ble', x, p['w_in'])
    q, k, v, g_att, x_lru, g_lru, z_ssd, xbc, dt_raw = jnp.split(proj, SPLIT_POINTS, axis=-1)
    q = partial_rope(q.reshape(B, L, ATT_HEADS, ATT_HEAD_DIM), pos)
    k = partial_rope(k.reshape(B, L, ATT_KV_HEADS, ATT_HEAD_DIM), pos)
    v = v.reshape(B, L, ATT_KV_HEADS, ATT_HEAD_DIM)
    if att_cache is None:
        att = swa_prompt(q, k, v, p['att_sinks'])
        k_buf, v_buf = k[:, -WINDOW:], v[:, -WINDOW:]
    else:
        att, k_buf, v_buf = swa_sample(q, k, v, att_cache[0], att_cache[1], p['att_sinks'])
    br_a = att * jax.nn.silu(g_att)
    xl, lru_conv1 = causal_conv(x_lru, lru_conv0, p['lru_conv_w'], p['lru_conv_b'])
    hl, lru_h1 = rglru(xl, lru_h0, p['lru_wa'], p['lru_ba'], p['lru_wx'], p['lru_bx'], p['lru_lambda'])
    br_b = hl * jax.nn.silu(g_lru)
    xbc_c, ssd_conv1 = causal_conv(xbc, ssd_conv0, p['ssd_conv_w'], p['ssd_conv_b'])
    xbc_c = jax.nn.silu(xbc_c)
    xs, b_ssm, c_ssm = jnp.split(xbc_c, (SSD_WIDTH, SSD_WIDTH + SSD_GROUPS * SSD_STATE), axis=-1)
    dt = jax.nn.softplus(dt_raw.astype(F32) + p['ssd_dt_bias'].astype(F32))
    a_head = -jnp.exp(p['ssd_a_log'].astype(F32))
    xh = xs.reshape(B, L, SSD_HEADS, SSD_HEAD_DIM)
    y, ssd_h1 = ssd_scan(xh, dt, a_head,
                         b_ssm.reshape(B, L, SSD_GROUPS, SSD_STATE),
                         c_ssm.reshape(B, L, SSD_GROUPS, SSD_STATE), ssd_h0)
    y = y + p['ssd_d'].astype(F32)[:, None] * xh.astype(F32)
    y = y.reshape(B, L, SSD_WIDTH) * jax.nn.silu(z_ssd.astype(F32))
    y = y * lax.rsqrt(jnp.mean(jnp.square(y), -1, keepdims=True) + NORM_EPS) * p['ssd_norm_g']
    br_c = y.astype(x.dtype)
    mix = jnp.concatenate([br_a.astype(x.dtype), br_b.astype(x.dtype), br_c], -1)
    out = jnp.einsum('ble,ed->bld', mix, p['w_out'])
    y_out = layer_norm(DEEPNORM_ALPHA * x + out, p['ln_g'], p['ln_b'])
    return y_out, (k_buf, v_buf, lru_conv1, lru_h1, ssd_conv1, ssd_h1)


def setup_inputs(seed: int = 0) -> dict:
    key = jax.random.key(seed)
    ks = jax.random.split(key, 32)
    nrm = lambda k, shape, s: jax.random.normal(k, shape, F32) * s
    u = jax.random.uniform(ks[20], (DEPTH, LRU_WIDTH), F32, 0.9, 0.999)
    a_lru = u ** (1.0 / LRU_C)
    lru_lambda = jnp.log(a_lru) - jnp.log1p(-a_lru)
    dt0 = jnp.exp(jax.random.uniform(ks[21], (DEPTH, SSD_HEADS), F32, math.log(1e-3), math.log(1e-1)))
    ssd_dt_bias = dt0 + jnp.log(-jnp.expm1(-dt0))
    ssd_a_log = jnp.log(jax.random.uniform(ks[22], (DEPTH, SSD_HEADS), F32, 1.0, 16.0))
    return {
        'x_prompt': nrm(ks[0], (BATCH, SEQ, D_MODEL), 1.0),
        'x_sample': nrm(ks[1], (DEC_BATCH, DEC_SEQ, D_MODEL), 1.0),
        'cache_swa_k': nrm(ks[2], (DEPTH, DEC_BATCH, WINDOW, ATT_KV_HEADS, ATT_HEAD_DIM), 1.0),
        'cache_swa_v': nrm(ks[3], (DEPTH, DEC_BATCH, WINDOW, ATT_KV_HEADS, ATT_HEAD_DIM), 1.0),
        'state_lru_conv': nrm(ks[4], (DEPTH, DEC_BATCH, CONV_W - 1, LRU_WIDTH), 1.0),
        'state_lru_h': nrm(ks[5], (DEPTH, DEC_BATCH, LRU_WIDTH), 0.5),
        'state_ssd_conv': nrm(ks[6], (DEPTH, DEC_BATCH, CONV_W - 1, SSD_CONV_CH), 1.0),
        'state_ssd_h': nrm(ks[7], (DEPTH, DEC_BATCH, SSD_HEADS, SSD_HEAD_DIM, SSD_STATE), 0.1),
        'w_in': nrm(ks[8], (DEPTH, D_MODEL, D_IN_PROJ), D_MODEL ** -0.5),
        'w_out': nrm(ks[9], (DEPTH, D_MIX, D_MODEL), DEEPNORM_BETA * D_MIX ** -0.5),
        'att_sinks': nrm(ks[10], (DEPTH, ATT_HEADS), 0.5),
        'lru_conv_w': nrm(ks[11], (DEPTH, CONV_W, LRU_WIDTH), CONV_W ** -0.5),
        'lru_conv_b': nrm(ks[12], (DEPTH, LRU_WIDTH), 0.02),
        'lru_wa': nrm(ks[13], (DEPTH, LRU_BLOCKS, LRU_BLOCK, LRU_BLOCK), LRU_BLOCK ** -0.5),
        'lru_ba': nrm(ks[14], (DEPTH, LRU_WIDTH), 0.02),
        'lru_wx': nrm(ks[15], (DEPTH, LRU_BLOCKS, LRU_BLOCK, LRU_BLOCK), LRU_BLOCK ** -0.5),
        'lru_bx': nrm(ks[16], (DEPTH, LRU_WIDTH), 0.02),
        'lru_lambda': lru_lambda,
        'ssd_conv_w': nrm(ks[17], (DEPTH, CONV_W, SSD_CONV_CH), CONV_W ** -0.5),
        'ssd_conv_b': nrm(ks[18], (DEPTH, SSD_CONV_CH), 0.02),
        'ssd_dt_bias': ssd_dt_bias,
        'ssd_a_log': ssd_a_log,
        'ssd_d': 1.0 + nrm(ks[23], (DEPTH, SSD_HEADS), 0.05),
        'ssd_norm_g': 1.0 + nrm(ks[24], (DEPTH, SSD_WIDTH), 0.05),
        'ln_g': 1.0 + nrm(ks[25], (DEPTH, D_MODEL), 0.05),
        'ln_b': nrm(ks[26], (DEPTH, D_MODEL), 0.02),
    }


def reference(x_prompt, x_sample, cache_swa_k, cache_swa_v, state_lru_conv, state_lru_h,
              state_ssd_conv, state_ssd_h, w_in, w_out, att_sinks, lru_conv_w, lru_conv_b,
              lru_wa, lru_ba, lru_wx, lru_bx, lru_lambda, ssd_conv_w, ssd_conv_b,
              ssd_dt_bias, ssd_a_log, ssd_d, ssd_norm_g, ln_g, ln_b):
    bp = x_prompt.shape[0]
    pos_p = jnp.arange(x_prompt.shape[1], dtype=jnp.int32)
    pos_s = PAST_LEN + jnp.arange(x_sample.shape[1], dtype=jnp.int32)
    zero_lru_conv = jnp.zeros((bp, CONV_W - 1, LRU_WIDTH), x_prompt.dtype)
    zero_lru_h = jnp.zeros((bp, LRU_WIDTH), F32)
    zero_ssd_conv = jnp.zeros((bp, CONV_W - 1, SSD_CONV_CH), x_prompt.dtype)
    zero_ssd_h = jnp.zeros((bp, SSD_HEADS, SSD_HEAD_DIM, SSD_STATE), F32)
    xp, xs = x_prompt, x_sample
    new_p = [[] for _ in range(6)]
    new_s = [[] for _ in range(6)]
    for l in range(DEPTH):
        p = {'w_in': w_in[l], 'w_out': w_out[l], 'att_sinks': att_sinks[l],
             'lru_conv_w': lru_conv_w[l], 'lru_conv_b': lru_conv_b[l],
             'lru_wa': lru_wa[l], 'lru_ba': lru_ba[l], 'lru_wx': lru_wx[l], 'lru_bx': lru_bx[l],
             'lru_lambda': lru_lambda[l], 'ssd_conv_w': ssd_conv_w[l], 'ssd_conv_b': ssd_conv_b[l],
             'ssd_dt_bias': ssd_dt_bias[l], 'ssd_a_log': ssd_a_log[l], 'ssd_d': ssd_d[l],
             'ssd_norm_g': ssd_norm_g[l], 'ln_g': ln_g[l], 'ln_b': ln_b[l]}
        xp, st_p = mixer_layer(xp, pos_p, None, zero_lru_conv, zero_lru_h, zero_ssd_conv, zero_ssd_h, p)
        xs, st_s = mixer_layer(xs, pos_s, (cache_swa_k[l], cache_swa_v[l]), state_lru_conv[l],
                               state_lru_h[l], state_ssd_conv[l], state_ssd_h[l], p)
        for lst, t in zip(new_p, st_p):
            lst.append(t)
        for lst, t in zip(new_s, st_s):
            lst.append(t)
    p_swa_k, p_swa_v, p_lru_conv, p_lru_h, p_ssd_conv, p_ssd_h = [jnp.stack(t) for t in new_p]
    s_swa_k, s_swa_v, s_lru_conv, s_lru_h, s_ssd_conv, s_ssd_h = [jnp.stack(t) for t in new_s]
    return (xp, xs, p_swa_k, p_swa_v, p_lru_conv, p_lru_h, p_ssd_conv, p_ssd_h,
            s_swa_k, s_swa_v, s_lru_conv, s_lru_h, s_ssd_conv, s_ssd_h)
```

```cpp
#include <hip/hip_runtime.h>
#include <hip/hip_cooperative_groups.h>
#include <cstdio>
namespace cg = cooperative_groups;

#define DI __device__ __forceinline__
#define PH __device__ __forceinline__
#define SMEM extern __shared__ __attribute__((aligned(16))) char smem[]
typedef unsigned short u16;
using bf16x8 = __attribute__((ext_vector_type(8))) short;
using f32x4 = __attribute__((ext_vector_type(4))) float;
using u32x4 = __attribute__((ext_vector_type(4))) unsigned;

constexpr int MP = 16384, MT = 16512;
constexpr int NPAD = 4992;
constexpr int C_K = 512, C_V = 640, C_GA = 768, C_XL = 1280, C_GL = 2048, C_Z = 2816, C_XBC = 3584, C_DT = 4864;
constexpr int LDS_BYTES = 73728;

constexpr size_t WS_WIN = 0;
constexpr size_t WS_WOUT = WS_WIN + (size_t)4 * NPAD * 1024 * 2;
constexpr size_t WS_WA = WS_WOUT + (size_t)4 * 1024 * 2048 * 2;
constexpr size_t WS_WX = WS_WA + (size_t)4 * 8 * 96 * 96 * 2;
constexpr size_t WS_XB = WS_WX + (size_t)4 * 8 * 96 * 96 * 2;
constexpr size_t WS_XF = WS_XB + (size_t)MT * 1024 * 2;
constexpr size_t WS_PRE = WS_XF + (size_t)MT * 1024 * 4;
constexpr size_t WS_PROJ = WS_PRE + (size_t)MT * 1024 * 4;
constexpr size_t WS_XL = WS_PROJ + (size_t)MT * NPAD * 2;
constexpr size_t WS_XBC = WS_XL + (size_t)MT * 768 * 2;
constexpr size_t WS_MIX = WS_XBC + (size_t)MT * 1280 * 2;
constexpr size_t WS_SSQ = WS_MIX + (size_t)MT * 2048 * 2;
constexpr size_t WS_ROPE = WS_SSQ + (size_t)MT * 12 * 4;
constexpr size_t WS_CTR = WS_ROPE + 131328;
constexpr size_t WS_SFLAG = WS_CTR + 256;
constexpr size_t WS_SEND = WS_SFLAG + 8192;
constexpr size_t WS_BAR = WS_SEND + (size_t)4 * 96 * 4 * 8192 * 4;
constexpr size_t WS_END = WS_BAR + 16384;

constexpr size_t O_YP = 0;
constexpr size_t O_YS = O_YP + (size_t)8 * 2048 * 1024;
constexpr size_t O_PK = O_YS + (size_t)128 * 1024;
constexpr size_t O_PV = O_PK + (size_t)4 * 8 * 128 * 2 * 64;
constexpr size_t O_PLC = O_PV + (size_t)4 * 8 * 128 * 2 * 64;
constexpr size_t O_PLH = O_PLC + (size_t)4 * 8 * 3 * 768;
constexpr size_t O_PSC = O_PLH + (size_t)4 * 8 * 768;
constexpr size_t O_PSH = O_PSC + (size_t)4 * 8 * 3 * 1280;
constexpr size_t O_SK = O_PSH + (size_t)4 * 8 * 12 * 64 * 128;
constexpr size_t O_SV = O_SK + (size_t)4 * 128 * 128 * 2 * 64;
constexpr size_t O_SLC = O_SV + (size_t)4 * 128 * 128 * 2 * 64;
constexpr size_t O_SLH = O_SLC + (size_t)4 * 128 * 3 * 768;
constexpr size_t O_SSC = O_SLH + (size_t)4 * 128 * 768;
constexpr size_t O_SSH = O_SSC + (size_t)4 * 128 * 3 * 1280;

struct Params {
  const float* in[26];
  float* out;
  char* ws;
};

typedef __bf16 bf2_t __attribute__((ext_vector_type(2)));
typedef float fl2_t __attribute__((ext_vector_type(2)));
DI u16 f2bf(float x) { return __builtin_bit_cast(u16, (__bf16)x); }
DI float bf2f(u16 b) { return __uint_as_float(((unsigned)b) << 16); }
DI unsigned pack2(float a, float b) { fl2_t v = {a, b}; return __builtin_bit_cast(unsigned, __builtin_convertvector(v, bf2_t)); }
DI float bflo(unsigned u) { return __uint_as_float(u << 16); }
DI float bfhi(unsigned u) { return __uint_as_float(u & 0xffff0000u); }
DI void unpack8(uint4 v, float* f) {
  f[0] = bflo(v.x); f[1] = bfhi(v.x); f[2] = bflo(v.y); f[3] = bfhi(v.y);
  f[4] = bflo(v.z); f[5] = bfhi(v.z); f[6] = bflo(v.w); f[7] = bfhi(v.w);
}
DI void unpack8v(u32x4 v, float* f) {
  f[0] = bflo(v[0]); f[1] = bfhi(v[0]); f[2] = bflo(v[1]); f[3] = bfhi(v[1]);
  f[4] = bflo(v[2]); f[5] = bfhi(v[2]); f[6] = bflo(v[3]); f[7] = bfhi(v[3]);
}
DI uint4 pack8(const float* f) {
  uint4 v; v.x = pack2(f[0], f[1]); v.y = pack2(f[2], f[3]); v.z = pack2(f[4], f[5]); v.w = pack2(f[6], f[7]); return v;
}
DI f32x4 mfma16(bf16x8 a, bf16x8 b, f32x4 c) { return __builtin_amdgcn_mfma_f32_16x16x32_bf16(a, b, c, 0, 0, 0); }
DI bf16x8 ldfrag(const u16* base, int ld, int row0, int k0, int lane) {
  return *(const bf16x8*)(base + (row0 + (lane & 15)) * ld + k0 + (lane >> 4) * 8);
}
DI bf16x8 ldfrag_perm(const u16* base, int ld, int row0, int k0, int lane) {
  const u16* pp = base + (row0 + (lane & 15)) * ld + k0 + (lane >> 4) * 4;
  uint2 a = *(const uint2*)pp; uint2 b = *(const uint2*)(pp + 16);
  uint4 v; v.x = a.x; v.y = a.y; v.z = b.x; v.w = b.y;
  return __builtin_bit_cast(bf16x8, v);
}
DI bf16x8 packfrag(f32x4 t0, f32x4 t1) {
  uint4 v; v.x = pack2(t0[0], t0[1]); v.y = pack2(t0[2], t0[3]); v.z = pack2(t1[0], t1[1]); v.w = pack2(t1[2], t1[3]);
  return __builtin_bit_cast(bf16x8, v);
}
DI float silu_f(float x) { return x * __builtin_amdgcn_rcpf(1.f + __expf(-x)); }
DI float sigmoid_f(float x) { return __builtin_amdgcn_rcpf(1.f + __expf(-x)); }
DI float softplus_f(float x) { return x > 20.f ? x : log1pf(__expf(x)); }

DI int opaque_tid() { int t = threadIdx.x; asm volatile("" : "+v"(t)); return t; }
DI int next_item(unsigned* ctr, int* slot) {
  __syncthreads();
  if (threadIdx.x == 0) *slot = (int)atomicAdd(ctr, 1u);
  __syncthreads();
  return *slot;
}

PH void phase_prep(const Params& p) {
  SMEM;
  const int tid = opaque_tid();
  float* tile = (float*)smem;
  u16* WinT = (u16*)(p.ws + WS_WIN);
  u16* WoutT = (u16*)(p.ws + WS_WOUT);
  u16* Xb = (u16*)(p.ws + WS_XB);
  float* ROPE = (float*)(p.ws + WS_ROPE);
  unsigned* ctr = (unsigned*)(p.ws + WS_CTR);
  if (blockIdx.x == 0 && tid < 64) ctr[tid] = 0u;
  if (blockIdx.x == 1) { unsigned* sf = (unsigned*)(p.ws + WS_SFLAG); for (int i = tid; i < 2048; i += 256) sf[i] = 0u; }
  constexpr int U_WIN = 4 * 16 * 78;
  constexpr int U_WOUT = 4 * 32 * 16;
  constexpr int U_LW = 64;
  constexpr int U_XB = MT * 1024 / 2048;
  constexpr int U_ROPE = 65;
  constexpr int U_TOT = U_WIN + U_WOUT + U_LW + U_XB + U_ROPE;
  for (int u = blockIdx.x; u < U_TOT; u += gridDim.x) {
    if (u < U_WIN) {
      const int l = u / (16 * 78), r = u % (16 * 78), kt = r / 78, nt = r % 78;
      const float* src = p.in[8] + (size_t)l * 1024 * 4876;
#pragma unroll
      for (int i = 0; i < 16; ++i) {
        const int k = (tid >> 6) + 4 * i, n = nt * 64 + (tid & 63);
        tile[k * 65 + (tid & 63)] = (n < 4876) ? src[(size_t)(kt * 64 + k) * 4876 + n] : 0.f;
      }
      __syncthreads();
      u16* dst = WinT + (size_t)l * NPAD * 1024;
#pragma unroll
      for (int i = 0; i < 8; ++i) {
        const int nn = (tid >> 5) + 8 * i, k = (tid & 31) * 2;
        *(unsigned*)(dst + (size_t)(nt * 64 + nn) * 1024 + kt * 64 + k) = pack2(tile[k * 65 + nn], tile[(k + 1) * 65 + nn]);
      }
      __syncthreads();
    } else if (u < U_WIN + U_WOUT) {
      const int v = u - U_WIN;
      const int l = v / (32 * 16), r = v % (32 * 16), kt = r / 16, nt = r % 16;
      const float* src = p.in[9] + (size_t)l * 2048 * 1024;
      const float* ng = p.in[23] + l * 768;
#pragma unroll
      for (int i = 0; i < 16; ++i) {
        const int k = (tid >> 6) + 4 * i, kg = kt * 64 + k;
        const float sc = (kg >= 1280) ? ng[kg - 1280] : 1.f;
        tile[k * 65 + (tid & 63)] = src[(size_t)kg * 1024 + nt * 64 + (tid & 63)] * sc;
      }
      __syncthreads();
      u16* dst = WoutT + (size_t)l * 1024 * 2048;
#pragma unroll
      for (int i = 0; i < 8; ++i) {
        const int nn = (tid >> 5) + 8 * i, k = (tid & 31) * 2;
        *(unsigned*)(dst + (size_t)(nt * 64 + nn) * 2048 + kt * 64 + k) = pack2(tile[k * 65 + nn], tile[(k + 1) * 65 + nn]);
      }
      __syncthreads();
    } else if (u < U_WIN + U_WOUT + U_LW) {
      const int v = u - U_WIN - U_WOUT;
      const int l = v / 16, rem = v % 16, n = rem / 2, which = rem % 2;
      const float* src = (which ? p.in[15] : p.in[13]) + (size_t)(l * 8 + n) * 9216;
      u16* dst = (u16*)(p.ws + (which ? WS_WX : WS_WA)) + (size_t)(l * 8 + n) * 9216;
      for (int e = tid; e < 9216; e += 256) {
        const int d = e / 96, c = e % 96;
        dst[e] = f2bf(src[c * 96 + d]);
      }
    } else if (u < U_WIN + U_WOUT + U_LW + U_XB) {
      const int v = u - U_WIN - U_WOUT - U_LW;
      const size_t ge = (size_t)v * 2048 + (size_t)tid * 8;
      const float* src = (ge < (size_t)MP * 1024) ? (p.in[0] + ge) : (p.in[1] + (ge - (size_t)MP * 1024));
      const float4 a = *(const float4*)src, b = *(const float4*)(src + 4);
      uint4 o; o.x = pack2(a.x, a.y); o.y = pack2(a.z, a.w); o.z = pack2(b.x, b.y); o.w = pack2(b.z, b.w);
      *(uint4*)(Xb + ge) = o;
    } else {
      const int v = u - U_WIN - U_WOUT - U_LW - U_XB;
      const int e = v * 256 + tid;
      if (e < 2049 * 8) {
        const int pi = e >> 3, i = e & 7;
        const double pos = (pi < 2048) ? (double)pi : 8192.0;
        const double inv = pow(500000.0, -(double)i / 8.0);
        double sn, cs; sincos(pos * inv, &sn, &cs);
        ROPE[e * 2 + 0] = (float)cs; ROPE[e * 2 + 1] = (float)sn;
      }
    }
  }
}

DI void tile_coords(int t, int NTN, int& m0, int& n0) {
  const int panel = t / (8 * NTN), within = t % (8 * NTN);
  int tm, tn;
  if (panel < 16) { tn = within >> 3; tm = panel * 8 + (within & 7); } else { tm = 128; tn = t - 16 * 8 * NTN; }
  m0 = tm * 128; n0 = tn * 128;
}
template <int MODE>
PH void gemm_phase(const Params& p, int layer) {
  SMEM;
  constexpr int K = (MODE == 0) ? 1024 : 2048;
  constexpr int NTN = (MODE == 0) ? 39 : 8;
  constexpr int NK = K / 64;
  constexpr int LOGNK = (MODE == 0) ? 4 : 5;
  const u16* X = (const u16*)(p.ws + (MODE == 0 ? WS_XB : WS_MIX));
  const u16* W = (const u16*)(p.ws + (MODE == 0 ? WS_WIN : WS_WOUT)) + (size_t)layer * (MODE == 0 ? (size_t)NPAD * 1024 : (size_t)1024 * 2048);
  u16* sX = (u16*)smem;
  u16* sW = sX + 2 * 128 * 72;
  const int tid = opaque_tid(), lane = tid & 63, w = tid >> 6, quad = lane >> 4, l15 = lane & 15;
  const int wn = w >> 1, wm = w & 1;
  const int ntiles = 129 * NTN;
  const int G = gridDim.x, bid = blockIdx.x;
  const int off = ((G & 7) == 0) ? ((bid & 7) * (G >> 3) + (bid >> 3)) : bid;
  if (off < ntiles) {
    const int nt_b = (ntiles - off + G - 1) / G;
    const int total = nt_b << LOGNK;
    const int soff = (tid >> 3) * 72 + (tid & 7) * 8;
    const int rowoff = tid >> 3, coloff = (tid & 7) * 8;
    f32x4 acc[4][4];
    u32x4 rx[2][4], rw[2][4];
#define GLOAD(S, g_) { \
      const int gg_ = ((g_) < total) ? (g_) : (total - 1); \
      const int it_ = gg_ >> LOGNK, kt_ = gg_ & (NK - 1); \
      int m0_, n0_; tile_coords(it_ * G + off, NTN, m0_, n0_); \
      const int k0_ = ((MODE == 0) ? kt_ : ((kt_ + 20) & 31)) * 64; \
      const u16* gx_ = X + (size_t)(m0_ + rowoff) * K + coloff + k0_; \
      const u16* gw_ = W + (size_t)(n0_ + rowoff) * K + coloff + k0_; \
      _Pragma("unroll") for (int i = 0; i < 4; ++i) { \
        rx[S][i] = *(const u32x4*)(gx_ + (size_t)i * 32 * K); \
        rw[S][i] = *(const u32x4*)(gw_ + (size_t)i * 32 * K); } }
#define LSTORE(S, buf_) { \
      u16* dX_ = sX + (buf_) * 128 * 72; u16* dW_ = sW + (buf_) * 128 * 72; \
      _Pragma("unroll") for (int i = 0; i < 4; ++i) { \
        *(u32x4*)(dX_ + soff + i * 32 * 72) = rx[S][i]; \
        *(u32x4*)(dW_ + soff + i * 32 * 72) = rw[S][i]; } }
    GLOAD(0, 0); GLOAD(1, 1);
    LSTORE(0, 0);
    __syncthreads();
#pragma unroll 1
    for (int g0 = 0; g0 < total; g0 += 2) {
#pragma unroll
      for (int s = 0; s < 2; ++s) {
        const int g = g0 + s;
        {
          const int kt = g & (NK - 1), it = g >> LOGNK;
          if (kt == 0) {
#pragma unroll
            for (int a = 0; a < 4; ++a)
#pragma unroll
              for (int b = 0; b < 4; ++b) acc[a][b] = (f32x4){0.f, 0.f, 0.f, 0.f};
          }
          if (MODE == 1 && kt == 12) {
            int m0, n0; tile_coords(it * G + off, NTN, m0, n0);
            const float* SSQ = (const float*)(p.ws + WS_SSQ);
#pragma unroll
            for (int mt = 0; mt < 4; ++mt) {
              const int m = m0 + wm * 64 + mt * 16 + l15;
              const float4 s0 = *(const float4*)(SSQ + (size_t)m * 12), s1 = *(const float4*)(SSQ + (size_t)m * 12 + 4), s2 = *(const float4*)(SSQ + (size_t)m * 12 + 8);
              const float ss = s0.x + s0.y + s0.z + s0.w + s1.x + s1.y + s1.z + s1.w + s2.x + s2.y + s2.z + s2.w;
              const float rs = rsqrtf(ss * (1.f / 768.f) + 1e-5f);
#pragma unroll
              for (int nt = 0; nt < 4; ++nt) acc[nt][mt] *= rs;
            }
          }
          const u16* cX = sX + (g & 1) * 128 * 72;
          const u16* cW = sW + (g & 1) * 128 * 72;
          u16* dX = sX + ((g + 1) & 1) * 128 * 72;
          u16* dW = sW + ((g + 1) & 1) * 128 * 72;
#pragma unroll
          for (int ks = 0; ks < 2; ++ks) {
            bf16x8 wf[4], xf[4];
#pragma unroll
            for (int i = 0; i < 4; ++i) {
              wf[i] = ldfrag(cW, 72, wn * 64 + i * 16, ks * 32, lane);
              xf[i] = ldfrag(cX, 72, wm * 64 + i * 16, ks * 32, lane);
            }
            __builtin_amdgcn_sched_barrier(0);
#pragma unroll
            for (int nt = 0; nt < 4; ++nt) {
#pragma unroll
              for (int mt = 0; mt < 4; ++mt) acc[nt][mt] = mfma16(wf[nt], xf[mt], acc[nt][mt]);
              if (ks == 0) *(u32x4*)(dX + soff + nt * 32 * 72) = rx[(s + 1) & 1][nt];
              else         *(u32x4*)(dW + soff + nt * 32 * 72) = rw[(s + 1) & 1][nt];
              __builtin_amdgcn_sched_barrier(0);
            }
            if (ks == 0) { GLOAD(s, g + 2); __builtin_amdgcn_sched_barrier(0); }
          }
          __syncthreads();
          if (kt == NK - 1) {
            int m0, n0; tile_coords(it * G + off, NTN, m0, n0);
            if (MODE == 0) {
              u16* PROJ = (u16*)(p.ws + WS_PROJ);
              u16* eX = sX + (g & 1) * 128 * 72;
              u16* eW = sW + (g & 1) * 128 * 72;
#pragma unroll
              for (int mt = 0; mt < 4; ++mt) {
                const int ml = mt * 16 + l15;
                u16* eb = (wm == 0 ? eX : eW) + ml * 136;
#pragma unroll
                for (int nt = 0; nt < 4; ++nt) {
                  const int nl = wn * 64 + nt * 16 + quad * 4;
                  uint2 o; o.x = pack2(acc[nt][mt][0], acc[nt][mt][1]); o.y = pack2(acc[nt][mt][2], acc[nt][mt][3]);
                  *(uint2*)(eb + nl) = o;
                }
              }
              __syncthreads();
#pragma unroll
              for (int i = 0; i < 8; ++i) {
                const int row = (tid >> 4) + 16 * i, ch = tid & 15;
                const u16* eb = (row < 64 ? eX + row * 136 : eW + (row - 64) * 136) + ch * 8;
                *(u32x4*)(PROJ + (size_t)(m0 + row) * NPAD + n0 + ch * 8) = *(const u32x4*)eb;
              }
              {
                const int tn_ = n0 >> 7;
                const bool is_lru = (tn_ >= 10) && (tn_ < 16), is_ssd = (tn_ >= 28) && (tn_ < 38);
                if ((is_lru || is_ssd) && m0 < MP) {
                  const int o = tid & 15, rbase = (tid >> 4) * 8;
                  const int nch = is_lru ? 768 : 1280;
                  const int chn = (is_lru ? (n0 - C_XL) : (n0 - C_XBC)) + o * 8;
                  const float* cw = (is_lru ? (p.in[11] + layer * 4 * 768) : (p.in[18] + layer * 4 * 1280)) + chn;
                  const float* cb = (is_lru ? (p.in[12] + layer * 768) : (p.in[19] + layer * 1280)) + chn;
                  u16* dst = (u16*)(p.ws + (is_lru ? WS_XL : WS_XBC)) + chn;
                  float w0[8], w1[8], w2[8], w3[8], bs[8];
#pragma unroll
                  for (int h = 0; h < 2; ++h) {
                    const float4 a0 = *(const float4*)(cw + 0 * nch + 4 * h), a1 = *(const float4*)(cw + 1 * nch + 4 * h);
                    const float4 a2 = *(const float4*)(cw + 2 * nch + 4 * h), a3 = *(const float4*)(cw + 3 * nch + 4 * h);
                    const float4 b4 = *(const float4*)(cb + 4 * h);
                    w0[4 * h] = a0.x; w0[4 * h + 1] = a0.y; w0[4 * h + 2] = a0.z; w0[4 * h + 3] = a0.w;
                    w1[4 * h] = a1.x; w1[4 * h + 1] = a1.y; w1[4 * h + 2] = a1.z; w1[4 * h + 3] = a1.w;
                    w2[4 * h] = a2.x; w2[4 * h + 1] = a2.y; w2[4 * h + 2] = a2.z; w2[4 * h + 3] = a2.w;
                    w3[4 * h] = a3.x; w3[4 * h + 1] = a3.y; w3[4 * h + 2] = a3.z; w3[4 * h + 3] = a3.w;
                    bs[4 * h] = b4.x; bs[4 * h + 1] = b4.y; bs[4 * h + 2] = b4.z; bs[4 * h + 3] = b4.w;
                  }
                  float xa[8], xb[8], xc[8], xd[8], yv[8];
#pragma unroll
                  for (int c = 0; c < 8; ++c) { xa[c] = 0.f; xb[c] = 0.f; xc[c] = 0.f; }
                  if (rbase >= 8) {
                    const int r1 = rbase - 3, r2 = rbase - 2, r3 = rbase - 1;
                    unpack8(*(const uint4*)((r1 < 64 ? eX + r1 * 136 : eW + (r1 - 64) * 136) + o * 8), xa);
                    unpack8(*(const uint4*)((r2 < 64 ? eX + r2 * 136 : eW + (r2 - 64) * 136) + o * 8), xb);
                    unpack8(*(const uint4*)((r3 < 64 ? eX + r3 * 136 : eW + (r3 - 64) * 136) + o * 8), xc);
                  }
#pragma unroll
                  for (int i = 0; i < 8; ++i) {
                    const int row = rbase + i;
                    unpack8(*(const uint4*)((row < 64 ? eX + row * 136 : eW + (row - 64) * 136) + o * 8), xd);
#pragma unroll
                    for (int c = 0; c < 8; ++c) {
                      const float v = bs[c] + w0[c] * xa[c] + w1[c] * xb[c] + w2[c] * xc[c] + w3[c] * xd[c];
                      yv[c] = is_lru ? v : silu_f(v);
                    }
                    if (row >= 3) *(uint4*)(dst + (size_t)(m0 + row) * nch) = pack8(yv);
#pragma unroll
                    for (int c = 0; c < 8; ++c) { xa[c] = xb[c]; xb[c] = xc[c]; xc[c] = xd[c]; }
                  }
                }
              }
              __syncthreads();
            } else {
              float* PRE = (float*)(p.ws + WS_PRE);
              const float alpha = 1.681792830507429f;
#pragma unroll
              for (int mt = 0; mt < 4; ++mt) {
                const int m = m0 + wm * 64 + mt * 16 + l15;
                const float* xres = (m < MP) ? (p.in[0] + (size_t)m * 1024) : (p.in[1] + (size_t)(m - MP) * 1024);
                const u16* xrb = (const u16*)(p.ws + WS_XB) + (size_t)m * 1024;
#pragma unroll
                for (int nt = 0; nt < 4; ++nt) {
                  const int n = n0 + wn * 64 + nt * 16 + quad * 4;
                  float4 xr;
                  if (layer == 0) xr = *(const float4*)(xres + n);
                  else { const uint2 xb2 = *(const uint2*)(xrb + n); xr = make_float4(bflo(xb2.x), bfhi(xb2.x), bflo(xb2.y), bfhi(xb2.y)); }
                  float4 o;
                  o.x = alpha * xr.x + acc[nt][mt][0]; o.y = alpha * xr.y + acc[nt][mt][1];
                  o.z = alpha * xr.z + acc[nt][mt][2]; o.w = alpha * xr.w + acc[nt][mt][3];
                  *(float4*)(PRE + (size_t)m * 1024 + n) = o;
                }
              }
            }
          }
        }
      }
    }
#undef GLOAD
#undef LSTORE
  }
}

PH void ln_phase(const Params& p, int layer) {
  const int tid = opaque_tid(), lane = tid & 63, w = tid >> 6;
  const float* PRE = (const float*)(p.ws + WS_PRE);
  u16* Xb = (u16*)(p.ws + WS_XB);
  const float* g = p.in[24] + layer * 1024;
  const float* bb = p.in[25] + layer * 1024;
  f32x4 gg[4], bv[4], nv[4];
#pragma unroll
  for (int i = 0; i < 4; ++i) {
    gg[i] = *(const f32x4*)(g + i * 256 + lane * 4);
    bv[i] = *(const f32x4*)(bb + i * 256 + lane * 4);
  }
  const int stride = gridDim.x * 4;
  int row = blockIdx.x * 4 + w;
  if (row < MT) {
#pragma unroll
    for (int i = 0; i < 4; ++i) nv[i] = *(const f32x4*)(PRE + (size_t)row * 1024 + i * 256 + lane * 4);
  }
#pragma unroll 1
  for (; row < MT; row += stride) {
    f32x4 v[4];
#pragma unroll
    for (int i = 0; i < 4; ++i) v[i] = nv[i];
    {
      const int nrow = (row + stride < MT) ? (row + stride) : row;
#pragma unroll
      for (int i = 0; i < 4; ++i) nv[i] = *(const f32x4*)(PRE + (size_t)nrow * 1024 + i * 256 + lane * 4);
    }
    float s = 0.f;
#pragma unroll
    for (int i = 0; i < 4; ++i) s += v[i][0] + v[i][1] + v[i][2] + v[i][3];
#pragma unroll
    for (int d = 1; d < 64; d <<= 1) s += __shfl_xor(s, d);
    const float mu = s * (1.f / 1024.f);
    float q = 0.f;
#pragma unroll
    for (int i = 0; i < 4; ++i) {
      v[i] -= mu;
      q += v[i][0] * v[i][0] + v[i][1] * v[i][1] + v[i][2] * v[i][2] + v[i][3] * v[i][3];
    }
#pragma unroll
    for (int d = 1; d < 64; d <<= 1) q += __shfl_xor(q, d);
    const float rs = rsqrtf(q * (1.f / 1024.f) + 1e-5f);
#pragma unroll
    for (int i = 0; i < 4; ++i) {
      const int c = i * 256 + lane * 4;
      const f32x4 o = v[i] * rs * gg[i] + bv[i];
      if (layer == 3) {
        float* dst = (row < MP) ? (p.out + O_YP + (size_t)row * 1024) : (p.out + O_YS + (size_t)(row - MP) * 1024);
        *(f32x4*)(dst + c) = o;
      } else {
        uint2 ob; ob.x = pack2(o[0], o[1]); ob.y = pack2(o[2], o[3]);
        *(uint2*)(Xb + (size_t)row * 1024 + c) = ob;
      }
    }
  }
}

PH void conv_unit(const Params& p, int layer, int unit) {
  const int tid = opaque_tid();
  const int T = (unit < 128) ? unit : 128, ru = (unit < 128) ? 0 : (unit - 128);
  const bool lru = tid < 96;
  const int oo = lru ? tid : tid - 96;
  const int nch = lru ? 768 : 1280;
  const int srccol = (lru ? C_XL : C_XBC) + 8 * oo;
  const float* cw = (lru ? (p.in[11] + layer * 4 * 768) : (p.in[18] + layer * 4 * 1280)) + 8 * oo;
  const float* cb = (lru ? (p.in[12] + layer * 768) : (p.in[19] + layer * 1280)) + 8 * oo;
  const u16* PROJ = (const u16*)(p.ws + WS_PROJ);
  u16* dst = (u16*)(p.ws + (lru ? WS_XL : WS_XBC)) + 8 * oo;
  float w0[8], w1[8], w2[8], w3[8], bs[8];
#pragma unroll
  for (int h = 0; h < 2; ++h) {
    const float4 a0 = *(const float4*)(cw + 0 * nch + 4 * h), a1 = *(const float4*)(cw + 1 * nch + 4 * h);
    const float4 a2 = *(const float4*)(cw + 2 * nch + 4 * h), a3 = *(const float4*)(cw + 3 * nch + 4 * h);
    const float4 b4 = *(const float4*)(cb + 4 * h);
    w0[4 * h] = a0.x; w0[4 * h + 1] = a0.y; w0[4 * h + 2] = a0.z; w0[4 * h + 3] = a0.w;
    w1[4 * h] = a1.x; w1[4 * h + 1] = a1.y; w1[4 * h + 2] = a1.z; w1[4 * h + 3] = a1.w;
    w2[4 * h] = a2.x; w2[4 * h + 1] = a2.y; w2[4 * h + 2] = a2.z; w2[4 * h + 3] = a2.w;
    w3[4 * h] = a3.x; w3[4 * h + 1] = a3.y; w3[4 * h + 2] = a3.z; w3[4 * h + 3] = a3.w;
    bs[4 * h] = b4.x; bs[4 * h + 1] = b4.y; bs[4 * h + 2] = b4.z; bs[4 * h + 3] = b4.w;
  }
  float xa[8], xb[8], xc[8], xd[8], y[8];
  if (T < 128) {
    const int r0 = T * 128, pos0 = r0 & 2047, b = r0 >> 11;
    if (pos0 == 0) {
#pragma unroll
      for (int c = 0; c < 8; ++c) { xa[c] = 0.f; xb[c] = 0.f; xc[c] = 0.f; }
    } else {
      unpack8(*(const uint4*)(PROJ + (size_t)(r0 - 3) * NPAD + srccol), xa);
      unpack8(*(const uint4*)(PROJ + (size_t)(r0 - 2) * NPAD + srccol), xb);
      unpack8(*(const uint4*)(PROJ + (size_t)(r0 - 1) * NPAD + srccol), xc);
    }
#pragma unroll
    for (int i = 0; i < 3; ++i) {
      const int row = r0 + i;
      unpack8(*(const uint4*)(PROJ + (size_t)row * NPAD + srccol), xd);
#pragma unroll
      for (int c = 0; c < 8; ++c) {
        float v = bs[c] + w0[c] * xa[c] + w1[c] * xb[c] + w2[c] * xc[c] + w3[c] * xd[c];
        y[c] = lru ? v : silu_f(v);
      }
      *(uint4*)(dst + (size_t)row * nch) = pack8(y);
#pragma unroll
      for (int c = 0; c < 8; ++c) { xa[c] = xb[c]; xb[c] = xc[c]; xc[c] = xd[c]; }
    }
    if ((T & 15) == 15) {
#pragma unroll
      for (int j = 0; j < 3; ++j) {
        unpack8(*(const uint4*)(PROJ + (size_t)(b * 2048 + 2045 + j) * NPAD + srccol), xd);
        float* op = p.out + (lru ? (O_PLC + (size_t)((layer * 8 + b) * 3 + j) * 768) : (O_PSC + (size_t)((layer * 8 + b) * 3 + j) * 1280)) + 8 * oo;
        *(float4*)op = make_float4(xd[0], xd[1], xd[2], xd[3]);
        *(float4*)(op + 4) = make_float4(xd[4], xd[5], xd[6], xd[7]);
      }
    }
  } else {
#pragma unroll 2
    for (int i = 0; i < 16; ++i) {
      const int bi = ru * 16 + i, row = MP + bi;
      const float* st = (lru ? (p.in[4] + (size_t)(layer * 128 + bi) * 3 * 768) : (p.in[6] + (size_t)(layer * 128 + bi) * 3 * 1280)) + 8 * oo;
#pragma unroll
      for (int h = 0; h < 2; ++h) {
        const float4 a = *(const float4*)(st + 0 * nch + 4 * h), b4 = *(const float4*)(st + 1 * nch + 4 * h), c4 = *(const float4*)(st + 2 * nch + 4 * h);
        xa[4 * h] = a.x; xa[4 * h + 1] = a.y; xa[4 * h + 2] = a.z; xa[4 * h + 3] = a.w;
        xb[4 * h] = b4.x; xb[4 * h + 1] = b4.y; xb[4 * h + 2] = b4.z; xb[4 * h + 3] = b4.w;
        xc[4 * h] = c4.x; xc[4 * h + 1] = c4.y; xc[4 * h + 2] = c4.z; xc[4 * h + 3] = c4.w;
      }
      unpack8(*(const uint4*)(PROJ + (size_t)row * NPAD + srccol), xd);
#pragma unroll
      for (int c = 0; c < 8; ++c) {
        float v = bs[c] + w0[c] * xa[c] + w1[c] * xb[c] + w2[c] * xc[c] + w3[c] * xd[c];
        y[c] = lru ? v : silu_f(v);
      }
      *(uint4*)(dst + (size_t)row * nch) = pack8(y);
      float* op = p.out + (lru ? (O_SLC + (size_t)(layer * 128 + bi) * 3 * 768) : (O_SSC + (size_t)(layer * 128 + bi) * 3 * 1280)) + 8 * oo;
      *(float4*)(op) = make_float4(xb[0], xb[1], xb[2], xb[3]);
      *(float4*)(op + 4) = make_float4(xb[4], xb[5], xb[6], xb[7]);
      *(float4*)(op + nch) = make_float4(xc[0], xc[1], xc[2], xc[3]);
      *(float4*)(op + nch + 4) = make_float4(xc[4], xc[5], xc[6], xc[7]);
      *(float4*)(op + 2 * nch) = make_float4(xd[0], xd[1], xd[2], xd[3]);
      *(float4*)(op + 2 * nch + 4) = make_float4(xd[4], xd[5], xd[6], xd[7]);
    }
  }
}

PH void attn_prompt_item(const Params& p, int layer, int item) {
  SMEM;
  const int tid = opaque_tid(), lane = tid & 63, w = tid >> 6, quad = lane >> 4, l15 = lane & 15;
  const int b = item >> 5, nb = (item >> 1) & 15, kvh = item & 1;
  u16* Ks = (u16*)smem;
  u16* Vt = (u16*)(smem + 256 * 72 * 2);
  const u16* PROJ = (const u16*)(p.ws + WS_PROJ);
  u16* MIX = (u16*)(p.ws + WS_MIX);
  const float* ROPE = (const float*)(p.ws + WS_ROPE);
  {
    const int j = tid, t = nb * 128 - 128 + j;
    uint4 kq[8], vq[8];
    if (t >= 0) {
      const u16* src = PROJ + (size_t)(b * 2048 + t) * NPAD;
#pragma unroll
      for (int i = 0; i < 8; ++i) {
        kq[i] = *(const uint4*)(src + C_K + kvh * 64 + i * 8);
        vq[i] = *(const uint4*)(src + C_V + kvh * 64 + i * 8);
      }
    } else {
#pragma unroll
      for (int i = 0; i < 8; ++i) { kq[i] = make_uint4(0, 0, 0, 0); vq[i] = make_uint4(0, 0, 0, 0); }
    }
    float x1[8], x2[8];
    unpack8(kq[0], x1); unpack8(kq[1], x2);
    if (t >= 0) {
      const float* cs = ROPE + (size_t)t * 16;
#pragma unroll
      for (int i = 0; i < 8; ++i) {
        const float c = cs[2 * i], s = cs[2 * i + 1];
        const float r1 = x1[i] * c - x2[i] * s, r2 = x2[i] * c + x1[i] * s;
        x1[i] = r1; x2[i] = r2;
      }
    }
    kq[0] = pack8(x1); kq[1] = pack8(x2);
#pragma unroll
    for (int i = 0; i < 8; ++i) *(uint4*)(Ks + j * 72 + i * 8) = kq[i];
#pragma unroll
    for (int i = 0; i < 8; ++i) {
      Vt[(i * 8 + 0) * 264 + j] = (u16)(vq[i].x & 0xffffu); Vt[(i * 8 + 1) * 264 + j] = (u16)(vq[i].x >> 16);
      Vt[(i * 8 + 2) * 264 + j] = (u16)(vq[i].y & 0xffffu); Vt[(i * 8 + 3) * 264 + j] = (u16)(vq[i].y >> 16);
      Vt[(i * 8 + 4) * 264 + j] = (u16)(vq[i].z & 0xffffu); Vt[(i * 8 + 5) * 264 + j] = (u16)(vq[i].z >> 16);
      Vt[(i * 8 + 6) * 264 + j] = (u16)(vq[i].w & 0xffffu); Vt[(i * 8 + 7) * 264 + j] = (u16)(vq[i].w >> 16);
    }
    if (nb == 15 && j >= 128) {
      float* ok = p.out + O_PK + ((size_t)((layer * 8 + b) * 128 + (j - 128)) * 2 + kvh) * 64;
      float* ov = p.out + O_PV + ((size_t)((layer * 8 + b) * 128 + (j - 128)) * 2 + kvh) * 64;
      *(float4*)(ok + 0) = make_float4(x1[0], x1[1], x1[2], x1[3]);
      *(float4*)(ok + 4) = make_float4(x1[4], x1[5], x1[6], x1[7]);
      *(float4*)(ok + 8) = make_float4(x2[0], x2[1], x2[2], x2[3]);
      *(float4*)(ok + 12) = make_float4(x2[4], x2[5], x2[6], x2[7]);
#pragma unroll
      for (int i = 2; i < 8; ++i) {
        float f[8]; unpack8(kq[i], f);
        *(float4*)(ok + i * 8) = make_float4(f[0], f[1], f[2], f[3]);
        *(float4*)(ok + i * 8 + 4) = make_float4(f[4], f[5], f[6], f[7]);
      }
#pragma unroll
      for (int i = 0; i < 8; ++i) {
        float f[8]; unpack8(vq[i], f);
        *(float4*)(ov + i * 8) = make_float4(f[0], f[1], f[2], f[3]);
        *(float4*)(ov + i * 8 + 4) = make_float4(f[4], f[5], f[6], f[7]);
      }
    }
  }
  __syncthreads();
  const int h = kvh * 4 + w;
  const float sink = p.in[10][layer * 8 + h];
#pragma unroll 1
  for (int c = 0; c < 4; ++c) {
    const int q0 = 32 * c;
    bf16x8 qf[2][2];
#pragma unroll
    for (int qt = 0; qt < 2; ++qt) {
      const int qi = q0 + qt * 16 + l15;
      const int tpos = nb * 128 + qi;
      const u16* src = PROJ + (size_t)(b * 2048 + tpos) * NPAD + h * 64;
      float own[8], o1[8];
      unpack8(*(const uint4*)(src + quad * 8), own);
      unpack8(*(const uint4*)(src + 32 + quad * 8), o1);
      if (quad < 2) {
        float pr[8];
        unpack8(*(const uint4*)(src + (quad ^ 1) * 8), pr);
        const float* cs = ROPE + (size_t)tpos * 16;
        const float sg = (quad == 0) ? -1.f : 1.f;
#pragma unroll
        for (int i = 0; i < 8; ++i) own[i] = own[i] * cs[2 * i] + sg * pr[i] * cs[2 * i + 1];
      }
#pragma unroll
      for (int i = 0; i < 8; ++i) { own[i] *= 0.125f; o1[i] *= 0.125f; }
      qf[qt][0] = __builtin_bit_cast(bf16x8, pack8(own));
      qf[qt][1] = __builtin_bit_cast(bf16x8, pack8(o1));
    }
    f32x4 s[10][2];
#pragma unroll
    for (int kt = 0; kt < 10; ++kt) { s[kt][0] = (f32x4){0.f, 0.f, 0.f, 0.f}; s[kt][1] = (f32x4){0.f, 0.f, 0.f, 0.f}; }
#pragma unroll
    for (int ks = 0; ks < 2; ++ks)
#pragma unroll
      for (int kt = 0; kt < 10; ++kt) {
        const bf16x8 af = ldfrag(Ks, 72, q0 + kt * 16, ks * 32, lane);
        s[kt][0] = mfma16(af, qf[0][ks], s[kt][0]);
        s[kt][1] = mfma16(af, qf[1][ks], s[kt][1]);
      }
    float inv[2];
    bf16x8 pf[5][2];
#pragma unroll
    for (int qt = 0; qt < 2; ++qt) {
      const int i = q0 + qt * 16 + l15;
      float mx = -INFINITY;
#pragma unroll
      for (int kt = 0; kt < 10; ++kt)
#pragma unroll
        for (int r = 0; r < 4; ++r) {
          const int j = q0 + kt * 16 + quad * 4 + r;
          const bool valid = (j >= i) && (j <= i + 128) && (nb > 0 || j >= 128);
          const float v = valid ? s[kt][qt][r] : -INFINITY;
          s[kt][qt][r] = v;
          mx = fmaxf(mx, v);
        }
      mx = fmaxf(mx, __shfl_xor(mx, 16));
      mx = fmaxf(mx, __shfl_xor(mx, 32));
      mx = fmaxf(mx, sink);
      float sum = 0.f;
#pragma unroll
      for (int kt = 0; kt < 10; ++kt)
#pragma unroll
        for (int r = 0; r < 4; ++r) {
          const float e = __expf(s[kt][qt][r] - mx);
          s[kt][qt][r] = e;
          sum += e;
        }
      sum += __shfl_xor(sum, 16);
      sum += __shfl_xor(sum, 32);
      inv[qt] = 1.f / (sum + __expf(sink - mx));
#pragma unroll
      for (int kk = 0; kk < 5; ++kk) pf[kk][qt] = packfrag(s[2 * kk][qt], s[2 * kk + 1][qt]);
    }
    f32x4 o[4][2];
#pragma unroll
    for (int dt = 0; dt < 4; ++dt) { o[dt][0] = (f32x4){0.f, 0.f, 0.f, 0.f}; o[dt][1] = (f32x4){0.f, 0.f, 0.f, 0.f}; }
#pragma unroll
    for (int kk = 0; kk < 5; ++kk)
#pragma unroll
      for (int dt = 0; dt < 4; ++dt) {
        const bf16x8 vf = ldfrag_perm(Vt, 264, dt * 16, q0 + kk * 32, lane);
        o[dt][0] = mfma16(vf, pf[kk][0], o[dt][0]);
        o[dt][1] = mfma16(vf, pf[kk][1], o[dt][1]);
      }
#pragma unroll
    for (int qt = 0; qt < 2; ++qt) {
      const int qi = q0 + qt * 16 + l15;
      const size_t row = (size_t)(b * 2048 + nb * 128 + qi);
#pragma unroll
      for (int dt = 0; dt < 4; ++dt) {
        const int col = h * 64 + dt * 16 + quad * 4;
        const uint2 gv = *(const uint2*)(PROJ + row * NPAD + C_GA + col);
        const float g0 = bflo(gv.x), g1 = bfhi(gv.x), g2 = bflo(gv.y), g3 = bfhi(gv.y);
        uint2 ov;
        ov.x = pack2(o[dt][qt][0] * inv[qt] * silu_f(g0), o[dt][qt][1] * inv[qt] * silu_f(g1));
        ov.y = pack2(o[dt][qt][2] * inv[qt] * silu_f(g2), o[dt][qt][3] * inv[qt] * silu_f(g3));
        *(uint2*)(MIX + row * 2048 + col) = ov;
      }
    }
  }
}

PH void attn_decode_item(const Params& p, int layer, int item) {
  SMEM;
  const int tid = opaque_tid(), lane = tid & 63, w = tid >> 6;
  const int b = item >> 1, kvh = item & 1;
  float* Kd = (float*)smem;
  float* Vd = Kd + 129 * 65;
  float* qs = Vd + 129 * 64;
  float* ps = qs + 256;
  const u16* PROJ = (const u16*)(p.ws + WS_PROJ);
  u16* MIX = (u16*)(p.ws + WS_MIX);
  const float* ROPE = (const float*)(p.ws + WS_ROPE) + (size_t)2048 * 16;
  const size_t row = (size_t)(MP + b);
  const float* ck = p.in[2] + (size_t)(layer * 128 + b) * 128 * 128;
  const float* cv = p.in[3] + (size_t)(layer * 128 + b) * 128 * 128;
  float* ok = p.out + O_SK + (size_t)(layer * 128 + b) * 128 * 128;
  float* ov = p.out + O_SV + (size_t)(layer * 128 + b) * 128 * 128;
#pragma unroll
  for (int i = 0; i < 8; ++i) {
    const int idx = tid + 256 * i, wi = idx >> 4, c4 = idx & 15;
    const float4 kv = *(const float4*)(ck + (size_t)(wi * 2 + kvh) * 64 + c4 * 4);
    const float4 vv = *(const float4*)(cv + (size_t)(wi * 2 + kvh) * 64 + c4 * 4);
    Kd[wi * 65 + c4 * 4 + 0] = kv.x; Kd[wi * 65 + c4 * 4 + 1] = kv.y; Kd[wi * 65 + c4 * 4 + 2] = kv.z; Kd[wi * 65 + c4 * 4 + 3] = kv.w;
    *(float4*)(Vd + wi * 64 + c4 * 4) = vv;
    if (wi >= 1) {
      *(float4*)(ok + (size_t)((wi - 1) * 2 + kvh) * 64 + c4 * 4) = kv;
      *(float4*)(ov + (size_t)((wi - 1) * 2 + kvh) * 64 + c4 * 4) = vv;
    }
  }
  if (tid < 64) {
    const int d = tid;
    float kx = bf2f(PROJ[row * NPAD + C_K + kvh * 64 + d]);
    if (d < 16) {
      const float pr = bf2f(PROJ[row * NPAD + C_K + kvh * 64 + (d ^ 8)]);
      const float c = ROPE[2 * (d & 7)], s = ROPE[2 * (d & 7) + 1];
      kx = (d < 8) ? (kx * c - pr * s) : (kx * c + pr * s);
    }
    const float vx = bf2f(PROJ[row * NPAD + C_V + kvh * 64 + d]);
    Kd[128 * 65 + d] = kx; Vd[128 * 64 + d] = vx;
    ok[(size_t)(127 * 2 + kvh) * 64 + d] = kx;
    ov[(size_t)(127 * 2 + kvh) * 64 + d] = vx;
  }
  {
    const int g = tid >> 6, d = tid & 63, h = kvh * 4 + g;
    float qx = bf2f(PROJ[row * NPAD + h * 64 + d]);
    if (d < 16) {
      const float pr = bf2f(PROJ[row * NPAD + h * 64 + (d ^ 8)]);
      const float c = ROPE[2 * (d & 7)], s = ROPE[2 * (d & 7) + 1];
      qx = (d < 8) ? (qx * c - pr * s) : (qx * c + pr * s);
    }
    qs[g * 64 + d] = qx * 0.125f;
  }
  __syncthreads();
  const int h = kvh * 4 + w;
  const float sink = p.in[10][layer * 8 + h];
  float s0 = 0.f, s1 = 0.f, s2 = 0.f;
  for (int d = 0; d < 64; ++d) {
    const float qv = qs[w * 64 + d];
    s0 += qv * Kd[lane * 65 + d];
    s1 += qv * Kd[(lane + 64) * 65 + d];
    s2 += qv * Kd[128 * 65 + d];
  }
  float mx = fmaxf(fmaxf(s0, s1), s2);
#pragma unroll
  for (int d = 1; d < 64; d <<= 1) mx = fmaxf(mx, __shfl_xor(mx, d));
  mx = fmaxf(mx, sink);
  const float e0 = __expf(s0 - mx), e1 = __expf(s1 - mx), e2 = __expf(s2 - mx);
  float sum = e0 + e1;
#pragma unroll
  for (int d = 1; d < 64; d <<= 1) sum += __shfl_xor(sum, d);
  const float inv = 1.f / (sum + e2 + __expf(sink - mx));
  ps[w * 132 + lane] = e0 * inv;
  ps[w * 132 + 64 + lane] = e1 * inv;
  if (lane == 0) ps[w * 132 + 128] = e2 * inv;
  __syncthreads();
  float o = 0.f;
  for (int k = 0; k < 129; ++k) o += ps[w * 132 + k] * Vd[k * 64 + lane];
  const float gt = bf2f(PROJ[row * NPAD + C_GA + h * 64 + lane]);
  MIX[row * 2048 + h * 64 + lane] = f2bf(o * silu_f(gt));
}

PH void lru_item(const Params& p, int layer, int b, int n, int dpart) {
  SMEM;
  const int tid = opaque_tid(), lane = tid & 63, w = tid >> 6, quad = lane >> 4, l15 = lane & 15;
  u16* xls = (u16*)smem;
  float* as_ = (float*)(smem + 26624);
  float* bs_ = (float*)(smem + 26624 + 16896);
  float* Pc = (float*)(smem + 60416);
  float* Hc = (float*)(smem + 61440);
  float* hprev = (float*)(smem + 62464);
  const u16* PROJ = (const u16*)(p.ws + WS_PROJ);
  const u16* XL = (const u16*)(p.ws + WS_XL);
  u16* MIX = (u16*)(p.ws + WS_MIX);
  const u16* WA = (const u16*)(p.ws + WS_WA) + (size_t)(layer * 8 + n) * 9216;
  const u16* WX = (const u16*)(p.ws + WS_WX) + (size_t)(layer * 8 + n) * 9216;
  bf16x8 wa[2][3], wx[2][3];
#pragma unroll
  for (int dt = 0; dt < 2; ++dt)
#pragma unroll
    for (int ks = 0; ks < 3; ++ks) {
      const int d = dpart * 32 + dt * 16 + l15, k = ks * 32 + quad * 8;
      wa[dt][ks] = *(const bf16x8*)(WA + d * 96 + k);
      wx[dt][ks] = *(const bf16x8*)(WX + d * 96 + k);
    }
  const int nchunks = (b >= 0) ? 16 : 1;
  const int sch = tid & 31, sub = tid >> 5;
  const int chg = n * 96 + dpart * 32 + sch;
  const float ba = p.in[14][layer * 768 + chg], bx = p.in[16][layer * 768 + chg];
  const float cl = -8.f * softplus_f(-p.in[17][layer * 768 + chg]);
  u32x4 pxl[6];
  u16 pgt[16];
  {
    const int nb_ = (b >= 0) ? (b * 2048) : MP;
#pragma unroll
    for (int i = 0; i < 6; ++i) {
      const int idx = tid + 256 * i, r = idx / 12, c16 = idx % 12;
      pxl[i] = *(const u32x4*)(XL + (size_t)(nb_ + r) * 768 + n * 96 + c16 * 8);
    }
#pragma unroll
    for (int t = 0; t < 16; ++t) pgt[t] = PROJ[(size_t)(nb_ + sub * 16 + t) * NPAD + C_GL + chg];
  }
#pragma unroll 1
  for (int c = 0; c < nchunks; ++c) {
    const int base = (b >= 0) ? (b * 2048 + c * 128) : MP;
    __syncthreads();
#pragma unroll
    for (int i = 0; i < 6; ++i) {
      const int idx = tid + 256 * i, r = idx / 12, c16 = idx % 12;
      *(u32x4*)(xls + r * 104 + c16 * 8) = pxl[i];
    }
    u16 gcur[16];
#pragma unroll
    for (int t = 0; t < 16; ++t) gcur[t] = pgt[t];
    {
      const int nb_ = (c + 1 < nchunks) ? (base + 128) : base;
#pragma unroll
      for (int i = 0; i < 6; ++i) {
        const int idx = tid + 256 * i, r = idx / 12, c16 = idx % 12;
        pxl[i] = *(const u32x4*)(XL + (size_t)(nb_ + r) * 768 + n * 96 + c16 * 8);
      }
#pragma unroll
      for (int t = 0; t < 16; ++t) pgt[t] = PROJ[(size_t)(nb_ + sub * 16 + t) * NPAD + C_GL + chg];
    }
    __syncthreads();
    {
      f32x4 ra[2][2], rx[2][2];
#pragma unroll
      for (int dt = 0; dt < 2; ++dt)
#pragma unroll
        for (int tt = 0; tt < 2; ++tt) { ra[dt][tt] = (f32x4){0.f, 0.f, 0.f, 0.f}; rx[dt][tt] = (f32x4){0.f, 0.f, 0.f, 0.f}; }
#pragma unroll
      for (int ks = 0; ks < 3; ++ks)
#pragma unroll
        for (int tt = 0; tt < 2; ++tt) {
          const bf16x8 xf = ldfrag(xls, 104, (2 * w + tt) * 16, ks * 32, lane);
#pragma unroll
          for (int dt = 0; dt < 2; ++dt) {
            ra[dt][tt] = mfma16(wa[dt][ks], xf, ra[dt][tt]);
            rx[dt][tt] = mfma16(wx[dt][ks], xf, rx[dt][tt]);
          }
        }
#pragma unroll
      for (int dt = 0; dt < 2; ++dt)
#pragma unroll
        for (int tt = 0; tt < 2; ++tt)
#pragma unroll
          for (int r = 0; r < 4; ++r) {
            const int tok = (2 * w + tt) * 16 + l15, dl = dt * 16 + quad * 4 + r;
            as_[tok * 33 + dl] = ra[dt][tt][r];
            bs_[tok * 33 + dl] = rx[dt][tt][r];
          }
    }
    __syncthreads();
    float P = 1.f, H = 0.f;
#pragma unroll
    for (int t = 0; t < 16; ++t) {
      const int tok = sub * 16 + t;
      const float rg = sigmoid_f(as_[tok * 33 + sch] + ba);
      const float ig = sigmoid_f(bs_[tok * 33 + sch] + bx);
      const float la = cl * rg;
      const float xv = bf2f(xls[tok * 104 + dpart * 32 + sch]);
      const float a = __expf(la);
      const float bb = __builtin_amdgcn_sqrtf(-expm1f(2.f * la)) * ig * xv;
      as_[tok * 33 + sch] = a;
      bs_[tok * 33 + sch] = bb;
      H = a * H + bb; P *= a;
    }
    if (b >= 0) {
      Pc[sub * 32 + sch] = P; Hc[sub * 32 + sch] = H;
      __syncthreads();
      float carry = (c == 0) ? 0.f : hprev[sch];
#pragma unroll
      for (int s = 0; s < 8; ++s) if (s < sub) carry = Pc[s * 32 + sch] * carry + Hc[s * 32 + sch];
      float hh = carry;
#pragma unroll
      for (int t = 0; t < 16; ++t) {
        const int tok = sub * 16 + t;
        const float a = as_[tok * 33 + sch], bb = bs_[tok * 33 + sch];
        hh = a * hh + bb;
        const size_t row = (size_t)(base + tok);
        const float g = bf2f(gcur[t]);
        MIX[row * 2048 + 512 + chg] = f2bf(hh * silu_f(g));
      }
      __syncthreads();
      if (sub == 7) {
        hprev[sch] = hh;
        if (c == 15) p.out[O_PLH + (size_t)(layer * 8 + b) * 768 + chg] = hh;
      }
    } else {
#pragma unroll
      for (int t = 0; t < 16; ++t) {
        const int tok = sub * 16 + t;
        const float a = as_[tok * 33 + sch], bb = bs_[tok * 33 + sch];
        const float h0 = p.in[5][(size_t)(layer * 128 + tok) * 768 + chg];
        const float hh = a * h0 + bb;
        const size_t row = (size_t)(MP + tok);
        const float g = bf2f(gcur[t]);
        MIX[row * 2048 + 512 + chg] = f2bf(hh * silu_f(g));
        p.out[O_SLH + (size_t)(layer * 128 + tok) * 768 + chg] = hh;
      }
    }
  }
}

constexpr int NSEG = 3;
template <int PROBE, int SONLY, int CPS>
DI void ssd_chunk_loop(const Params& p, int layer, int b, int e, int c0, f32x4 (&h)[8], float& dtot, bool write_final) {
  SMEM;
  const int tid = opaque_tid(), lane = tid & 63, w = tid >> 6, quad = lane >> 4, l15 = lane & 15;
  const int g = e / 6;
  u16* Cs = (u16*)smem;
  u16* Bs = (u16*)(smem + 17408);
  u16* Bt2 = (u16*)(smem + 34816);
  u16* Xt = (u16*)(smem + 53248);
  u16* Ms = (u16*)(smem + 62464);
  float* dt_s = (float*)(smem + 71680);
  float* acs_s = dt_s + 64;
  float* ssq_s = acs_s + 64;
  const u16* PROJ = (const u16*)(p.ws + WS_PROJ);
  const u16* XBC = (const u16*)(p.ws + WS_XBC);
  u16* MIX = (u16*)(p.ws + WS_MIX);
  float* SSQ = (float*)(p.ws + WS_SSQ);
  const float dtb = p.in[20][layer * 12 + e];
  const float ah = -__expf(p.in[21][layer * 12 + e]);
  const float Dv = p.in[22][layer * 12 + e];
  const bool do_store = !(PROBE & 1) || (dtb == 1234.5f);
  u32x4 pc[4], pb[4], px[2];
  u16 pru;
  {
    const int nb_ = b * 2048 + c0 * 64;
#pragma unroll
    for (int i = 0; i < 4; ++i) {
      const int idx = tid + 256 * i, r = idx >> 4, c16 = idx & 15;
      if (!SONLY) pc[i] = *(const u32x4*)(XBC + (size_t)(nb_ + r) * 1280 + 1024 + g * 128 + c16 * 8);
      pb[i] = *(const u32x4*)(XBC + (size_t)(nb_ + r) * 1280 + 768 + g * 128 + c16 * 8);
    }
#pragma unroll
    for (int i = 0; i < 2; ++i) {
      const int idx = tid + 256 * i, r = idx >> 3, c8 = idx & 7;
      px[i] = *(const u32x4*)(XBC + (size_t)(nb_ + r) * 1280 + e * 64 + c8 * 8);
    }
    pru = PROJ[(size_t)(nb_ + lane) * NPAD + C_DT + e];
  }
#pragma unroll 1
  for (int cc = c0; cc < c0 + CPS; ++cc) {
    const int base = b * 2048 + cc * 64;
#pragma unroll
    for (int i = 0; i < 4; ++i) {
      const int idx = tid + 256 * i, r = idx >> 4, c16 = idx & 15;
      if (!SONLY) *(u32x4*)(Cs + r * 136 + c16 * 8) = pc[i];
      *(u32x4*)(Bs + r * 136 + c16 * 8) = pb[i];
    }
    u32x4 xr[2];
    xr[0] = px[0]; xr[1] = px[1];
    if (w == 0) {
      const float dtv = softplus_f(bf2f(pru) + dtb);
      float a = dtv * ah;
#pragma unroll
      for (int d = 1; d < 64; d <<= 1) { const float t = __shfl_up(a, d); if (lane >= d) a += t; }
      dt_s[lane] = dtv; acs_s[lane] = a;
    }
    {
      const int nb_ = b * 2048 + ((cc + 1 < c0 + CPS) ? (cc + 1) : cc) * 64;
#pragma unroll
      for (int i = 0; i < 4; ++i) {
        const int idx = tid + 256 * i, r = idx >> 4, c16 = idx & 15;
        if (!SONLY) pc[i] = *(const u32x4*)(XBC + (size_t)(nb_ + r) * 1280 + 1024 + g * 128 + c16 * 8);
        pb[i] = *(const u32x4*)(XBC + (size_t)(nb_ + r) * 1280 + 768 + g * 128 + c16 * 8);
      }
#pragma unroll
      for (int i = 0; i < 2; ++i) {
        const int idx = tid + 256 * i, r = idx >> 3, c8 = idx & 7;
        px[i] = *(const u32x4*)(XBC + (size_t)(nb_ + r) * 1280 + e * 64 + c8 * 8);
      }
      pru = PROJ[(size_t)(nb_ + lane) * NPAD + C_DT + e];
    }
    uint2 dx[4], dz[4];
    if (!SONLY)
#pragma unroll
    for (int qt = 0; qt < 4; ++qt) {
      const size_t row = (size_t)(base + qt * 16 + l15);
      const int pcol = w * 16 + quad * 4;
      dx[qt] = *(const uint2*)(XBC + row * 1280 + e * 64 + pcol);
      dz[qt] = *(const uint2*)(PROJ + row * NPAD + C_Z + e * 64 + pcol);
    }
    __syncthreads();
    dtot += acs_s[63];
    if (!(PROBE & 2)) {
#pragma unroll
    for (int i = 0; i < 2; ++i) {
      const int idx = tid + 256 * i, r = idx >> 3, c8 = idx & 7;
      const float dtv = dt_s[r];
      float f[8]; unpack8v(xr[i], f);
#pragma unroll
      for (int j = 0; j < 8; ++j) Xt[(c8 * 8 + j) * 72 + r] = f2bf(f[j] * dtv);
    }
    {
      const int q = tid & 63, ng = tid >> 6;
      const float dte = __expf(acs_s[63] - acs_s[q]);
#pragma unroll
      for (int i = 0; i < 8; ++i) {
        const uint2 v = *(const uint2*)(Bs + q * 136 + ng * 32 + i * 4);
        Bt2[(ng * 32 + i * 4 + 0) * 72 + q] = f2bf(bflo(v.x) * dte);
        Bt2[(ng * 32 + i * 4 + 1) * 72 + q] = f2bf(bfhi(v.x) * dte);
        Bt2[(ng * 32 + i * 4 + 2) * 72 + q] = f2bf(bflo(v.y) * dte);
        Bt2[(ng * 32 + i * 4 + 3) * 72 + q] = f2bf(bfhi(v.y) * dte);
      }
    }
    }
    __syncthreads();
    if (!(PROBE & 4) && !SONLY) {
      const int q = w * 16 + l15;
      const float aq = acs_s[q];
      bf16x8 cfr[4];
#pragma unroll
      for (int ks = 0; ks < 4; ++ks) cfr[ks] = ldfrag(Cs, 136, w * 16, ks * 32, lane);
#pragma unroll
      for (int st = 0; st < 4; ++st) {
        uint2 ov;
        const int s0 = st * 16 + quad * 4;
        {
          f32x4 acc = (f32x4){0.f, 0.f, 0.f, 0.f};
#pragma unroll
          for (int ks = 0; ks < 4; ++ks) acc = mfma16(ldfrag(Bs, 136, st * 16, ks * 32, lane), cfr[ks], acc);
          float v[4];
#pragma unroll
          for (int r = 0; r < 4; ++r) { const int s = s0 + r; v[r] = (s <= q) ? acc[r] * __expf(fminf(aq - acs_s[s], 0.f)) : 0.f; }
          ov.x = pack2(v[0], v[1]); ov.y = pack2(v[2], v[3]);
        }
        *(uint2*)(Ms + q * 72 + s0) = ov;
      }
    }
    f32x4 y[4];
#pragma unroll
    for (int qt = 0; qt < 4; ++qt) y[qt] = (f32x4){0.f, 0.f, 0.f, 0.f};
    if (!(PROBE & 4) && !SONLY)
#pragma unroll
    for (int kk = 0; kk < 4; ++kk) {
      const bf16x8 hf = packfrag(h[2 * kk], h[2 * kk + 1]);
#pragma unroll
      for (int qt = 0; qt < 4; ++qt) y[qt] = mfma16(hf, ldfrag_perm(Cs, 136, qt * 16, kk * 32, lane), y[qt]);
    }
    if (!SONLY) {
#pragma unroll
    for (int qt = 0; qt < 4; ++qt) y[qt] *= __expf(acs_s[qt * 16 + l15]);
    __syncthreads();
    }
    if (!(PROBE & 8) && !SONLY)
#pragma unroll
    for (int qt = 0; qt < 4; ++qt)
#pragma unroll
      for (int ks = 0; ks < 2; ++ks)
        if (ks == 0 || qt >= 2) y[qt] = mfma16(ldfrag(Xt, 72, w * 16, ks * 32, lane), ldfrag(Ms, 72, qt * 16, ks * 32, lane), y[qt]);
    if (!(PROBE & 8)) {
      const float cd = __expf(acs_s[63]);
#pragma unroll
      for (int nt = 0; nt < 8; ++nt) h[nt] *= cd;
#pragma unroll
      for (int ks = 0; ks < 2; ++ks) {
        const bf16x8 xf = ldfrag(Xt, 72, w * 16, ks * 32, lane);
#pragma unroll
        for (int nt = 0; nt < 8; ++nt) h[nt] = mfma16(ldfrag(Bt2, 72, nt * 16, ks * 32, lane), xf, h[nt]);
      }
    }
    if (!SONLY)
#pragma unroll
    for (int qt = 0; qt < 4; ++qt) {
      const int q = qt * 16 + l15;
      const size_t row = (size_t)(base + q);
      const int pcol = w * 16 + quad * 4;
      const uint2 xv = dx[qt];
      const uint2 zv = dz[qt];
      const float y0 = (y[qt][0] + Dv * bflo(xv.x)) * silu_f(bflo(zv.x));
      const float y1 = (y[qt][1] + Dv * bfhi(xv.x)) * silu_f(bfhi(zv.x));
      const float y2 = (y[qt][2] + Dv * bflo(xv.y)) * silu_f(bflo(zv.y));
      const float y3 = (y[qt][3] + Dv * bfhi(xv.y)) * silu_f(bfhi(zv.y));
      uint2 ov; ov.x = pack2(y0, y1); ov.y = pack2(y2, y3);
      if (do_store) *(uint2*)(MIX + row * 2048 + 1280 + e * 64 + pcol) = ov;
      float ss = y0 * y0 + y1 * y1 + y2 * y2 + y3 * y3;
      ss += __shfl_xor(ss, 16);
      ss += __shfl_xor(ss, 32);
      if (quad == 0) ssq_s[w * 64 + q] = ss;
    }
    __syncthreads();
    if (do_store && !SONLY) if (tid < 64) SSQ[(size_t)(base + tid) * 12 + e] = ssq_s[tid] + ssq_s[64 + tid] + ssq_s[128 + tid] + ssq_s[192 + tid];
  }
  if (do_store && write_final) {
    float* oh = p.out + O_PSH + (size_t)((layer * 8 + b) * 12 + e) * 64 * 128;
    const int pidx = w * 16 + l15;
#pragma unroll
    for (int nt = 0; nt < 8; ++nt) {
      const int n = nt * 16 + quad * 4;
      *(float4*)(oh + (size_t)pidx * 128 + n) = make_float4(h[nt][0], h[nt][1], h[nt][2], h[nt][3]);
    }
  }
}


DI unsigned flag_ld(unsigned* f) { return __hip_atomic_load(f, __ATOMIC_RELAXED, __HIP_MEMORY_SCOPE_AGENT); }
template <int PROBE>
PH void ssd_prompt_item(const Params& p, int layer, int b, int e, int seg) {
  const int tid = opaque_tid(), lane = tid & 63, w = tid >> 6, quad = lane >> 4, l15 = lane & 15;
  float* SEND = (float*)(p.ws + WS_SEND) + (size_t)((layer * 96 + b * 12 + e) * NSEG) * 8192;
  unsigned* SFLAG = (unsigned*)(p.ws + WS_SFLAG) + (layer * 96 + b * 12 + e) * NSEG;
  f32x4 h[8];
#pragma unroll
  for (int i = 0; i < 8; ++i) h[i] = (f32x4){0.f, 0.f, 0.f, 0.f};
  float dtot = 0.f;
  const size_t eoff = (size_t)(w * 16 + l15) * 128 + quad * 4;
  if (seg < NSEG - 1) ssd_chunk_loop<PROBE, 1, 10>(p, layer, b, e, seg * 10, h, dtot, false);
  if (seg > 0) {
    if (tid == 0) {
      unsigned sp = 0;
      while (flag_ld(SFLAG + seg - 1) == 0u) { __builtin_amdgcn_s_sleep(2); if (++sp > (1u << 22)) break; }
    }
    __syncthreads();
    __builtin_amdgcn_fence(__ATOMIC_ACQUIRE, "agent");
    asm volatile("s_waitcnt vmcnt(0)" ::: "memory");
    const float* hin = SEND + (size_t)(seg - 1) * 8192 + eoff;
    const float fdec = __expf(dtot);
#pragma unroll
    for (int nt = 0; nt < 8; ++nt) {
      const float4 v = *(const float4*)(hin + nt * 16);
      const f32x4 hv = (f32x4){v.x, v.y, v.z, v.w};
      if (seg < NSEG - 1) {
        const f32x4 he = fdec * hv + h[nt];
        *(float4*)(SEND + (size_t)seg * 8192 + eoff + nt * 16) = make_float4(he[0], he[1], he[2], he[3]);
      }
      h[nt] = hv;
    }
  } else {
#pragma unroll
    for (int nt = 0; nt < 8; ++nt) {
      *(float4*)(SEND + eoff + nt * 16) = make_float4(h[nt][0], h[nt][1], h[nt][2], h[nt][3]);
      h[nt] = (f32x4){0.f, 0.f, 0.f, 0.f};
    }
  }
  if (seg < NSEG - 1) {
    __builtin_amdgcn_fence(__ATOMIC_RELEASE, "agent");
    asm volatile("s_waitcnt vmcnt(0)" ::: "memory");
    __syncthreads();
    if (tid == 0) __hip_atomic_store(SFLAG + seg, 1u, __ATOMIC_RELAXED, __HIP_MEMORY_SCOPE_AGENT);
  }
  float dummy = 0.f;
  if (seg < NSEG - 1) ssd_chunk_loop<PROBE, 0, 10>(p, layer, b, e, seg * 10, h, dummy, false);
  else ssd_chunk_loop<PROBE, 0, 12>(p, layer, b, e, 20, h, dummy, true);
}

PH void ssd_decode_item(const Params& p, int layer, int b, int e) {
  SMEM;
  const int tid = opaque_tid();
  const int g = e / 6;
  float* xs_s = (float*)smem;
  float* Bv = xs_s + 64;
  float* Cv = Bv + 128;
  float* ys = Cv + 128;
  const u16* PROJ = (const u16*)(p.ws + WS_PROJ);
  const u16* XBC = (const u16*)(p.ws + WS_XBC);
  u16* MIX = (u16*)(p.ws + WS_MIX);
  float* SSQ = (float*)(p.ws + WS_SSQ);
  const size_t row = (size_t)(MP + b);
  const float* h0 = p.in[7] + (size_t)((layer * 128 + b) * 12 + e) * 64 * 128;
  float* h1 = p.out + O_SSH + (size_t)((layer * 128 + b) * 12 + e) * 64 * 128;
  const int n4 = tid & 31;
  f32x4 hv[8];
  u16 zv[8];
#pragma unroll
  for (int i = 0; i < 8; ++i) {
    const int pidx = (tid >> 5) + 8 * i;
    hv[i] = *(const f32x4*)(h0 + (size_t)pidx * 128 + n4 * 4);
    zv[i] = PROJ[row * NPAD + C_Z + e * 64 + pidx];
  }
  const u16 xsr = XBC[row * 1280 + e * 64 + (tid & 63)];
  const u16 bvr = XBC[row * 1280 + 768 + g * 128 + (tid & 127)];
  const u16 cvr = XBC[row * 1280 + 1024 + g * 128 + (tid & 127)];
  const float dtv = softplus_f(bf2f(PROJ[row * NPAD + C_DT + e]) + p.in[20][layer * 12 + e]);
  const float dA = __expf(dtv * (-__expf(p.in[21][layer * 12 + e])));
  const float Dv = p.in[22][layer * 12 + e];
  if (tid < 64) xs_s[tid] = bf2f(xsr);
  if (tid < 128) { Bv[tid] = bf2f(bvr); Cv[tid] = bf2f(cvr); }
  __syncthreads();
  const float4 Bq = *(const float4*)(Bv + n4 * 4), Cq = *(const float4*)(Cv + n4 * 4);
#pragma unroll
  for (int i = 0; i < 8; ++i) {
    const int pidx = (tid >> 5) + 8 * i;
    const float xsv = xs_s[pidx];
    const float xdt = dtv * xsv;
    f32x4 hn;
    hn[0] = dA * hv[i][0] + xdt * Bq.x; hn[1] = dA * hv[i][1] + xdt * Bq.y; hn[2] = dA * hv[i][2] + xdt * Bq.z; hn[3] = dA * hv[i][3] + xdt * Bq.w;
    *(f32x4*)(h1 + (size_t)pidx * 128 + n4 * 4) = hn;
    float part = Cq.x * hn[0] + Cq.y * hn[1] + Cq.z * hn[2] + Cq.w * hn[3];
#pragma unroll
    for (int d = 1; d < 32; d <<= 1) part += __shfl_xor(part, d);
    if (n4 == 0) ys[pidx] = (part + Dv * xsv) * silu_f(bf2f(zv[i]));
  }
  __syncthreads();
  if (tid < 64) {
    const float v = ys[tid];
    MIX[row * 2048 + 1280 + e * 64 + tid] = f2bf(v);
    float ss = v * v;
#pragma unroll
    for (int d = 1; d < 64; d <<= 1) ss += __shfl_xor(ss, d);
    if (tid == 0) SSQ[row * 12 + e] = ss;
  }
}

#define XB_TMO      128
#define XB_XCNT(j)  (256  + 64 * (j))
#define XB_XSUB(j)  (1280 + 64 * (j))
#define XB_XGEN(j)  (2304 + 64 * (j))
#define XB_TOP      3328
#define XB_TOPGEN   3392
#define XCD_BAR_WORDS 3456
#define XB_SPIN_CAP (1u << 18)
#define LAS __attribute__((address_space(3)))
DI unsigned xb_ld(unsigned* p)              { return __hip_atomic_load(p, __ATOMIC_RELAXED, __HIP_MEMORY_SCOPE_AGENT); }
DI unsigned xb_add(unsigned* p, unsigned v) { return __hip_atomic_fetch_add(p, v, __ATOMIC_RELAXED, __HIP_MEMORY_SCOPE_AGENT); }
DI unsigned xb_xcc_id() { return (unsigned)__builtin_amdgcn_s_getreg((3 << 11) | 20) & 0xFu; }
#define XB_SPIN(cond, bar) do { unsigned _sp = 0; while (cond) { __builtin_amdgcn_s_sleep(1); \
    if ((++_sp & 255u) == 0u) { if (xb_ld(&(bar)[XB_TMO])) break; if (_sp > XB_SPIN_CAP) { atomicAdd(&(bar)[XB_TMO], 1u); break; } } } } while (0)
struct XcdBarrier { unsigned* bar; unsigned x; volatile LAS unsigned* st; };
DI XcdBarrier xcd_barrier_post(unsigned* bar, volatile LAS unsigned* st) {
  XcdBarrier b; b.bar = bar; b.x = xb_xcc_id(); b.st = st;
  if (threadIdx.x == 0) (void)xb_add(&bar[XB_XCNT(b.x)], 1u);
  return b;
}
DI void xcd_barrier_complete(unsigned* bar, unsigned x, unsigned& nloc, unsigned& nx) {
  const unsigned G = gridDim.x * gridDim.y * gridDim.z;
  unsigned sum, cnt, mine, sp = 0u;
  for (;;) {
    sum = 0u; cnt = 0u; mine = 0u;
#pragma unroll
    for (unsigned j = 0; j < 16; ++j) { const unsigned c = xb_ld(&bar[XB_XCNT(j)]); sum += c; cnt += (c > 0u) ? 1u : 0u; mine = (j == x) ? c : mine; }
    if (sum == G) break;
    __builtin_amdgcn_s_sleep(1);
    if ((++sp & 255u) == 0u) { if (xb_ld(&bar[XB_TMO])) break; if (sp > XB_SPIN_CAP) { atomicAdd(&bar[XB_TMO], 1u); break; } }
  }
  nloc = mine > 0u ? mine : 1u; nx = cnt > 0u ? cnt : 1u;
}
DI void xcd_barrier(const XcdBarrier& b) {
  asm volatile("s_waitcnt vmcnt(0)" ::: "memory");
  __syncthreads();
  if (threadIdx.x == 0) {
    unsigned* bar = b.bar;
    __builtin_amdgcn_s_waitcnt(0);
    unsigned nloc = b.st[0], nx = b.st[1];
    if (nloc == 0u) { xcd_barrier_complete(bar, b.x, nloc, nx); b.st[0] = nloc; b.st[1] = nx; }
    const unsigned old = xb_add(&bar[XB_XSUB(b.x)], 1u);
    const unsigned gen = old / nloc;
    if (old + 1u == (gen + 1u) * nloc) {
      __builtin_amdgcn_fence(__ATOMIC_RELEASE, "agent");
      asm volatile("s_waitcnt vmcnt(0)" ::: "memory");
      const unsigned og = xb_add(&bar[XB_TOP], 1u);
      const unsigned tg = og / nx;
      if (og + 1u == (tg + 1u) * nx) xb_add(&bar[XB_TOPGEN], 1u);
      else XB_SPIN(xb_ld(&bar[XB_TOPGEN]) == tg, bar);
      __builtin_amdgcn_fence(__ATOMIC_ACQUIRE, "agent");
      xb_add(&bar[XB_XGEN(b.x)], 1u);
      asm volatile("s_waitcnt vmcnt(0)" ::: "memory");
    } else {
      XB_SPIN(xb_ld(&bar[XB_XGEN(b.x)]) == gen, bar);
      __builtin_amdgcn_fence(__ATOMIC_ACQUIRE, "agent");
      asm volatile("s_waitcnt vmcnt(0)" ::: "memory");
    }
  }
  __syncthreads();
}

#define REP_PREP 1
#define REP_G0 1
#define REP_2A 1
#define REP_2B 1
#define REP_G1 1
#define REP_LN 1
#define REP_SYNC 0
#define PROBE_SSD 0
#define PROBE_2B_LO 0
#define PROBE_2B_HI 96
__global__ void __launch_bounds__(256, 2) mega(Params p) {
  __shared__ int slot;
  __shared__ uint4 xb_words;
  cg::grid_group grid = cg::this_grid();
  unsigned* ctr = (unsigned*)(p.ws + WS_CTR);
  if (threadIdx.x == 0) xb_words = make_uint4(0u, 0u, 0u, 0u);
  __syncthreads();
  XcdBarrier xb = xcd_barrier_post((unsigned*)(p.ws + WS_BAR), (volatile LAS unsigned*)&xb_words);
  if (p.ws == nullptr) grid.sync();
  for (int rep = 0; rep < REP_PREP; ++rep) { phase_prep(p); xcd_barrier(xb); }
#pragma unroll 1
  for (int layer = 0; layer < 4; ++layer) {
    for (int rep = 0; rep < REP_G0; ++rep) { gemm_phase<0>(p, layer); xcd_barrier(xb); }
    for (int rep = 0; rep < REP_2A; ++rep) {
      for (;;) {
        int it = next_item(ctr + layer * 2 + 8 * rep, &slot);
        if (it >= 136 + 512) break;
        it = (it < 512) ? (it + 136) : (it - 512);
        if (it < 136) conv_unit(p, layer, it);
        else if (it < 392) attn_prompt_item(p, layer, it - 136);
        else attn_decode_item(p, layer, it - 392);
      }
      xcd_barrier(xb);
    }
    for (int rep = 0; rep < REP_2B; ++rep) {
      for (;;) {
        int it = next_item(ctr + layer * 2 + 1 + 8 * rep, &slot);
        if (rep > 0) { it += PROBE_2B_LO; if (it >= PROBE_2B_HI) break; }
        if (it >= 288 + 192 + 24 + 1536) break;
        it = (it < 192) ? (it + 384) : ((it < 480) ? (it - 192) : (it + 608));
        if (it < 384) { const int v = it % 96; ssd_prompt_item<0>(p, layer, v / 12, v % 12, it / 96); }
        else if (it < 576) { const int v = it - 384; lru_item(p, layer, v / 24, (v % 24) / 3, v % 3); }
        else if (it < 832) attn_prompt_item(p, layer, it - 576);
        else if (it < 1088) attn_decode_item(p, layer, it - 832);
        else if (it < 1112) { const int v = it - 1088; lru_item(p, layer, -1, v / 3, v % 3); }
        else { const int v = it - 1112; ssd_decode_item(p, layer, v / 12, v % 12); }
      }
      xcd_barrier(xb);
    }
    for (int rep = 0; rep < REP_G1; ++rep) { gemm_phase<1>(p, layer); xcd_barrier(xb); }
    for (int rep = 0; rep < REP_LN; ++rep) { ln_phase(p, layer); xcd_barrier(xb); }
    for (int rep = 0; rep < REP_SYNC; ++rep) xcd_barrier(xb);
  }
}

extern "C" void kernel_launch(void* const* d_in, const int* in_sizes, int n_in,
                              void* d_out, int out_size, void* d_ws, size_t ws_size,
                              hipStream_t stream) {
  static int grid_blocks = 0;
  if (grid_blocks == 0) {
    if (n_in != 26 || ws_size < WS_END) { fprintf(stderr, "kernel_launch: unexpected n_in %d or ws_size %zu (< %zu)\n", n_in, ws_size, (size_t)WS_END); grid_blocks = -1; return; }
    int dev = 0, cus = 0, per_cu = 0;
    hipGetDevice(&dev);
    hipDeviceGetAttribute(&cus, hipDeviceAttributeMultiprocessorCount, dev);
    if (hipFuncSetAttribute((const void*)mega, hipFuncAttributeMaxDynamicSharedMemorySize, LDS_BYTES) != hipSuccess) { fprintf(stderr, "kernel_launch: hipFuncSetAttribute failed\n"); grid_blocks = -1; return; }
    if (hipOccupancyMaxActiveBlocksPerMultiprocessor(&per_cu, (const void*)mega, 256, LDS_BYTES) != hipSuccess || per_cu < 1) { fprintf(stderr, "kernel_launch: occupancy query failed (%d)\n", per_cu); grid_blocks = -1; return; }
    if (per_cu > 2) per_cu = 2;
    grid_blocks = cus * per_cu;
  }
  if (grid_blocks < 0) return;
  Params p{};
  for (int i = 0; i < 26; ++i) p.in[i] = (const float*)d_in[i];
  p.out = (float*)d_out;
  p.ws = (char*)d_ws;
  if (hipMemsetAsync((char*)d_ws + WS_BAR, 0, 16384, stream) != hipSuccess) { fprintf(stderr, "kernel_launch: memset of barrier words failed\n"); return; }
  void* args[] = {&p};
  hipError_t e = hipLaunchCooperativeKernel((const void*)mega, dim3(grid_blocks), dim3(256), args, LDS_BYTES, stream);
  if (e != hipSuccess) fprintf(stderr, "cooperative launch failed: %s (grid %d)\n", hipGetErrorString(e), grid_blocks);
}
```

```cpp
#include <hip/hip_runtime.h>
#include <hip/hip_cooperative_groups.h>
#include <cstdio>
namespace cg = cooperative_groups;

#define DI __device__ __forceinline__
#define PH __device__ __forceinline__
#define SMEM extern __shared__ __attribute__((aligned(16))) char smem[]
typedef unsigned short u16;
using bf16x8 = __attribute__((ext_vector_type(8))) short;
using f32x4 = __attribute__((ext_vector_type(4))) float;
using u32x4 = __attribute__((ext_vector_type(4))) unsigned;

constexpr int MP = 16384, MT = 16512;
constexpr int NPAD = 4992;
constexpr int C_K = 512, C_V = 640, C_GA = 768, C_XL = 1280, C_GL = 2048, C_Z = 2816, C_XBC = 3584, C_DT = 4864;
constexpr int LDS_BYTES = 73728;

constexpr size_t WS_WIN = 0;
constexpr size_t WS_WOUT = WS_WIN + (size_t)4 * NPAD * 1024 * 2;
constexpr size_t WS_WA = WS_WOUT + (size_t)4 * 1024 * 2048 * 2;
constexpr size_t WS_WX = WS_WA + (size_t)4 * 8 * 96 * 96 * 2;
constexpr size_t WS_XB = WS_WX + (size_t)4 * 8 * 96 * 96 * 2;
constexpr size_t WS_XF = WS_XB + (size_t)MT * 1024 * 2;
constexpr size_t WS_PRE = WS_XF + (size_t)MT * 1024 * 4;
constexpr size_t WS_PROJ = WS_PRE + (size_t)MT * 1024 * 4;
constexpr size_t WS_XL = WS_PROJ + (size_t)MT * NPAD * 2;
constexpr size_t WS_XBC = WS_XL + (size_t)MT * 768 * 2;
constexpr size_t WS_MIX = WS_XBC + (size_t)MT * 1280 * 2;
constexpr size_t WS_SSQ = WS_MIX + (size_t)MT * 2048 * 2;
constexpr size_t WS_ROPE = WS_SSQ + (size_t)MT * 12 * 4;
constexpr size_t WS_CTR = WS_ROPE + 131328;
constexpr size_t WS_SFLAG = WS_CTR + 256;
constexpr size_t WS_SEND = WS_SFLAG + 8192;
constexpr size_t WS_BAR = WS_SEND + (size_t)4 * 96 * 4 * 8192 * 4;
constexpr size_t WS_END = WS_BAR + 16384;

constexpr size_t O_YP = 0;
constexpr size_t O_YS = O_YP + (size_t)8 * 2048 * 1024;
constexpr size_t O_PK = O_YS + (size_t)128 * 1024;
constexpr size_t O_PV = O_PK + (size_t)4 * 8 * 128 * 2 * 64;
constexpr size_t O_PLC = O_PV + (size_t)4 * 8 * 128 * 2 * 64;
constexpr size_t O_PLH = O_PLC + (size_t)4 * 8 * 3 * 768;
constexpr size_t O_PSC = O_PLH + (size_t)4 * 8 * 768;
constexpr size_t O_PSH = O_PSC + (size_t)4 * 8 * 3 * 1280;
constexpr size_t O_SK = O_PSH + (size_t)4 * 8 * 12 * 64 * 128;
constexpr size_t O_SV = O_SK + (size_t)4 * 128 * 128 * 2 * 64;
constexpr size_t O_SLC = O_SV + (size_t)4 * 128 * 128 * 2 * 64;
constexpr size_t O_SLH = O_SLC + (size_t)4 * 128 * 3 * 768;
constexpr size_t O_SSC = O_SLH + (size_t)4 * 128 * 768;
constexpr size_t O_SSH = O_SSC + (size_t)4 * 128 * 3 * 1280;

struct Params {
  const float* in[26];
  float* out;
  char* ws;
};

typedef __bf16 bf2_t __attribute__((ext_vector_type(2)));
typedef float fl2_t __attribute__((ext_vector_type(2)));
DI u16 f2bf(float x) { return __builtin_bit_cast(u16, (__bf16)x); }
DI float bf2f(u16 b) { return __uint_as_float(((unsigned)b) << 16); }
DI unsigned pack2(float a, float b) { fl2_t v = {a, b}; return __builtin_bit_cast(unsigned, __builtin_convertvector(v, bf2_t)); }
DI float bflo(unsigned u) { return __uint_as_float(u << 16); }
DI float bfhi(unsigned u) { return __uint_as_float(u & 0xffff0000u); }
DI void unpack8(uint4 v, float* f) {
  f[0] = bflo(v.x); f[1] = bfhi(v.x); f[2] = bflo(v.y); f[3] = bfhi(v.y);
  f[4] = bflo(v.z); f[5] = bfhi(v.z); f[6] = bflo(v.w); f[7] = bfhi(v.w);
}
DI void unpack8v(u32x4 v, float* f) {
  f[0] = bflo(v[0]); f[1] = bfhi(v[0]); f[2] = bflo(v[1]); f[3] = bfhi(v[1]);
  f[4] = bflo(v[2]); f[5] = bfhi(v[2]); f[6] = bflo(v[3]); f[7] = bfhi(v[3]);
}
DI uint4 pack8(const float* f) {
  uint4 v; v.x = pack2(f[0], f[1]); v.y = pack2(f[2], f[3]); v.z = pack2(f[4], f[5]); v.w = pack2(f[6], f[7]); return v;
}
DI f32x4 mfma16(bf16x8 a, bf16x8 b, f32x4 c) { return __builtin_amdgcn_mfma_f32_16x16x32_bf16(a, b, c, 0, 0, 0); }
DI bf16x8 ldfrag(const u16* base, int ld, int row0, int k0, int lane) {
  return *(const bf16x8*)(base + (row0 + (lane & 15)) * ld + k0 + (lane >> 4) * 8);
}
DI bf16x8 ldfrag_perm(const u16* base, int ld, int row0, int k0, int lane) {
  const u16* pp = base + (row0 + (lane & 15)) * ld + k0 + (lane >> 4) * 4;
  uint2 a = *(const uint2*)pp; uint2 b = *(const uint2*)(pp + 16);
  uint4 v; v.x = a.x; v.y = a.y; v.z = b.x; v.w = b.y;
  return __builtin_bit_cast(bf16x8, v);
}
DI bf16x8 packfrag(f32x4 t0, f32x4 t1) {
  uint4 v; v.x = pack2(t0[0], t0[1]); v.y = pack2(t0[2], t0[3]); v.z = pack2(t1[0], t1[1]); v.w = pack2(t1[2], t1[3]);
  return __builtin_bit_cast(bf16x8, v);
}
DI float silu_f(float x) { return x * __builtin_amdgcn_rcpf(1.f + __expf(-x)); }
DI float sigmoid_f(float x) { return __builtin_amdgcn_rcpf(1.f + __expf(-x)); }
DI float softplus_f(float x) { return x > 20.f ? x : log1pf(__expf(x)); }

DI int opaque_tid() { int t = threadIdx.x; asm volatile("" : "+v"(t)); return t; }
DI int next_item(unsigned* ctr, int* slot) {
  __syncthreads();
  if (threadIdx.x == 0) *slot = (int)atomicAdd(ctr, 1u);
  __syncthreads();
  return *slot;
}

PH void phase_prep(const Params& p) {
  SMEM;
  const int tid = opaque_tid();
  float* tile = (float*)smem;
  u16* WinT = (u16*)(p.ws + WS_WIN);
  u16* WoutT = (u16*)(p.ws + WS_WOUT);
  u16* Xb = (u16*)(p.ws + WS_XB);
  float* ROPE = (float*)(p.ws + WS_ROPE);
  unsigned* ctr = (unsigned*)(p.ws + WS_CTR);
  if (blockIdx.x == 0 && tid < 64) ctr[tid] = 0u;
  if (blockIdx.x == 1) { unsigned* sf = (unsigned*)(p.ws + WS_SFLAG); for (int i = tid; i < 2048; i += 256) sf[i] = 0u; }
  constexpr int U_WIN = 4 * 16 * 78;
  constexpr int U_WOUT = 4 * 32 * 16;
  constexpr int U_LW = 64;
  constexpr int U_XB = MT * 1024 / 2048;
  constexpr int U_ROPE = 65;
  constexpr int U_TOT = U_WIN + U_WOUT + U_LW + U_XB + U_ROPE;
  for (int u = blockIdx.x; u < U_TOT; u += gridDim.x) {
    if (u < U_WIN) {
      const int l = u / (16 * 78), r = u % (16 * 78), kt = r / 78, nt = r % 78;
      const float* src = p.in[8] + (size_t)l * 1024 * 4876;
#pragma unroll
      for (int i = 0; i < 16; ++i) {
        const int k = (tid >> 6) + 4 * i, n = nt * 64 + (tid & 63);
        tile[k * 65 + (tid & 63)] = (n < 4876) ? src[(size_t)(kt * 64 + k) * 4876 + n] : 0.f;
      }
      __syncthreads();
      u16* dst = WinT + (size_t)l * NPAD * 1024;
#pragma unroll
      for (int i = 0; i < 8; ++i) {
        const int nn = (tid >> 5) + 8 * i, k = (tid & 31) * 2;
        *(unsigned*)(dst + (size_t)(nt * 64 + nn) * 1024 + kt * 64 + k) = pack2(tile[k * 65 + nn], tile[(k + 1) * 65 + nn]);
      }
      __syncthreads();
    } else if (u < U_WIN + U_WOUT) {
      const int v = u - U_WIN;
      const int l = v / (32 * 16), r = v % (32 * 16), kt = r / 16, nt = r % 16;
      const float* src = p.in[9] + (size_t)l * 2048 * 1024;
      const float* ng = p.in[23] + l * 768;
#pragma unroll
      for (int i = 0; i < 16; ++i) {
        const int k = (tid >> 6) + 4 * i, kg = kt * 64 + k;
        const float sc = (kg >= 1280) ? ng[kg - 1280] : 1.f;
        tile[k * 65 + (tid & 63)] = src[(size_t)kg * 1024 + nt * 64 + (tid & 63)] * sc;
      }
      __syncthreads();
      u16* dst = WoutT + (size_t)l * 1024 * 2048;
#pragma unroll
      for (int i = 0; i < 8; ++i) {
        const int nn = (tid >> 5) + 8 * i, k = (tid & 31) * 2;
        *(unsigned*)(dst + (size_t)(nt * 64 + nn) * 2048 + kt * 64 + k) = pack2(tile[k * 65 + nn], tile[(k + 1) * 65 + nn]);
      }
      __syncthreads();
    } else if (u < U_WIN + U_WOUT + U_LW) {
      const int v = u - U_WIN - U_WOUT;
      const int l = v / 16, rem = v % 16, n = rem / 2, which = rem % 2;
      const float* src = (which ? p.in[15] : p.in[13]) + (size_t)(l * 8 + n) * 9216;
      u16* dst = (u16*)(p.ws + (which ? WS_WX : WS_WA)) + (size_t)(l * 8 + n) * 9216;
      for (int e = tid; e < 9216; e += 256) {
        const int d = e / 96, c = e % 96;
        dst[e] = f2bf(src[c * 96 + d]);
      }
    } else if (u < U_WIN + U_WOUT + U_LW + U_XB) {
      const int v = u - U_WIN - U_WOUT - U_LW;
      const size_t ge = (size_t)v * 2048 + (size_t)tid * 8;
      const float* src = (ge < (size_t)MP * 1024) ? (p.in[0] + ge) : (p.in[1] + (ge - (size_t)MP * 1024));
      const float4 a = *(const float4*)src, b = *(const float4*)(src + 4);
      uint4 o; o.x = pack2(a.x, a.y); o.y = pack2(a.z, a.w); o.z = pack2(b.x, b.y); o.w = pack2(b.z, b.w);
      *(uint4*)(Xb + ge) = o;
    } else {
      const int v = u - U_WIN - U_WOUT - U_LW - U_XB;
      const int e = v * 256 + tid;
      if (e < 2049 * 8) {
        const int pi = e >> 3, i = e & 7;
        const double pos = (pi < 2048) ? (double)pi : 8192.0;
        const double inv = pow(500000.0, -(double)i / 8.0);
        double sn, cs; sincos(pos * inv, &sn, &cs);
        ROPE[e * 2 + 0] = (float)cs; ROPE[e * 2 + 1] = (float)sn;
      }
    }
  }
}

DI void tile_coords(int t, int NTN, int& m0, int& n0) {
  const int panel = t / (8 * NTN), within = t % (8 * NTN);
  int tm, tn;
  if (panel < 16) { tn = within >> 3; tm = panel * 8 + (within & 7); } else { tm = 128; tn = t - 16 * 8 * NTN; }
  m0 = tm * 128; n0 = tn * 128;
}
template <int MODE>
PH void gemm_phase(const Params& p, int layer) {
  SMEM;
  constexpr int K = (MODE == 0) ? 1024 : 2048;
  constexpr int NTN = (MODE == 0) ? 39 : 8;
  constexpr int NK = K / 64;
  constexpr int LOGNK = (MODE == 0) ? 4 : 5;
  const u16* X = (const u16*)(p.ws + (MODE == 0 ? WS_XB : WS_MIX));
  const u16* W = (const u16*)(p.ws + (MODE == 0 ? WS_WIN : WS_WOUT)) + (size_t)layer * (MODE == 0 ? (size_t)NPAD * 1024 : (size_t)1024 * 2048);
  u16* sX = (u16*)smem;
  u16* sW = sX + 2 * 128 * 72;
  const int tid = opaque_tid(), lane = tid & 63, w = tid >> 6, quad = lane >> 4, l15 = lane & 15;
  const int wn = w >> 1, wm = w & 1;
  const int ntiles = 129 * NTN;
  const int G = gridDim.x, bid = blockIdx.x;
  const int off = ((G & 7) == 0) ? ((bid & 7) * (G >> 3) + (bid >> 3)) : bid;
  if (off < ntiles) {
    const int nt_b = (ntiles - off + G - 1) / G;
    const int total = nt_b << LOGNK;
    const int soff = (tid >> 3) * 72 + (tid & 7) * 8;
    const int rowoff = tid >> 3, coloff = (tid & 7) * 8;
    f32x4 acc[4][4];
    u32x4 rx[2][4], rw[2][4];
#define GLOAD(S, g_) { \
      const int gg_ = ((g_) < total) ? (g_) : (total - 1); \
      const int it_ = gg_ >> LOGNK, kt_ = gg_ & (NK - 1); \
      int m0_, n0_; tile_coords(it_ * G + off, NTN, m0_, n0_); \
      const int k0_ = ((MODE == 0) ? kt_ : ((kt_ + 20) & 31)) * 64; \
      const u16* gx_ = X + (size_t)(m0_ + rowoff) * K + coloff + k0_; \
      const u16* gw_ = W + (size_t)(n0_ + rowoff) * K + coloff + k0_; \
      _Pragma("unroll") for (int i = 0; i < 4; ++i) { \
        rx[S][i] = *(const u32x4*)(gx_ + (size_t)i * 32 * K); \
        rw[S][i] = *(const u32x4*)(gw_ + (size_t)i * 32 * K); } }
#define LSTORE(S, buf_) { \
      u16* dX_ = sX + (buf_) * 128 * 72; u16* dW_ = sW + (buf_) * 128 * 72; \
      _Pragma("unroll") for (int i = 0; i < 4; ++i) { \
        *(u32x4*)(dX_ + soff + i * 32 * 72) = rx[S][i]; \
        *(u32x4*)(dW_ + soff + i * 32 * 72) = rw[S][i]; } }
    GLOAD(0, 0); GLOAD(1, 1);
    LSTORE(0, 0);
    __syncthreads();
#pragma unroll 1
    for (int g0 = 0; g0 < total; g0 += 2) {
#pragma unroll
      for (int s = 0; s < 2; ++s) {
        const int g = g0 + s;
        {
          const int kt = g & (NK - 1), it = g >> LOGNK;
          if (kt == 0) {
#pragma unroll
            for (int a = 0; a < 4; ++a)
#pragma unroll
              for (int b = 0; b < 4; ++b) acc[a][b] = (f32x4){0.f, 0.f, 0.f, 0.f};
          }
          if (MODE == 1 && kt == 12) {
            int m0, n0; tile_coords(it * G + off, NTN, m0, n0);
            const float* SSQ = (const float*)(p.ws + WS_SSQ);
#pragma unroll
            for (int mt = 0; mt < 4; ++mt) {
              const int m = m0 + wm * 64 + mt * 16 + l15;
              const float4 s0 = *(const float4*)(SSQ + (size_t)m * 12), s1 = *(const float4*)(SSQ + (size_t)m * 12 + 4), s2 = *(const float4*)(SSQ + (size_t)m * 12 + 8);
              const float ss = s0.x + s0.y + s0.z + s0.w + s1.x + s1.y + s1.z + s1.w + s2.x + s2.y + s2.z + s2.w;
              const float rs = rsqrtf(ss * (1.f / 768.f) + 1e-5f);
#pragma unroll
              for (int nt = 0; nt < 4; ++nt) acc[nt][mt] *= rs;
            }
          }
          const u16* cX = sX + (g & 1) * 128 * 72;
          const u16* cW = sW + (g & 1) * 128 * 72;
          u16* dX = sX + ((g + 1) & 1) * 128 * 72;
          u16* dW = sW + ((g + 1) & 1) * 128 * 72;
#pragma unroll
          for (int ks = 0; ks < 2; ++ks) {
            bf16x8 wf[4], xf[4];
#pragma unroll
            for (int i = 0; i < 4; ++i) {
              wf[i] = ldfrag(cW, 72, wn * 64 + i * 16, ks * 32, lane);
              xf[i] = ldfrag(cX, 72, wm * 64 + i * 16, ks * 32, lane);
            }
            __builtin_amdgcn_sched_barrier(0);
#pragma unroll
            for (int nt = 0; nt < 4; ++nt) {
#pragma unroll
              for (int mt = 0; mt < 4; ++mt) acc[nt][mt] = mfma16(wf[nt], xf[mt], acc[nt][mt]);
              if (ks == 0) *(u32x4*)(dX + soff + nt * 32 * 72) = rx[(s + 1) & 1][nt];
              else         *(u32x4*)(dW + soff + nt * 32 * 72) = rw[(s + 1) & 1][nt];
              __builtin_amdgcn_sched_barrier(0);
            }
            if (ks == 0) { GLOAD(s, g + 2); __builtin_amdgcn_sched_barrier(0); }
          }
          __syncthreads();
          if (kt == NK - 1) {
            int m0, n0; tile_coords(it * G + off, NTN, m0, n0);
            if (MODE == 0) {
              u16* PROJ = (u16*)(p.ws + WS_PROJ);
              u16* eX = sX + (g & 1) * 128 * 72;
              u16* eW = sW + (g & 1) * 128 * 72;
#pragma unroll
              for (int mt = 0; mt < 4; ++mt) {
                const int ml = mt * 16 + l15;
                u16* eb = (wm == 0 ? eX : eW) + ml * 136;
#pragma unroll
                for (int nt = 0; nt < 4; ++nt) {
                  const int nl = wn * 64 + nt * 16 + quad * 4;
                  uint2 o; o.x = pack2(acc[nt][mt][0], acc[nt][mt][1]); o.y = pack2(acc[nt][mt][2], acc[nt][mt][3]);
                  *(uint2*)(eb + nl) = o;
                }
              }
              __syncthreads();
#pragma unroll
              for (int i = 0; i < 8; ++i) {
                const int row = (tid >> 4) + 16 * i, ch = tid & 15;
                const u16* eb = (row < 64 ? eX + row * 136 : eW + (row - 64) * 136) + ch * 8;
                *(u32x4*)(PROJ + (size_t)(m0 + row) * NPAD + n0 + ch * 8) = *(const u32x4*)eb;
              }
              {
                const int tn_ = n0 >> 7;
                const bool is_lru = (tn_ >= 10) && (tn_ < 16), is_ssd = (tn_ >= 28) && (tn_ < 38);
                if ((is_lru || is_ssd) && m0 < MP) {
                  const int o = tid & 15, rbase = (tid >> 4) * 8;
                  const int nch = is_lru ? 768 : 1280;
                  const int chn = (is_lru ? (n0 - C_XL) : (n0 - C_XBC)) + o * 8;
                  const float* cw = (is_lru ? (p.in[11] + layer * 4 * 768) : (p.in[18] + layer * 4 * 1280)) + chn;
                  const float* cb = (is_lru ? (p.in[12] + layer * 768) : (p.in[19] + layer * 1280)) + chn;
                  u16* dst = (u16*)(p.ws + (is_lru ? WS_XL : WS_XBC)) + chn;
                  float w0[8], w1[8], w2[8], w3[8], bs[8];
#pragma unroll
                  for (int h = 0; h < 2; ++h) {
                    const float4 a0 = *(const float4*)(cw + 0 * nch + 4 * h), a1 = *(const float4*)(cw + 1 * nch + 4 * h);
                    const float4 a2 = *(const float4*)(cw + 2 * nch + 4 * h), a3 = *(const float4*)(cw + 3 * nch + 4 * h);
                    const float4 b4 = *(const float4*)(cb + 4 * h);
                    w0[4 * h] = a0.x; w0[4 * h + 1] = a0.y; w0[4 * h + 2] = a0.z; w0[4 * h + 3] = a0.w;
                    w1[4 * h] = a1.x; w1[4 * h + 1] = a1.y; w1[4 * h + 2] = a1.z; w1[4 * h + 3] = a1.w;
                    w2[4 * h] = a2.x; w2[4 * h + 1] = a2.y; w2[4 * h + 2] = a2.z; w2[4 * h + 3] = a2.w;
                    w3[4 * h] = a3.x; w3[4 * h + 1] = a3.y; w3[4 * h + 2] = a3.z; w3[4 * h + 3] = a3.w;
                    bs[4 * h] = b4.x; bs[4 * h + 1] = b4.y; bs[4 * h + 2] = b4.z; bs[4 * h + 3] = b4.w;
                  }
                  float xa[8], xb[8], xc[8], xd[8], yv[8];
#pragma unroll
                  for (int c = 0; c < 8; ++c) { xa[c] = 0.f; xb[c] = 0.f; xc[c] = 0.f; }
                  if (rbase >= 8) {
                    const int r1 = rbase - 3, r2 = rbase - 2, r3 = rbase - 1;
                    unpack8(*(const uint4*)((r1 < 64 ? eX + r1 * 136 : eW + (r1 - 64) * 136) + o * 8), xa);
                    unpack8(*(const uint4*)((r2 < 64 ? eX + r2 * 136 : eW + (r2 - 64) * 136) + o * 8), xb);
                    unpack8(*(const uint4*)((r3 < 64 ? eX + r3 * 136 : eW + (r3 - 64) * 136) + o * 8), xc);
                  }
#pragma unroll
                  for (int i = 0; i < 8; ++i) {
                    const int row = rbase + i;
                    unpack8(*(const uint4*)((row < 64 ? eX + row * 136 : eW + (row - 64) * 136) + o * 8), xd);
#pragma unroll
                    for (int c = 0; c < 8; ++c) {
                      const float v = bs[c] + w0[c] * xa[c] + w1[c] * xb[c] + w2[c] * xc[c] + w3[c] * xd[c];
                      yv[c] = is_lru ? v : silu_f(v);
                    }
                    if (row >= 3) *(uint4*)(dst + (size_t)(m0 + row) * nch) = pack8(yv);
#pragma unroll
                    for (int c = 0; c < 8; ++c) { xa[c] = xb[c]; xb[c] = xc[c]; xc[c] = xd[c]; }
                  }
                }
              }
              __syncthreads();
            } else {
              float* PRE = (float*)(p.ws + WS_PRE);
              const float alpha = 1.681792830507429f;
#pragma unroll
              for (int mt = 0; mt < 4; ++mt) {
                const int m = m0 + wm * 64 + mt * 16 + l15;
                const float* xres = (m < MP) ? (p.in[0] + (size_t)m * 1024) : (p.in[1] + (size_t)(m - MP) * 1024);
                const u16* xrb = (const u16*)(p.ws + WS_XB) + (size_t)m * 1024;
#pragma unroll
                for (int nt = 0; nt < 4; ++nt) {
                  const int n = n0 + wn * 64 + nt * 16 + quad * 4;
                  float4 xr;
                  if (layer == 0) xr = *(const float4*)(xres + n);
                  else { const uint2 xb2 = *(const uint2*)(xrb + n); xr = make_float4(bflo(xb2.x), bfhi(xb2.x), bflo(xb2.y), bfhi(xb2.y)); }
                  float4 o;
                  o.x = alpha * xr.x + acc[nt][mt][0]; o.y = alpha * xr.y + acc[nt][mt][1];
                  o.z = alpha * xr.z + acc[nt][mt][2]; o.w = alpha * xr.w + acc[nt][mt][3];
                  *(float4*)(PRE + (size_t)m * 1024 + n) = o;
                }
              }
            }
          }
        }
      }
    }
#undef GLOAD
#undef LSTORE
  }
}

PH void ln_phase(const Params& p, int layer) {
  const int tid = opaque_tid(), lane = tid & 63, w = tid >> 6;
  const float* PRE = (const float*)(p.ws + WS_PRE);
  u16* Xb = (u16*)(p.ws + WS_XB);
  const float* g = p.in[24] + layer * 1024;
  const float* bb = p.in[25] + layer * 1024;
  f32x4 gg[4], bv[4], nv[4];
#pragma unroll
  for (int i = 0; i < 4; ++i) {
    gg[i] = *(const f32x4*)(g + i * 256 + lane * 4);
    bv[i] = *(const f32x4*)(bb + i * 256 + lane * 4);
  }
  const int stride = gridDim.x * 4;
  int row = blockIdx.x * 4 + w;
  if (row < MT) {
#pragma unroll
    for (int i = 0; i < 4; ++i) nv[i] = *(const f32x4*)(PRE + (size_t)row * 1024 + i * 256 + lane * 4);
  }
#pragma unroll 1
  for (; row < MT; row += stride) {
    f32x4 v[4];
#pragma unroll
    for (int i = 0; i < 4; ++i) v[i] = nv[i];
    {
      const int nrow = (row + stride < MT) ? (row + stride) : row;
#pragma unroll
      for (int i = 0; i < 4; ++i) nv[i] = *(const f32x4*)(PRE + (size_t)nrow * 1024 + i * 256 + lane * 4);
    }
    float s = 0.f;
#pragma unroll
    for (int i = 0; i < 4; ++i) s += v[i][0] + v[i][1] + v[i][2] + v[i][3];
#pragma unroll
    for (int d = 1; d < 64; d <<= 1) s += __shfl_xor(s, d);
    const float mu = s * (1.f / 1024.f);
    float q = 0.f;
#pragma unroll
    for (int i = 0; i < 4; ++i) {
      v[i] -= mu;
      q += v[i][0] * v[i][0] + v[i][1] * v[i][1] + v[i][2] * v[i][2] + v[i][3] * v[i][3];
    }
#pragma unroll
    for (int d = 1; d < 64; d <<= 1) q += __shfl_xor(q, d);
    const float rs = rsqrtf(q * (1.f / 1024.f) + 1e-5f);
#pragma unroll
    for (int i = 0; i < 4; ++i) {
      const int c = i * 256 + lane * 4;
      const f32x4 o = v[i] * rs * gg[i] + bv[i];
      if (layer == 3) {
        float* dst = (row < MP) ? (p.out + O_YP + (size_t)row * 1024) : (p.out + O_YS + (size_t)(row - MP) * 1024);
        *(f32x4*)(dst + c) = o;
      } else {
        uint2 ob; ob.x = pack2(o[0], o[1]); ob.y = pack2(o[2], o[3]);
        *(uint2*)(Xb + (size_t)row * 1024 + c) = ob;
      }
    }
  }
}

PH void conv_unit(const Params& p, int layer, int unit) {
  const int tid = opaque_tid();
  const int T = (unit < 128) ? unit : 128, ru = (unit < 128) ? 0 : (unit - 128);
  const bool lru = tid < 96;
  const int oo = lru ? tid : tid - 96;
  const int nch = lru ? 768 : 1280;
  const int srccol = (lru ? C_XL : C_XBC) + 8 * oo;
  const float* cw = (lru ? (p.in[11] + layer * 4 * 768) : (p.in[18] + layer * 4 * 1280)) + 8 * oo;
  const float* cb = (lru ? (p.in[12] + layer * 768) : (p.in[19] + layer * 1280)) + 8 * oo;
  const u16* PROJ = (const u16*)(p.ws + WS_PROJ);
  u16* dst = (u16*)(p.ws + (lru ? WS_XL : WS_XBC)) + 8 * oo;
  float w0[8], w1[8], w2[8], w3[8], bs[8];
#pragma unroll
  for (int h = 0; h < 2; ++h) {
    const float4 a0 = *(const float4*)(cw + 0 * nch + 4 * h), a1 = *(const float4*)(cw + 1 * nch + 4 * h);
    const float4 a2 = *(const float4*)(cw + 2 * nch + 4 * h), a3 = *(const float4*)(cw + 3 * nch + 4 * h);
    const float4 b4 = *(const float4*)(cb + 4 * h);
    w0[4 * h] = a0.x; w0[4 * h + 1] = a0.y; w0[4 * h + 2] = a0.z; w0[4 * h + 3] = a0.w;
    w1[4 * h] = a1.x; w1[4 * h + 1] = a1.y; w1[4 * h + 2] = a1.z; w1[4 * h + 3] = a1.w;
    w2[4 * h] = a2.x; w2[4 * h + 1] = a2.y; w2[4 * h + 2] = a2.z; w2[4 * h + 3] = a2.w;
    w3[4 * h] = a3.x; w3[4 * h + 1] = a3.y; w3[4 * h + 2] = a3.z; w3[4 * h + 3] = a3.w;
    bs[4 * h] = b4.x; bs[4 * h + 1] = b4.y; bs[4 * h + 2] = b4.z; bs[4 * h + 3] = b4.w;
  }
  float xa[8], xb[8], xc[8], xd[8], y[8];
  if (T < 128) {
    const int r0 = T * 128, pos0 = r0 & 2047, b = r0 >> 11;
    if (pos0 == 0) {
#pragma unroll
      for (int c = 0; c < 8; ++c) { xa[c] = 0.f; xb[c] = 0.f; xc[c] = 0.f; }
    } else {
      unpack8(*(const uint4*)(PROJ + (size_t)(r0 - 3) * NPAD + srccol), xa);
      unpack8(*(const uint4*)(PROJ + (size_t)(r0 - 2) * NPAD + srccol), xb);
      unpack8(*(const uint4*)(PROJ + (size_t)(r0 - 1) * NPAD + srccol), xc);
    }
#pragma unroll
    for (int i = 0; i < 3; ++i) {
      const int row = r0 + i;
      unpack8(*(const uint4*)(PROJ + (size_t)row * NPAD + srccol), xd);
#pragma unroll
      for (int c = 0; c < 8; ++c) {
        float v = bs[c] + w0[c] * xa[c] + w1[c] * xb[c] + w2[c] * xc[c] + w3[c] * xd[c];
        y[c] = lru ? v : silu_f(v);
      }
      *(uint4*)(dst + (size_t)row * nch) = pack8(y);
#pragma unroll
      for (int c = 0; c < 8; ++c) { xa[c] = xb[c]; xb[c] = xc[c]; xc[c] = xd[c]; }
    }
    if ((T & 15) == 15) {
#pragma unroll
      for (int j = 0; j < 3; ++j) {
        unpack8(*(const uint4*)(PROJ + (size_t)(b * 2048 + 2045 + j) * NPAD + srccol), xd);
        float* op = p.out + (lru ? (O_PLC + (size_t)((layer * 8 + b) * 3 + j) * 768) : (O_PSC + (size_t)((layer * 8 + b) * 3 + j) * 1280)) + 8 * oo;
        *(float4*)op = make_float4(xd[0], xd[1], xd[2], xd[3]);
        *(float4*)(op + 4) = make_float4(xd[4], xd[5], xd[6], xd[7]);
      }
    }
  } else {
#pragma unroll 2
    for (int i = 0; i < 16; ++i) {
      const int bi = ru * 16 + i, row = MP + bi;
      const float* st = (lru ? (p.in[4] + (size_t)(layer * 128 + bi) * 3 * 768) : (p.in[6] + (size_t)(layer * 128 + bi) * 3 * 1280)) + 8 * oo;
#pragma unroll
      for (int h = 0; h < 2; ++h) {
        const float4 a = *(const float4*)(st + 0 * nch + 4 * h), b4 = *(const float4*)(st + 1 * nch + 4 * h), c4 = *(const float4*)(st + 2 * nch + 4 * h);
        xa[4 * h] = a.x; xa[4 * h + 1] = a.y; xa[4 * h + 2] = a.z; xa[4 * h + 3] = a.w;
        xb[4 * h] = b4.x; xb[4 * h + 1] = b4.y; xb[4 * h + 2] = b4.z; xb[4 * h + 3] = b4.w;
        xc[4 * h] = c4.x; xc[4 * h + 1] = c4.y; xc[4 * h + 2] = c4.z; xc[4 * h + 3] = c4.w;
      }
      unpack8(*(const uint4*)(PROJ + (size_t)row * NPAD + srccol), xd);
#pragma unroll
      for (int c = 0; c < 8; ++c) {
        float v = bs[c] + w0[c] * xa[c] + w1[c] * xb[c] + w2[c] * xc[c] + w3[c] * xd[c];
        y[c] = lru ? v : silu_f(v);
      }
      *(uint4*)(dst + (size_t)row * nch) = pack8(y);
      float* op = p.out + (lru ? (O_SLC + (size_t)(layer * 128 + bi) * 3 * 768) : (O_SSC + (size_t)(layer * 128 + bi) * 3 * 1280)) + 8 * oo;
      *(float4*)(op) = make_float4(xb[0], xb[1], xb[2], xb[3]);
      *(float4*)(op + 4) = make_float4(xb[4], xb[5], xb[6], xb[7]);
      *(float4*)(op + nch) = make_float4(xc[0], xc[1], xc[2], xc[3]);
      *(float4*)(op + nch + 4) = make_float4(xc[4], xc[5], xc[6], xc[7]);
      *(float4*)(op + 2 * nch) = make_float4(xd[0], xd[1], xd[2], xd[3]);
      *(float4*)(op + 2 * nch + 4) = make_float4(xd[4], xd[5], xd[6], xd[7]);
    }
  }
}

PH void attn_prompt_item(const Params& p, int layer, int item) {
  SMEM;
  const int tid = opaque_tid(), lane = tid & 63, w = tid >> 6, quad = lane >> 4, l15 = lane & 15;
  const int b = item >> 5, nb = (item >> 1) & 15, kvh = item & 1;
  u16* Ks = (u16*)smem;
  u16* Vt = (u16*)(smem + 256 * 72 * 2);
  const u16* PROJ = (const u16*)(p.ws + WS_PROJ);
  u16* MIX = (u16*)(p.ws + WS_MIX);
  const float* ROPE = (const float*)(p.ws + WS_ROPE);
  {
    const int j = tid, t = nb * 128 - 128 + j;
    uint4 kq[8], vq[8];
    if (t >= 0) {
      const u16* src = PROJ + (size_t)(b * 2048 + t) * NPAD;
#pragma unroll
      for (int i = 0; i < 8; ++i) {
        kq[i] = *(const uint4*)(src + C_K + kvh * 64 + i * 8);
        vq[i] = *(const uint4*)(src + C_V + kvh * 64 + i * 8);
      }
    } else {
#pragma unroll
      for (int i = 0; i < 8; ++i) { kq[i] = make_uint4(0, 0, 0, 0); vq[i] = make_uint4(0, 0, 0, 0); }
    }
    float x1[8], x2[8];
    unpack8(kq[0], x1); unpack8(kq[1], x2);
    if (t >= 0) {
      const float* cs = ROPE + (size_t)t * 16;
#pragma unroll
      for (int i = 0; i < 8; ++i) {
        const float c = cs[2 * i], s = cs[2 * i + 1];
        const float r1 = x1[i] * c - x2[i] * s, r2 = x2[i] * c + x1[i] * s;
        x1[i] = r1; x2[i] = r2;
      }
    }
    kq[0] = pack8(x1); kq[1] = pack8(x2);
#pragma unroll
    for (int i = 0; i < 8; ++i) *(uint4*)(Ks + j * 72 + i * 8) = kq[i];
#pragma unroll
    for (int i = 0; i < 8; ++i) {
      Vt[(i * 8 + 0) * 264 + j] = (u16)(vq[i].x & 0xffffu); Vt[(i * 8 + 1) * 264 + j] = (u16)(vq[i].x >> 16);
      Vt[(i * 8 + 2) * 264 + j] = (u16)(vq[i].y & 0xffffu); Vt[(i * 8 + 3) * 264 + j] = (u16)(vq[i].y >> 16);
      Vt[(i * 8 + 4) * 264 + j] = (u16)(vq[i].z & 0xffffu); Vt[(i * 8 + 5) * 264 + j] = (u16)(vq[i].z >> 16);
      Vt[(i * 8 + 6) * 264 + j] = (u16)(vq[i].w & 0xffffu); Vt[(i * 8 + 7) * 264 + j] = (u16)(vq[i].w >> 16);
    }
    if (nb == 15 && j >= 128) {
      float* ok = p.out + O_PK + ((size_t)((layer * 8 + b) * 128 + (j - 128)) * 2 + kvh) * 64;
      float* ov = p.out + O_PV + ((size_t)((layer * 8 + b) * 128 + (j - 128)) * 2 + kvh) * 64;
      *(float4*)(ok + 0) = make_float4(x1[0], x1[1], x1[2], x1[3]);
      *(float4*)(ok + 4) = make_float4(x1[4], x1[5], x1[6], x1[7]);
      *(float4*)(ok + 8) = make_float4(x2[0], x2[1], x2[2], x2[3]);
      *(float4*)(ok + 12) = make_float4(x2[4], x2[5], x2[6], x2[7]);
#pragma unroll
      for (int i = 2; i < 8; ++i) {
        float f[8]; unpack8(kq[i], f);
        *(float4*)(ok + i * 8) = make_float4(f[0], f[1], f[2], f[3]);
        *(float4*)(ok + i * 8 + 4) = make_float4(f[4], f[5], f[6], f[7]);
      }
#pragma unroll
      for (int i = 0; i < 8; ++i) {
        float f[8]; unpack8(vq[i], f);
        *(float4*)(ov + i * 8) = make_float4(f[0], f[1], f[2], f[3]);
        *(float4*)(ov + i * 8 + 4) = make_float4(f[4], f[5], f[6], f[7]);
      }
    }
  }
  __syncthreads();
  const int h = kvh * 4 + w;
  const float sink = p.in[10][layer * 8 + h];
  u32x4 nq[2][3];
#pragma unroll
  for (int qt = 0; qt < 2; ++qt) {
    const u16* src = PROJ + (size_t)(b * 2048 + nb * 128 + qt * 16 + l15) * NPAD + h * 64;
    nq[qt][0] = *(const u32x4*)(src + quad * 8);
    nq[qt][1] = *(const u32x4*)(src + 32 + quad * 8);
    nq[qt][2] = *(const u32x4*)(src + (quad ^ 1) * 8);
  }
#pragma unroll 1
  for (int c = 0; c < 4; ++c) {
    const int q0 = 32 * c;
    u32x4 cq[2][3];
#pragma unroll
    for (int qt = 0; qt < 2; ++qt) { cq[qt][0] = nq[qt][0]; cq[qt][1] = nq[qt][1]; cq[qt][2] = nq[qt][2]; }
    {
      const int qn = 32 * ((c < 3) ? (c + 1) : c);
#pragma unroll
      for (int qt = 0; qt < 2; ++qt) {
        const u16* src = PROJ + (size_t)(b * 2048 + nb * 128 + qn + qt * 16 + l15) * NPAD + h * 64;
        nq[qt][0] = *(const u32x4*)(src + quad * 8);
        nq[qt][1] = *(const u32x4*)(src + 32 + quad * 8);
        nq[qt][2] = *(const u32x4*)(src + (quad ^ 1) * 8);
      }
    }
    uint2 gpre[2][4];
#pragma unroll
    for (int qt = 0; qt < 2; ++qt)
#pragma unroll
      for (int dt = 0; dt < 4; ++dt)
        gpre[qt][dt] = *(const uint2*)(PROJ + (size_t)(b * 2048 + nb * 128 + q0 + qt * 16 + l15) * NPAD + C_GA + h * 64 + dt * 16 + quad * 4);
    bf16x8 qf[2][2];
#pragma unroll
    for (int qt = 0; qt < 2; ++qt) {
      const int qi = q0 + qt * 16 + l15;
      const int tpos = nb * 128 + qi;
      float own[8], o1[8];
      unpack8v(cq[qt][0], own);
      unpack8v(cq[qt][1], o1);
      if (quad < 2) {
        float pr[8];
        unpack8v(cq[qt][2], pr);
        const float* cs = ROPE + (size_t)tpos * 16;
        const float sg = (quad == 0) ? -1.f : 1.f;
#pragma unroll
        for (int i = 0; i < 8; ++i) own[i] = own[i] * cs[2 * i] + sg * pr[i] * cs[2 * i + 1];
      }
#pragma unroll
      for (int i = 0; i < 8; ++i) { own[i] *= 0.125f; o1[i] *= 0.125f; }
      qf[qt][0] = __builtin_bit_cast(bf16x8, pack8(own));
      qf[qt][1] = __builtin_bit_cast(bf16x8, pack8(o1));
    }
    f32x4 s[10][2];
#pragma unroll
    for (int kt = 0; kt < 10; ++kt) { s[kt][0] = (f32x4){0.f, 0.f, 0.f, 0.f}; s[kt][1] = (f32x4){0.f, 0.f, 0.f, 0.f}; }
#pragma unroll
    for (int ks = 0; ks < 2; ++ks)
#pragma unroll
      for (int kt = 0; kt < 10; ++kt) {
        const bf16x8 af = ldfrag(Ks, 72, q0 + kt * 16, ks * 32, lane);
        s[kt][0] = mfma16(af, qf[0][ks], s[kt][0]);
        s[kt][1] = mfma16(af, qf[1][ks], s[kt][1]);
      }
    float inv[2];
    bf16x8 pf[5][2];
#pragma unroll
    for (int qt = 0; qt < 2; ++qt) {
      const int i = q0 + qt * 16 + l15;
      float mx = -INFINITY;
#pragma unroll
      for (int kt = 0; kt < 10; ++kt)
#pragma unroll
        for (int r = 0; r < 4; ++r) {
          const int j = q0 + kt * 16 + quad * 4 + r;
          const bool valid = (j >= i) && (j <= i + 128) && (nb > 0 || j >= 128);
          const float v = valid ? s[kt][qt][r] : -INFINITY;
          s[kt][qt][r] = v;
          mx = fmaxf(mx, v);
        }
      mx = fmaxf(mx, __shfl_xor(mx, 16));
      mx = fmaxf(mx, __shfl_xor(mx, 32));
      mx = fmaxf(mx, sink);
      float sum = 0.f;
#pragma unroll
      for (int kt = 0; kt < 10; ++kt)
#pragma unroll
        for (int r = 0; r < 4; ++r) {
          const float e = __expf(s[kt][qt][r] - mx);
          s[kt][qt][r] = e;
          sum += e;
        }
      sum += __shfl_xor(sum, 16);
      sum += __shfl_xor(sum, 32);
      inv[qt] = 1.f / (sum + __expf(sink - mx));
#pragma unroll
      for (int kk = 0; kk < 5; ++kk) pf[kk][qt] = packfrag(s[2 * kk][qt], s[2 * kk + 1][qt]);
    }
    f32x4 o[4][2];
#pragma unroll
    for (int dt = 0; dt < 4; ++dt) { o[dt][0] = (f32x4){0.f, 0.f, 0.f, 0.f}; o[dt][1] = (f32x4){0.f, 0.f, 0.f, 0.f}; }
#pragma unroll
    for (int kk = 0; kk < 5; ++kk)
#pragma unroll
      for (int dt = 0; dt < 4; ++dt) {
        const bf16x8 vf = ldfrag_perm(Vt, 264, dt * 16, q0 + kk * 32, lane);
        o[dt][0] = mfma16(vf, pf[kk][0], o[dt][0]);
        o[dt][1] = mfma16(vf, pf[kk][1], o[dt][1]);
      }
#pragma unroll
    for (int qt = 0; qt < 2; ++qt) {
      const int qi = q0 + qt * 16 + l15;
      const size_t row = (size_t)(b * 2048 + nb * 128 + qi);
#pragma unroll
      for (int dt = 0; dt < 4; ++dt) {
        const int col = h * 64 + dt * 16 + quad * 4;
        const uint2 gv = gpre[qt][dt];
        const float g0 = bflo(gv.x), g1 = bfhi(gv.x), g2 = bflo(gv.y), g3 = bfhi(gv.y);
        uint2 ov;
        ov.x = pack2(o[dt][qt][0] * inv[qt] * silu_f(g0), o[dt][qt][1] * inv[qt] * silu_f(g1));
        ov.y = pack2(o[dt][qt][2] * inv[qt] * silu_f(g2), o[dt][qt][3] * inv[qt] * silu_f(g3));
        *(uint2*)(MIX + row * 2048 + col) = ov;
      }
    }
  }
}

PH void attn_decode_item(const Params& p, int layer, int item) {
  SMEM;
  const int tid = opaque_tid(), lane = tid & 63, w = tid >> 6;
  const int b = item >> 1, kvh = item & 1;
  float* Kd = (float*)smem;
  float* Vd = Kd + 129 * 65;
  float* qs = Vd + 129 * 64;
  float* ps = qs + 256;
  const u16* PROJ = (const u16*)(p.ws + WS_PROJ);
  u16* MIX = (u16*)(p.ws + WS_MIX);
  const float* ROPE = (const float*)(p.ws + WS_ROPE) + (size_t)2048 * 16;
  const size_t row = (size_t)(MP + b);
  const float* ck = p.in[2] + (size_t)(layer * 128 + b) * 128 * 128;
  const float* cv = p.in[3] + (size_t)(layer * 128 + b) * 128 * 128;
  float* ok = p.out + O_SK + (size_t)(layer * 128 + b) * 128 * 128;
  float* ov = p.out + O_SV + (size_t)(layer * 128 + b) * 128 * 128;
#pragma unroll
  for (int i = 0; i < 8; ++i) {
    const int idx = tid + 256 * i, wi = idx >> 4, c4 = idx & 15;
    const float4 kv = *(const float4*)(ck + (size_t)(wi * 2 + kvh) * 64 + c4 * 4);
    const float4 vv = *(const float4*)(cv + (size_t)(wi * 2 + kvh) * 64 + c4 * 4);
    Kd[wi * 65 + c4 * 4 + 0] = kv.x; Kd[wi * 65 + c4 * 4 + 1] = kv.y; Kd[wi * 65 + c4 * 4 + 2] = kv.z; Kd[wi * 65 + c4 * 4 + 3] = kv.w;
    *(float4*)(Vd + wi * 64 + c4 * 4) = vv;
    if (wi >= 1) {
      *(float4*)(ok + (size_t)((wi - 1) * 2 + kvh) * 64 + c4 * 4) = kv;
      *(float4*)(ov + (size_t)((wi - 1) * 2 + kvh) * 64 + c4 * 4) = vv;
    }
  }
  if (tid < 64) {
    const int d = tid;
    float kx = bf2f(PROJ[row * NPAD + C_K + kvh * 64 + d]);
    if (d < 16) {
      const float pr = bf2f(PROJ[row * NPAD + C_K + kvh * 64 + (d ^ 8)]);
      const float c = ROPE[2 * (d & 7)], s = ROPE[2 * (d & 7) + 1];
      kx = (d < 8) ? (kx * c - pr * s) : (kx * c + pr * s);
    }
    const float vx = bf2f(PROJ[row * NPAD + C_V + kvh * 64 + d]);
    Kd[128 * 65 + d] = kx; Vd[128 * 64 + d] = vx;
    ok[(size_t)(127 * 2 + kvh) * 64 + d] = kx;
    ov[(size_t)(127 * 2 + kvh) * 64 + d] = vx;
  }
  {
    const int g = tid >> 6, d = tid & 63, h = kvh * 4 + g;
    float qx = bf2f(PROJ[row * NPAD + h * 64 + d]);
    if (d < 16) {
      const float pr = bf2f(PROJ[row * NPAD + h * 64 + (d ^ 8)]);
      const float c = ROPE[2 * (d & 7)], s = ROPE[2 * (d & 7) + 1];
      qx = (d < 8) ? (qx * c - pr * s) : (qx * c + pr * s);
    }
    qs[g * 64 + d] = qx * 0.125f;
  }
  __syncthreads();
  const int h = kvh * 4 + w;
  const float sink = p.in[10][layer * 8 + h];
  float s0 = 0.f, s1 = 0.f, s2 = 0.f;
  for (int d = 0; d < 64; ++d) {
    const float qv = qs[w * 64 + d];
    s0 += qv * Kd[lane * 65 + d];
    s1 += qv * Kd[(lane + 64) * 65 + d];
    s2 += qv * Kd[128 * 65 + d];
  }
  float mx = fmaxf(fmaxf(s0, s1), s2);
#pragma unroll
  for (int d = 1; d < 64; d <<= 1) mx = fmaxf(mx, __shfl_xor(mx, d));
  mx = fmaxf(mx, sink);
  const float e0 = __expf(s0 - mx), e1 = __expf(s1 - mx), e2 = __expf(s2 - mx);
  float sum = e0 + e1;
#pragma unroll
  for (int d = 1; d < 64; d <<= 1) sum += __shfl_xor(sum, d);
  const float inv = 1.f / (sum + e2 + __expf(sink - mx));
  ps[w * 132 + lane] = e0 * inv;
  ps[w * 132 + 64 + lane] = e1 * inv;
  if (lane == 0) ps[w * 132 + 128] = e2 * inv;
  __syncthreads();
  float o = 0.f;
  for (int k = 0; k < 129; ++k) o += ps[w * 132 + k] * Vd[k * 64 + lane];
  const float gt = bf2f(PROJ[row * NPAD + C_GA + h * 64 + lane]);
  MIX[row * 2048 + h * 64 + lane] = f2bf(o * silu_f(gt));
}

PH void lru_item(const Params& p, int layer, int b, int n, int dpart) {
  SMEM;
  const int tid = opaque_tid(), lane = tid & 63, w = tid >> 6, quad = lane >> 4, l15 = lane & 15;
  u16* xls = (u16*)smem;
  float* as_ = (float*)(smem + 26624);
  float* bs_ = (float*)(smem + 26624 + 16896);
  float* Pc = (float*)(smem + 60416);
  float* Hc = (float*)(smem + 61440);
  float* hprev = (float*)(smem + 62464);
  const u16* PROJ = (const u16*)(p.ws + WS_PROJ);
  const u16* XL = (const u16*)(p.ws + WS_XL);
  u16* MIX = (u16*)(p.ws + WS_MIX);
  const u16* WA = (const u16*)(p.ws + WS_WA) + (size_t)(layer * 8 + n) * 9216;
  const u16* WX = (const u16*)(p.ws + WS_WX) + (size_t)(layer * 8 + n) * 9216;
  bf16x8 wa[2][3], wx[2][3];
#pragma unroll
  for (int dt = 0; dt < 2; ++dt)
#pragma unroll
    for (int ks = 0; ks < 3; ++ks) {
      const int d = dpart * 32 + dt * 16 + l15, k = ks * 32 + quad * 8;
      wa[dt][ks] = *(const bf16x8*)(WA + d * 96 + k);
      wx[dt][ks] = *(const bf16x8*)(WX + d * 96 + k);
    }
  const int nchunks = (b >= 0) ? 16 : 1;
  const int sch = tid & 31, sub = tid >> 5;
  const int chg = n * 96 + dpart * 32 + sch;
  const float ba = p.in[14][layer * 768 + chg], bx = p.in[16][layer * 768 + chg];
  const float cl = -8.f * softplus_f(-p.in[17][layer * 768 + chg]);
  u32x4 pxl[6];
  u16 pgt[16];
  {
    const int nb_ = (b >= 0) ? (b * 2048) : MP;
#pragma unroll
    for (int i = 0; i < 6; ++i) {
      const int idx = tid + 256 * i, r = idx / 12, c16 = idx % 12;
      pxl[i] = *(const u32x4*)(XL + (size_t)(nb_ + r) * 768 + n * 96 + c16 * 8);
    }
#pragma unroll
    for (int t = 0; t < 16; ++t) pgt[t] = PROJ[(size_t)(nb_ + sub * 16 + t) * NPAD + C_GL + chg];
  }
#pragma unroll 1
  for (int c = 0; c < nchunks; ++c) {
    const int base = (b >= 0) ? (b * 2048 + c * 128) : MP;
    __syncthreads();
#pragma unroll
    for (int i = 0; i < 6; ++i) {
      const int idx = tid + 256 * i, r = idx / 12, c16 = idx % 12;
      *(u32x4*)(xls + r * 104 + c16 * 8) = pxl[i];
    }
    u16 gcur[16];
#pragma unroll
    for (int t = 0; t < 16; ++t) gcur[t] = pgt[t];
    {
      const int nb_ = (c + 1 < nchunks) ? (base + 128) : base;
#pragma unroll
      for (int i = 0; i < 6; ++i) {
        const int idx = tid + 256 * i, r = idx / 12, c16 = idx % 12;
        pxl[i] = *(const u32x4*)(XL + (size_t)(nb_ + r) * 768 + n * 96 + c16 * 8);
      }
#pragma unroll
      for (int t = 0; t < 16; ++t) pgt[t] = PROJ[(size_t)(nb_ + sub * 16 + t) * NPAD + C_GL + chg];
    }
    __syncthreads();
    {
      f32x4 ra[2][2], rx[2][2];
#pragma unroll
      for (int dt = 0; dt < 2; ++dt)
#pragma unroll
        for (int tt = 0; tt < 2; ++tt) { ra[dt][tt] = (f32x4){0.f, 0.f, 0.f, 0.f}; rx[dt][tt] = (f32x4){0.f, 0.f, 0.f, 0.f}; }
#pragma unroll
      for (int ks = 0; ks < 3; ++ks)
#pragma unroll
        for (int tt = 0; tt < 2; ++tt) {
          const bf16x8 xf = ldfrag(xls, 104, (2 * w + tt) * 16, ks * 32, lane);
#pragma unroll
          for (int dt = 0; dt < 2; ++dt) {
            ra[dt][tt] = mfma16(wa[dt][ks], xf, ra[dt][tt]);
            rx[dt][tt] = mfma16(wx[dt][ks], xf, rx[dt][tt]);
          }
        }
#pragma unroll
      for (int dt = 0; dt < 2; ++dt)
#pragma unroll
        for (int tt = 0; tt < 2; ++tt)
#pragma unroll
          for (int r = 0; r < 4; ++r) {
            const int tok = (2 * w + tt) * 16 + l15, dl = dt * 16 + quad * 4 + r;
            as_[tok * 33 + dl] = ra[dt][tt][r];
            bs_[tok * 33 + dl] = rx[dt][tt][r];
          }
    }
    __syncthreads();
    float P = 1.f, H = 0.f;
#pragma unroll
    for (int t = 0; t < 16; ++t) {
      const int tok = sub * 16 + t;
      const float rg = sigmoid_f(as_[tok * 33 + sch] + ba);
      const float ig = sigmoid_f(bs_[tok * 33 + sch] + bx);
      const float la = cl * rg;
      const float xv = bf2f(xls[tok * 104 + dpart * 32 + sch]);
      const float a = __expf(la);
      const float bb = __builtin_amdgcn_sqrtf(-expm1f(2.f * la)) * ig * xv;
      as_[tok * 33 + sch] = a;
      bs_[tok * 33 + sch] = bb;
      H = a * H + bb; P *= a;
    }
    if (b >= 0) {
      Pc[sub * 32 + sch] = P; Hc[sub * 32 + sch] = H;
      __syncthreads();
      float carry = (c == 0) ? 0.f : hprev[sch];
#pragma unroll
      for (int s = 0; s < 8; ++s) if (s < sub) carry = Pc[s * 32 + sch] * carry + Hc[s * 32 + sch];
      float hh = carry;
#pragma unroll
      for (int t = 0; t < 16; ++t) {
        const int tok = sub * 16 + t;
        const float a = as_[tok * 33 + sch], bb = bs_[tok * 33 + sch];
        hh = a * hh + bb;
        const size_t row = (size_t)(base + tok);
        const float g = bf2f(gcur[t]);
        MIX[row * 2048 + 512 + chg] = f2bf(hh * silu_f(g));
      }
      __syncthreads();
      if (sub == 7) {
        hprev[sch] = hh;
        if (c == 15) p.out[O_PLH + (size_t)(layer * 8 + b) * 768 + chg] = hh;
      }
    } else {
#pragma unroll
      for (int t = 0; t < 16; ++t) {
        const int tok = sub * 16 + t;
        const float a = as_[tok * 33 + sch], bb = bs_[tok * 33 + sch];
        const float h0 = p.in[5][(size_t)(layer * 128 + tok) * 768 + chg];
        const float hh = a * h0 + bb;
        const size_t row = (size_t)(MP + tok);
        const float g = bf2f(gcur[t]);
        MIX[row * 2048 + 512 + chg] = f2bf(hh * silu_f(g));
        p.out[O_SLH + (size_t)(layer * 128 + tok) * 768 + chg] = hh;
      }
    }
  }
}

constexpr int NSEG = 3;
template <int PROBE, int SONLY, int CPS>
DI void ssd_chunk_loop(const Params& p, int layer, int b, int e, int c0, f32x4 (&h)[8], float& dtot, bool write_final) {
  SMEM;
  const int tid = opaque_tid(), lane = tid & 63, w = tid >> 6, quad = lane >> 4, l15 = lane & 15;
  const int g = e / 6;
  u16* Cs = (u16*)smem;
  u16* Bs = (u16*)(smem + 17408);
  u16* Bt2 = (u16*)(smem + 34816);
  u16* Xt = (u16*)(smem + 53248);
  u16* Ms = (u16*)(smem + 62464);
  float* dt_s = (float*)(smem + 71680);
  float* acs_s = dt_s + 64;
  float* ssq_s = acs_s + 64;
  const u16* PROJ = (const u16*)(p.ws + WS_PROJ);
  const u16* XBC = (const u16*)(p.ws + WS_XBC);
  u16* MIX = (u16*)(p.ws + WS_MIX);
  float* SSQ = (float*)(p.ws + WS_SSQ);
  const float dtb = p.in[20][layer * 12 + e];
  const float ah = -__expf(p.in[21][layer * 12 + e]);
  const float Dv = p.in[22][layer * 12 + e];
  const bool do_store = !(PROBE & 1) || (dtb == 1234.5f);
  u32x4 pc[4], pb[4], px[2];
  u16 pru;
  {
    const int nb_ = b * 2048 + c0 * 64;
#pragma unroll
    for (int i = 0; i < 4; ++i) {
      const int idx = tid + 256 * i, r = idx >> 4, c16 = idx & 15;
      if (!SONLY) pc[i] = *(const u32x4*)(XBC + (size_t)(nb_ + r) * 1280 + 1024 + g * 128 + c16 * 8);
      pb[i] = *(const u32x4*)(XBC + (size_t)(nb_ + r) * 1280 + 768 + g * 128 + c16 * 8);
    }
#pragma unroll
    for (int i = 0; i < 2; ++i) {
      const int idx = tid + 256 * i, r = idx >> 3, c8 = idx & 7;
      px[i] = *(const u32x4*)(XBC + (size_t)(nb_ + r) * 1280 + e * 64 + c8 * 8);
    }
    pru = PROJ[(size_t)(nb_ + lane) * NPAD + C_DT + e];
  }
#pragma unroll 1
  for (int cc = c0; cc < c0 + CPS; ++cc) {
    const int base = b * 2048 + cc * 64;
#pragma unroll
    for (int i = 0; i < 4; ++i) {
      const int idx = tid + 256 * i, r = idx >> 4, c16 = idx & 15;
      if (!SONLY) *(u32x4*)(Cs + r * 136 + c16 * 8) = pc[i];
      *(u32x4*)(Bs + r * 136 + c16 * 8) = pb[i];
    }
    u32x4 xr[2];
    xr[0] = px[0]; xr[1] = px[1];
    if (w == 0) {
      const float dtv = softplus_f(bf2f(pru) + dtb);
      float a = dtv * ah;
#pragma unroll
      for (int d = 1; d < 64; d <<= 1) { const float t = __shfl_up(a, d); if (lane >= d) a += t; }
      dt_s[lane] = dtv; acs_s[lane] = a;
    }
    {
      const int nb_ = b * 2048 + ((cc + 1 < c0 + CPS) ? (cc + 1) : cc) * 64;
#pragma unroll
      for (int i = 0; i < 4; ++i) {
        const int idx = tid + 256 * i, r = idx >> 4, c16 = idx & 15;
        if (!SONLY) pc[i] = *(const u32x4*)(XBC + (size_t)(nb_ + r) * 1280 + 1024 + g * 128 + c16 * 8);
        pb[i] = *(const u32x4*)(XBC + (size_t)(nb_ + r) * 1280 + 768 + g * 128 + c16 * 8);
      }
#pragma unroll
      for (int i = 0; i < 2; ++i) {
        const int idx = tid + 256 * i, r = idx >> 3, c8 = idx & 7;
        px[i] = *(const u32x4*)(XBC + (size_t)(nb_ + r) * 1280 + e * 64 + c8 * 8);
      }
      pru = PROJ[(size_t)(nb_ + lane) * NPAD + C_DT + e];
    }
    uint2 dx[4], dz[4];
    if (!SONLY)
#pragma unroll
    for (int qt = 0; qt < 4; ++qt) {
      const size_t row = (size_t)(base + qt * 16 + l15);
      const int pcol = w * 16 + quad * 4;
      dx[qt] = *(const uint2*)(XBC + row * 1280 + e * 64 + pcol);
      dz[qt] = *(const uint2*)(PROJ + row * NPAD + C_Z + e * 64 + pcol);
    }
    __syncthreads();
    dtot += acs_s[63];
    if (!(PROBE & 2)) {
#pragma unroll
    for (int i = 0; i < 2; ++i) {
      const int idx = tid + 256 * i, r = idx >> 3, c8 = idx & 7;
      const float dtv = dt_s[r];
      float f[8]; unpack8v(xr[i], f);
#pragma unroll
      for (int j = 0; j < 8; ++j) Xt[(c8 * 8 + j) * 72 + r] = f2bf(f[j] * dtv);
    }
    {
      const int q = tid & 63, ng = tid >> 6;
      const float dte = __expf(acs_s[63] - acs_s[q]);
#pragma unroll
      for (int i = 0; i < 8; ++i) {
        const uint2 v = *(const uint2*)(Bs + q * 136 + ng * 32 + i * 4);
        Bt2[(ng * 32 + i * 4 + 0) * 72 + q] = f2bf(bflo(v.x) * dte);
        Bt2[(ng * 32 + i * 4 + 1) * 72 + q] = f2bf(bfhi(v.x) * dte);
        Bt2[(ng * 32 + i * 4 + 2) * 72 + q] = f2bf(bflo(v.y) * dte);
        Bt2[(ng * 32 + i * 4 + 3) * 72 + q] = f2bf(bfhi(v.y) * dte);
      }
    }
    }
    __syncthreads();
    if (!(PROBE & 4) && !SONLY) {
      const int q = w * 16 + l15;
      const float aq = acs_s[q];
      bf16x8 cfr[4];
#pragma unroll
      for (int ks = 0; ks < 4; ++ks) cfr[ks] = ldfrag(Cs, 136, w * 16, ks * 32, lane);
#pragma unroll
      for (int st = 0; st < 4; ++st) {
        uint2 ov;
        const int s0 = st * 16 + quad * 4;
        {
          f32x4 acc = (f32x4){0.f, 0.f, 0.f, 0.f};
#pragma unroll
          for (int ks = 0; ks < 4; ++ks) acc = mfma16(ldfrag(Bs, 136, st * 16, ks * 32, lane), cfr[ks], acc);
          float v[4];
#pragma unroll
          for (int r = 0; r < 4; ++r) { const int s = s0 + r; v[r] = (s <= q) ? acc[r] * __expf(fminf(aq - acs_s[s], 0.f)) : 0.f; }
          ov.x = pack2(v[0], v[1]); ov.y = pack2(v[2], v[3]);
        }
        *(uint2*)(Ms + q * 72 + s0) = ov;
      }
    }
    f32x4 y[4];
#pragma unroll
    for (int qt = 0; qt < 4; ++qt) y[qt] = (f32x4){0.f, 0.f, 0.f, 0.f};
    if (!(PROBE & 4) && !SONLY)
#pragma unroll
    for (int kk = 0; kk < 4; ++kk) {
      const bf16x8 hf = packfrag(h[2 * kk], h[2 * kk + 1]);
#pragma unroll
      for (int qt = 0; qt < 4; ++qt) y[qt] = mfma16(hf, ldfrag_perm(Cs, 136, qt * 16, kk * 32, lane), y[qt]);
    }
    if (!SONLY) {
#pragma unroll
    for (int qt = 0; qt < 4; ++qt) y[qt] *= __expf(acs_s[qt * 16 + l15]);
    __syncthreads();
    }
    if (!(PROBE & 8) && !SONLY)
#pragma unroll
    for (int qt = 0; qt < 4; ++qt)
#pragma unroll
      for (int ks = 0; ks < 2; ++ks)
        if (ks == 0 || qt >= 2) y[qt] = mfma16(ldfrag(Xt, 72, w * 16, ks * 32, lane), ldfrag(Ms, 72, qt * 16, ks * 32, lane), y[qt]);
    if (!(PROBE & 8)) {
      const float cd = __expf(acs_s[63]);
#pragma unroll
      for (int nt = 0; nt < 8; ++nt) h[nt] *= cd;
#pragma unroll
      for (int ks = 0; ks < 2; ++ks) {
        const bf16x8 xf = ldfrag(Xt, 72, w * 16, ks * 32, lane);
#pragma unroll
        for (int nt = 0; nt < 8; ++nt) h[nt] = mfma16(ldfrag(Bt2, 72, nt * 16, ks * 32, lane), xf, h[nt]);
      }
    }
    if (!SONLY)
#pragma unroll
    for (int qt = 0; qt < 4; ++qt) {
      const int q = qt * 16 + l15;
      const size_t row = (size_t)(base + q);
      const int pcol = w * 16 + quad * 4;
      const uint2 xv = dx[qt];
      const uint2 zv = dz[qt];
      const float y0 = (y[qt][0] + Dv * bflo(xv.x)) * silu_f(bflo(zv.x));
      const float y1 = (y[qt][1] + Dv * bfhi(xv.x)) * silu_f(bfhi(zv.x));
      const float y2 = (y[qt][2] + Dv * bflo(xv.y)) * silu_f(bflo(zv.y));
      const float y3 = (y[qt][3] + Dv * bfhi(xv.y)) * silu_f(bfhi(zv.y));
      uint2 ov; ov.x = pack2(y0, y1); ov.y = pack2(y2, y3);
      if (do_store) *(uint2*)(MIX + row * 2048 + 1280 + e * 64 + pcol) = ov;
      float ss = y0 * y0 + y1 * y1 + y2 * y2 + y3 * y3;
      ss += __shfl_xor(ss, 16);
      ss += __shfl_xor(ss, 32);
      if (quad == 0) ssq_s[w * 64 + q] = ss;
    }
    __syncthreads();
    if (do_store && !SONLY) if (tid < 64) SSQ[(size_t)(base + tid) * 12 + e] = ssq_s[tid] + ssq_s[64 + tid] + ssq_s[128 + tid] + ssq_s[192 + tid];
  }
  if (do_store && write_final) {
    float* oh = p.out + O_PSH + (size_t)((layer * 8 + b) * 12 + e) * 64 * 128;
    const int pidx = w * 16 + l15;
#pragma unroll
    for (int nt = 0; nt < 8; ++nt) {
      const int n = nt * 16 + quad * 4;
      *(float4*)(oh + (size_t)pidx * 128 + n) = make_float4(h[nt][0], h[nt][1], h[nt][2], h[nt][3]);
    }
  }
}


DI unsigned flag_ld(unsigned* f) { return __hip_atomic_load(f, __ATOMIC_RELAXED, __HIP_MEMORY_SCOPE_AGENT); }
template <int PROBE>
PH void ssd_prompt_item(const Params& p, int layer, int b, int e, int seg) {
  const int tid = opaque_tid(), lane = tid & 63, w = tid >> 6, quad = lane >> 4, l15 = lane & 15;
  float* SEND = (float*)(p.ws + WS_SEND) + (size_t)((layer * 96 + b * 12 + e) * NSEG) * 8192;
  unsigned* SFLAG = (unsigned*)(p.ws + WS_SFLAG) + (layer * 96 + b * 12 + e) * NSEG;
  f32x4 h[8];
#pragma unroll
  for (int i = 0; i < 8; ++i) h[i] = (f32x4){0.f, 0.f, 0.f, 0.f};
  float dtot = 0.f;
  const size_t eoff = (size_t)(w * 16 + l15) * 128 + quad * 4;
  if (seg < NSEG - 1) ssd_chunk_loop<PROBE, 1, 10>(p, layer, b, e, seg * 10, h, dtot, false);
  if (seg > 0) {
    if (tid == 0) {
      unsigned sp = 0;
      while (flag_ld(SFLAG + seg - 1) == 0u) { __builtin_amdgcn_s_sleep(2); if (++sp > (1u << 22)) break; }
    }
    __syncthreads();
    __builtin_amdgcn_fence(__ATOMIC_ACQUIRE, "agent");
    asm volatile("s_waitcnt vmcnt(0)" ::: "memory");
    const float* hin = SEND + (size_t)(seg - 1) * 8192 + eoff;
    const float fdec = __expf(dtot);
#pragma unroll
    for (int nt = 0; nt < 8; ++nt) {
      const float4 v = *(const float4*)(hin + nt * 16);
      const f32x4 hv = (f32x4){v.x, v.y, v.z, v.w};
      if (seg < NSEG - 1) {
        const f32x4 he = fdec * hv + h[nt];
        *(float4*)(SEND + (size_t)seg * 8192 + eoff + nt * 16) = make_float4(he[0], he[1], he[2], he[3]);
      }
      h[nt] = hv;
    }
  } else {
#pragma unroll
    for (int nt = 0; nt < 8; ++nt) {
      *(float4*)(SEND + eoff + nt * 16) = make_float4(h[nt][0], h[nt][1], h[nt][2], h[nt][3]);
      h[nt] = (f32x4){0.f, 0.f, 0.f, 0.f};
    }
  }
  if (seg < NSEG - 1) {
    __builtin_amdgcn_fence(__ATOMIC_RELEASE, "agent");
    asm volatile("s_waitcnt vmcnt(0)" ::: "memory");
    __syncthreads();
    if (tid == 0) __hip_atomic_store(SFLAG + seg, 1u, __ATOMIC_RELAXED, __HIP_MEMORY_SCOPE_AGENT);
  }
  float dummy = 0.f;
  if (seg < NSEG - 1) ssd_chunk_loop<PROBE, 0, 10>(p, layer, b, e, seg * 10, h, dummy, false);
  else ssd_chunk_loop<PROBE, 0, 12>(p, layer, b, e, 20, h, dummy, true);
}

PH void ssd_decode_item(const Params& p, int layer, int b, int e) {
  SMEM;
  const int tid = opaque_tid();
  const int g = e / 6;
  float* xs_s = (float*)smem;
  float* Bv = xs_s + 64;
  float* Cv = Bv + 128;
  float* ys = Cv + 128;
  const u16* PROJ = (const u16*)(p.ws + WS_PROJ);
  const u16* XBC = (const u16*)(p.ws + WS_XBC);
  u16* MIX = (u16*)(p.ws + WS_MIX);
  float* SSQ = (float*)(p.ws + WS_SSQ);
  const size_t row = (size_t)(MP + b);
  const float* h0 = p.in[7] + (size_t)((layer * 128 + b) * 12 + e) * 64 * 128;
  float* h1 = p.out + O_SSH + (size_t)((layer * 128 + b) * 12 + e) * 64 * 128;
  const int n4 = tid & 31;
  f32x4 hv[8];
  u16 zv[8];
#pragma unroll
  for (int i = 0; i < 8; ++i) {
    const int pidx = (tid >> 5) + 8 * i;
    hv[i] = *(const f32x4*)(h0 + (size_t)pidx * 128 + n4 * 4);
    zv[i] = PROJ[row * NPAD + C_Z + e * 64 + pidx];
  }
  const u16 xsr = XBC[row * 1280 + e * 64 + (tid & 63)];
  const u16 bvr = XBC[row * 1280 + 768 + g * 128 + (tid & 127)];
  const u16 cvr = XBC[row * 1280 + 1024 + g * 128 + (tid & 127)];
  const float dtv = softplus_f(bf2f(PROJ[row * NPAD + C_DT + e]) + p.in[20][layer * 12 + e]);
  const float dA = __expf(dtv * (-__expf(p.in[21][layer * 12 + e])));
  const float Dv = p.in[22][layer * 12 + e];
  if (tid < 64) xs_s[tid] = bf2f(xsr);
  if (tid < 128) { Bv[tid] = bf2f(bvr); Cv[tid] = bf2f(cvr); }
  __syncthreads();
  const float4 Bq = *(const float4*)(Bv + n4 * 4), Cq = *(const float4*)(Cv + n4 * 4);
#pragma unroll
  for (int i = 0; i < 8; ++i) {
    const int pidx = (tid >> 5) + 8 * i;
    const float xsv = xs_s[pidx];
    const float xdt = dtv * xsv;
    f32x4 hn;
    hn[0] = dA * hv[i][0] + xdt * Bq.x; hn[1] = dA * hv[i][1] + xdt * Bq.y; hn[2] = dA * hv[i][2] + xdt * Bq.z; hn[3] = dA * hv[i][3] + xdt * Bq.w;
    *(f32x4*)(h1 + (size_t)pidx * 128 + n4 * 4) = hn;
    float part = Cq.x * hn[0] + Cq.y * hn[1] + Cq.z * hn[2] + Cq.w * hn[3];
#pragma unroll
    for (int d = 1; d < 32; d <<= 1) part += __shfl_xor(part, d);
    if (n4 == 0) ys[pidx] = (part + Dv * xsv) * silu_f(bf2f(zv[i]));
  }
  __syncthreads();
  if (tid < 64) {
    const float v = ys[tid];
    MIX[row * 2048 + 1280 + e * 64 + tid] = f2bf(v);
    float ss = v * v;
#pragma unroll
    for (int d = 1; d < 64; d <<= 1) ss += __shfl_xor(ss, d);
    if (tid == 0) SSQ[row * 12 + e] = ss;
  }
}

#define XB_TMO      128
#define XB_XCNT(j)  (256  + 64 * (j))
#define XB_XSUB(j)  (1280 + 64 * (j))
#define XB_XGEN(j)  (2304 + 64 * (j))
#define XB_TOP      3328
#define XB_TOPGEN   3392
#define XCD_BAR_WORDS 3456
#define XB_SPIN_CAP (1u << 18)
#define LAS __attribute__((address_space(3)))
DI unsigned xb_ld(unsigned* p)              { return __hip_atomic_load(p, __ATOMIC_RELAXED, __HIP_MEMORY_SCOPE_AGENT); }
DI unsigned xb_add(unsigned* p, unsigned v) { return __hip_atomic_fetch_add(p, v, __ATOMIC_RELAXED, __HIP_MEMORY_SCOPE_AGENT); }
DI unsigned xb_xcc_id() { return (unsigned)__builtin_amdgcn_s_getreg((3 << 11) | 20) & 0xFu; }
#define XB_SPIN(cond, bar) do { unsigned _sp = 0; while (cond) { __builtin_amdgcn_s_sleep(1); \
    if ((++_sp & 255u) == 0u) { if (xb_ld(&(bar)[XB_TMO])) break; if (_sp > XB_SPIN_CAP) { atomicAdd(&(bar)[XB_TMO], 1u); break; } } } } while (0)
struct XcdBarrier { unsigned* bar; unsigned x; volatile LAS unsigned* st; };
DI XcdBarrier xcd_barrier_post(unsigned* bar, volatile LAS unsigned* st) {
  XcdBarrier b; b.bar = bar; b.x = xb_xcc_id(); b.st = st;
  if (threadIdx.x == 0) (void)xb_add(&bar[XB_XCNT(b.x)], 1u);
  return b;
}
DI void xcd_barrier_complete(unsigned* bar, unsigned x, unsigned& nloc, unsigned& nx) {
  const unsigned G = gridDim.x * gridDim.y * gridDim.z;
  unsigned sum, cnt, mine, sp = 0u;
  for (;;) {
    sum = 0u; cnt = 0u; mine = 0u;
#pragma unroll
    for (unsigned j = 0; j < 16; ++j) { const unsigned c = xb_ld(&bar[XB_XCNT(j)]); sum += c; cnt += (c > 0u) ? 1u : 0u; mine = (j == x) ? c : mine; }
    if (sum == G) break;
    __builtin_amdgcn_s_sleep(1);
    if ((++sp & 255u) == 0u) { if (xb_ld(&bar[XB_TMO])) break; if (sp > XB_SPIN_CAP) { atomicAdd(&bar[XB_TMO], 1u); break; } }
  }
  nloc = mine > 0u ? mine : 1u; nx = cnt > 0u ? cnt : 1u;
}
DI void xcd_barrier(const XcdBarrier& b) {
  asm volatile("s_waitcnt vmcnt(0)" ::: "memory");
  __syncthreads();
  if (threadIdx.x == 0) {
    unsigned* bar = b.bar;
    __builtin_amdgcn_s_waitcnt(0);
    unsigned nloc = b.st[0], nx = b.st[1];
    if (nloc == 0u) { xcd_barrier_complete(bar, b.x, nloc, nx); b.st[0] = nloc; b.st[1] = nx; }
    const unsigned old = xb_add(&bar[XB_XSUB(b.x)], 1u);
    const unsigned gen = old / nloc;
    if (old + 1u == (gen + 1u) * nloc) {
      __builtin_amdgcn_fence(__ATOMIC_RELEASE, "agent");
      asm volatile("s_waitcnt vmcnt(0)" ::: "memory");
      const unsigned og = xb_add(&bar[XB_TOP], 1u);
      const unsigned tg = og / nx;
      if (og + 1u == (tg + 1u) * nx) xb_add(&bar[XB_TOPGEN], 1u);
      else XB_SPIN(xb_ld(&bar[XB_TOPGEN]) == tg, bar);
      __builtin_amdgcn_fence(__ATOMIC_ACQUIRE, "agent");
      xb_add(&bar[XB_XGEN(b.x)], 1u);
      asm volatile("s_waitcnt vmcnt(0)" ::: "memory");
    } else {
      XB_SPIN(xb_ld(&bar[XB_XGEN(b.x)]) == gen, bar);
      __builtin_amdgcn_fence(__ATOMIC_ACQUIRE, "agent");
      asm volatile("s_waitcnt vmcnt(0)" ::: "memory");
    }
  }
  __syncthreads();
}

#define REP_PREP 1
#define REP_G0 1
#define REP_2A 1
#define REP_2B 1
#define REP_G1 1
#define REP_LN 1
#define REP_SYNC 0
#define PROBE_SSD 0
#define PROBE_2B_LO 0
#define PROBE_2B_HI 96
__global__ void __launch_bounds__(256, 2) mega(Params p) {
  __shared__ int slot;
  __shared__ uint4 xb_words;
  cg::grid_group grid = cg::this_grid();
  unsigned* ctr = (unsigned*)(p.ws + WS_CTR);
  if (threadIdx.x == 0) xb_words = make_uint4(0u, 0u, 0u, 0u);
  __syncthreads();
  XcdBarrier xb = xcd_barrier_post((unsigned*)(p.ws + WS_BAR), (volatile LAS unsigned*)&xb_words);
  if (p.ws == nullptr) grid.sync();
  for (int rep = 0; rep < REP_PREP; ++rep) { phase_prep(p); xcd_barrier(xb); }
#pragma unroll 1
  for (int layer = 0; layer < 4; ++layer) {
    for (int rep = 0; rep < REP_G0; ++rep) { gemm_phase<0>(p, layer); xcd_barrier(xb); }
    for (int rep = 0; rep < REP_2A; ++rep) {
      for (;;) {
        int it = next_item(ctr + layer * 2 + 8 * rep, &slot);
        if (it >= 136 + 512) break;
        it = (it < 512) ? (it + 136) : (it - 512);
        if (it < 136) conv_unit(p, layer, it);
        else if (it < 392) attn_prompt_item(p, layer, it - 136);
        else attn_decode_item(p, layer, it - 392);
      }
      xcd_barrier(xb);
    }
    for (int rep = 0; rep < REP_2B; ++rep) {
      for (;;) {
        int it = next_item(ctr + layer * 2 + 1 + 8 * rep, &slot);
        if (rep > 0) { it += PROBE_2B_LO; if (it >= PROBE_2B_HI) break; }
        if (it >= 288 + 192 + 24 + 1536) break;
        it = (it < 192) ? (it + 384) : ((it < 480) ? (it - 192) : (it + 608));
        if (it < 384) { const int v = it % 96; ssd_prompt_item<0>(p, layer, v / 12, v % 12, it / 96); }
        else if (it < 576) { const int v = it - 384; lru_item(p, layer, v / 24, (v % 24) / 3, v % 3); }
        else if (it < 832) attn_prompt_item(p, layer, it - 576);
        else if (it < 1088) attn_decode_item(p, layer, it - 832);
        else if (it < 1112) { const int v = it - 1088; lru_item(p, layer, -1, v / 3, v % 3); }
        else { const int v = it - 1112; ssd_decode_item(p, layer, v / 12, v % 12); }
      }
      xcd_barrier(xb);
    }
    for (int rep = 0; rep < REP_G1; ++rep) { gemm_phase<1>(p, layer); xcd_barrier(xb); }
    for (int rep = 0; rep < REP_LN; ++rep) { ln_phase(p, layer); xcd_barrier(xb); }
    for (int rep = 0; rep < REP_SYNC; ++rep) xcd_barrier(xb);
  }
}

extern "C" void kernel_launch(void* const* d_in, const int* in_sizes, int n_in,
                              void* d_out, int out_size, void* d_ws, size_t ws_size,
                              hipStream_t stream) {
  static int grid_blocks = 0;
  if (grid_blocks == 0) {
    if (n_in != 26 || ws_size < WS_END) { fprintf(stderr, "kernel_launch: unexpected n_in %d or ws_size %zu (< %zu)\n", n_in, ws_size, (size_t)WS_END); grid_blocks = -1; return; }
    int dev = 0, cus = 0, per_cu = 0;
    hipGetDevice(&dev);
    hipDeviceGetAttribute(&cus, hipDeviceAttributeMultiprocessorCount, dev);
    if (hipFuncSetAttribute((const void*)mega, hipFuncAttributeMaxDynamicSharedMemorySize, LDS_BYTES) != hipSuccess) { fprintf(stderr, "kernel_launch: hipFuncSetAttribute failed\n"); grid_blocks = -1; return; }
    if (hipOccupancyMaxActiveBlocksPerMultiprocessor(&per_cu, (const void*)mega, 256, LDS_BYTES) != hipSuccess || per_cu < 1) { fprintf(stderr, "kernel_launch: occupancy query failed (%d)\n", per_cu); grid_blocks = -1; return; }
    if (per_cu > 2) per_cu = 2;
    grid_blocks = cus * per_cu;
  }
  if (grid_blocks < 0) return;
  Params p{};
  for (int i = 0; i < 26; ++i) p.in[i] = (const float*)d_in[i];
  p.out = (float*)d_out;
  p.ws = (char*)d_ws;
  if (hipMemsetAsync((char*)d_ws + WS_BAR, 0, 16384, stream) != hipSuccess) { fprintf(stderr, "kernel_launch: memset of barrier words failed\n"); return; }
  void* args[] = {&p};
  hipError_t e = hipLaunchCooperativeKernel((const void*)mega, dim3(grid_blocks), dim3(256), args, LDS_BYTES, stream);
  if (e != hipSuccess) fprintf(stderr, "cooperative launch failed: %s (grid %d)\n", hipGetErrorString(e), grid_blocks);
}
```

```cpp
#include <hip/hip_runtime.h>
#include <hip/hip_cooperative_groups.h>
#include <cstdio>
namespace cg = cooperative_groups;

#define DI __device__ __forceinline__
#define PH __device__ __forceinline__
#define SMEM extern __shared__ __attribute__((aligned(16))) char smem[]
typedef unsigned short u16;
using bf16x8 = __attribute__((ext_vector_type(8))) short;
using f32x4 = __attribute__((ext_vector_type(4))) float;
using u32x4 = __attribute__((ext_vector_type(4))) unsigned;

constexpr int MP = 16384, MT = 16512;
constexpr int NPAD = 4992;
constexpr int C_K = 512, C_V = 640, C_GA = 768, C_XL = 1280, C_GL = 2048, C_Z = 2816, C_XBC = 3584, C_DT = 4864;
constexpr int LDS_BYTES = 73728;

constexpr size_t WS_WIN = 0;
constexpr size_t WS_WOUT = WS_WIN + (size_t)4 * NPAD * 1024 * 2;
constexpr size_t WS_WA = WS_WOUT + (size_t)4 * 1024 * 2048 * 2;
constexpr size_t WS_WX = WS_WA + (size_t)4 * 8 * 96 * 96 * 2;
constexpr size_t WS_XB = WS_WX + (size_t)4 * 8 * 96 * 96 * 2;
constexpr size_t WS_XF = WS_XB + (size_t)MT * 1024 * 2;
constexpr size_t WS_PRE = WS_XF + (size_t)MT * 1024 * 4;
constexpr size_t WS_PROJ = WS_PRE + (size_t)MT * 1024 * 4;
constexpr size_t WS_XL = WS_PROJ + (size_t)MT * NPAD * 2;
constexpr size_t WS_XBC = WS_XL + (size_t)MT * 768 * 2;
constexpr size_t WS_MIX = WS_XBC + (size_t)MT * 1280 * 2;
constexpr size_t WS_SSQ = WS_MIX + (size_t)MT * 2048 * 2;
constexpr size_t WS_ROPE = WS_SSQ + (size_t)MT * 12 * 4;
constexpr size_t WS_CTR = WS_ROPE + 131328;
constexpr size_t WS_SFLAG = WS_CTR + 256;
constexpr size_t WS_SEND = WS_SFLAG + 8192;
constexpr size_t WS_BAR = WS_SEND + (size_t)4 * 96 * 4 * 8192 * 4;
constexpr size_t WS_END = WS_BAR + 16384;

constexpr size_t O_YP = 0;
constexpr size_t O_YS = O_YP + (size_t)8 * 2048 * 1024;
constexpr size_t O_PK = O_YS + (size_t)128 * 1024;
constexpr size_t O_PV = O_PK + (size_t)4 * 8 * 128 * 2 * 64;
constexpr size_t O_PLC = O_PV + (size_t)4 * 8 * 128 * 2 * 64;
constexpr size_t O_PLH = O_PLC + (size_t)4 * 8 * 3 * 768;
constexpr size_t O_PSC = O_PLH + (size_t)4 * 8 * 768;
constexpr size_t O_PSH = O_PSC + (size_t)4 * 8 * 3 * 1280;
constexpr size_t O_SK = O_PSH + (size_t)4 * 8 * 12 * 64 * 128;
constexpr size_t O_SV = O_SK + (size_t)4 * 128 * 128 * 2 * 64;
constexpr size_t O_SLC = O_SV + (size_t)4 * 128 * 128 * 2 * 64;
constexpr size_t O_SLH = O_SLC + (size_t)4 * 128 * 3 * 768;
constexpr size_t O_SSC = O_SLH + (size_t)4 * 128 * 768;
constexpr size_t O_SSH = O_SSC + (size_t)4 * 128 * 3 * 1280;

struct Params {
  const float* in[26];
  float* out;
  char* ws;
};

typedef __bf16 bf2_t __attribute__((ext_vector_type(2)));
typedef float fl2_t __attribute__((ext_vector_type(2)));
DI u16 f2bf(float x) { return __builtin_bit_cast(u16, (__bf16)x); }
DI float bf2f(u16 b) { return __uint_as_float(((unsigned)b) << 16); }
DI unsigned pack2(float a, float b) { fl2_t v = {a, b}; return __builtin_bit_cast(unsigned, __builtin_convertvector(v, bf2_t)); }
DI float bflo(unsigned u) { return __uint_as_float(u << 16); }
DI float bfhi(unsigned u) { return __uint_as_float(u & 0xffff0000u); }
DI void unpack8(uint4 v, float* f) {
  f[0] = bflo(v.x); f[1] = bfhi(v.x); f[2] = bflo(v.y); f[3] = bfhi(v.y);
  f[4] = bflo(v.z); f[5] = bfhi(v.z); f[6] = bflo(v.w); f[7] = bfhi(v.w);
}
DI void unpack8v(u32x4 v, float* f) {
  f[0] = bflo(v[0]); f[1] = bfhi(v[0]); f[2] = bflo(v[1]); f[3] = bfhi(v[1]);
  f[4] = bflo(v[2]); f[5] = bfhi(v[2]); f[6] = bflo(v[3]); f[7] = bfhi(v[3]);
}
DI uint4 pack8(const float* f) {
  uint4 v; v.x = pack2(f[0], f[1]); v.y = pack2(f[2], f[3]); v.z = pack2(f[4], f[5]); v.w = pack2(f[6], f[7]); return v;
}
DI f32x4 mfma16(bf16x8 a, bf16x8 b, f32x4 c) { return __builtin_amdgcn_mfma_f32_16x16x32_bf16(a, b, c, 0, 0, 0); }
DI bf16x8 ldfrag(const u16* base, int ld, int row0, int k0, int lane) {
  return *(const bf16x8*)(base + (row0 + (lane & 15)) * ld + k0 + (lane >> 4) * 8);
}
DI bf16x8 ldfrag_perm(const u16* base, int ld, int row0, int k0, int lane) {
  const u16* pp = base + (row0 + (lane & 15)) * ld + k0 + (lane >> 4) * 4;
  uint2 a = *(const uint2*)pp; uint2 b = *(const uint2*)(pp + 16);
  uint4 v; v.x = a.x; v.y = a.y; v.z = b.x; v.w = b.y;
  return __builtin_bit_cast(bf16x8, v);
}
DI bf16x8 packfrag(f32x4 t0, f32x4 t1) {
  uint4 v; v.x = pack2(t0[0], t0[1]); v.y = pack2(t0[2], t0[3]); v.z = pack2(t1[0], t1[1]); v.w = pack2(t1[2], t1[3]);
  return __builtin_bit_cast(bf16x8, v);
}
DI float silu_f(float x) { return x * __builtin_amdgcn_rcpf(1.f + __expf(-x)); }
DI float sigmoid_f(float x) { return __builtin_amdgcn_rcpf(1.f + __expf(-x)); }
DI float softplus_f(float x) { return x > 20.f ? x : log1pf(__expf(x)); }

DI int opaque_tid() { int t = threadIdx.x; asm volatile("" : "+v"(t)); return t; }
DI int next_item(unsigned* ctr, int* slot) {
  __syncthreads();
  if (threadIdx.x == 0) *slot = (int)atomicAdd(ctr, 1u);
  __syncthreads();
  return *slot;
}

PH void phase_prep(const Params& p) {
  SMEM;
  const int tid = opaque_tid();
  float* tile = (float*)smem;
  u16* WinT = (u16*)(p.ws + WS_WIN);
  u16* WoutT = (u16*)(p.ws + WS_WOUT);
  u16* Xb = (u16*)(p.ws + WS_XB);
  float* ROPE = (float*)(p.ws + WS_ROPE);
  unsigned* ctr = (unsigned*)(p.ws + WS_CTR);
  if (blockIdx.x == 0 && tid < 64) ctr[tid] = 0u;
  if (blockIdx.x == 1) { unsigned* sf = (unsigned*)(p.ws + WS_SFLAG); for (int i = tid; i < 2048; i += 256) sf[i] = 0u; }
  constexpr int U_WIN = 4 * 16 * 78;
  constexpr int U_WOUT = 4 * 32 * 16;
  constexpr int U_LW = 64;
  constexpr int U_XB = MT * 1024 / 2048;
  constexpr int U_ROPE = 65;
  constexpr int U_TOT = U_WIN + U_WOUT + U_LW + U_XB + U_ROPE;
  for (int u = blockIdx.x; u < U_TOT; u += gridDim.x) {
    if (u < U_WIN) {
      const int l = u / (16 * 78), r = u % (16 * 78), kt = r / 78, nt = r % 78;
      const float* src = p.in[8] + (size_t)l * 1024 * 4876;
#pragma unroll
      for (int i = 0; i < 16; ++i) {
        const int k = (tid >> 6) + 4 * i, n = nt * 64 + (tid & 63);
        tile[k * 65 + (tid & 63)] = (n < 4876) ? src[(size_t)(kt * 64 + k) * 4876 + n] : 0.f;
      }
      __syncthreads();
      u16* dst = WinT + (size_t)l * NPAD * 1024;
#pragma unroll
      for (int i = 0; i < 8; ++i) {
        const int nn = (tid >> 5) + 8 * i, k = (tid & 31) * 2;
        *(unsigned*)(dst + (size_t)(nt * 64 + nn) * 1024 + kt * 64 + k) = pack2(tile[k * 65 + nn], tile[(k + 1) * 65 + nn]);
      }
      __syncthreads();
    } else if (u < U_WIN + U_WOUT) {
      const int v = u - U_WIN;
      const int l = v / (32 * 16), r = v % (32 * 16), kt = r / 16, nt = r % 16;
      const float* src = p.in[9] + (size_t)l * 2048 * 1024;
      const float* ng = p.in[23] + l * 768;
#pragma unroll
      for (int i = 0; i < 16; ++i) {
        const int k = (tid >> 6) + 4 * i, kg = kt * 64 + k;
        const float sc = (kg >= 1280) ? ng[kg - 1280] : 1.f;
        tile[k * 65 + (tid & 63)] = src[(size_t)kg * 1024 + nt * 64 + (tid & 63)] * sc;
      }
      __syncthreads();
      u16* dst = WoutT + (size_t)l * 1024 * 2048;
#pragma unroll
      for (int i = 0; i < 8; ++i) {
        const int nn = (tid >> 5) + 8 * i, k = (tid & 31) * 2;
        *(unsigned*)(dst + (size_t)(nt * 64 + nn) * 2048 + kt * 64 + k) = pack2(tile[k * 65 + nn], tile[(k + 1) * 65 + nn]);
      }
      __syncthreads();
    } else if (u < U_WIN + U_WOUT + U_LW) {
      const int v = u - U_WIN - U_WOUT;
      const int l = v / 16, rem = v % 16, n = rem / 2, which = rem % 2;
      const float* src = (which ? p.in[15] : p.in[13]) + (size_t)(l * 8 + n) * 9216;
      u16* dst = (u16*)(p.ws + (which ? WS_WX : WS_WA)) + (size_t)(l * 8 + n) * 9216;
      for (int e = tid; e < 9216; e += 256) {
        const int d = e / 96, c = e % 96;
        dst[e] = f2bf(src[c * 96 + d]);
      }
    } else if (u < U_WIN + U_WOUT + U_LW + U_XB) {
      const int v = u - U_WIN - U_WOUT - U_LW;
      const size_t ge = (size_t)v * 2048 + (size_t)tid * 8;
      const float* src = (ge < (size_t)MP * 1024) ? (p.in[0] + ge) : (p.in[1] + (ge - (size_t)MP * 1024));
      const float4 a = *(const float4*)src, b = *(const float4*)(src + 4);
      uint4 o; o.x = pack2(a.x, a.y); o.y = pack2(a.z, a.w); o.z = pack2(b.x, b.y); o.w = pack2(b.z, b.w);
      *(uint4*)(Xb + ge) = o;
    } else {
      const int v = u - U_WIN - U_WOUT - U_LW - U_XB;
      const int e = v * 256 + tid;
      if (e < 2049 * 8) {
        const int pi = e >> 3, i = e & 7;
        const double pos = (pi < 2048) ? (double)pi : 8192.0;
        const double inv = pow(500000.0, -(double)i / 8.0);
        double sn, cs; sincos(pos * inv, &sn, &cs);
        ROPE[e * 2 + 0] = (float)cs; ROPE[e * 2 + 1] = (float)sn;
      }
    }
  }
}

DI void tile_coords(int t, int NTN, int& m0, int& n0) {
  const int panel = t / (8 * NTN), within = t % (8 * NTN);
  int tm, tn;
  if (panel < 16) { tn = within >> 3; tm = panel * 8 + (within & 7); } else { tm = 128; tn = t - 16 * 8 * NTN; }
  m0 = tm * 128; n0 = tn * 128;
}
template <int MODE>
PH void gemm_phase(const Params& p, int layer) {
  SMEM;
  constexpr int K = (MODE == 0) ? 1024 : 2048;
  constexpr int NTN = (MODE == 0) ? 39 : 8;
  constexpr int NK = K / 64;
  constexpr int LOGNK = (MODE == 0) ? 4 : 5;
  const u16* X = (const u16*)(p.ws + (MODE == 0 ? WS_XB : WS_MIX));
  const u16* W = (const u16*)(p.ws + (MODE == 0 ? WS_WIN : WS_WOUT)) + (size_t)layer * (MODE == 0 ? (size_t)NPAD * 1024 : (size_t)1024 * 2048);
  u16* sX = (u16*)smem;
  u16* sW = sX + 2 * 128 * 72;
  const int tid = opaque_tid(), lane = tid & 63, w = tid >> 6, quad = lane >> 4, l15 = lane & 15;
  const int wn = w >> 1, wm = w & 1;
  const int ntiles = 129 * NTN;
  const int G = gridDim.x, bid = blockIdx.x;
  const int off = ((G & 7) == 0) ? ((bid & 7) * (G >> 3) + (bid >> 3)) : bid;
  if (off < ntiles) {
    const int nt_b = (ntiles - off + G - 1) / G;
    const int total = nt_b << LOGNK;
    const int soff = (tid >> 3) * 72 + (tid & 7) * 8;
    const int rowoff = tid >> 3, coloff = (tid & 7) * 8;
    f32x4 acc[4][4];
    u32x4 rx[2][4], rw[2][4];
#define GLOAD(S, g_) { \
      const int gg_ = ((g_) < total) ? (g_) : (total - 1); \
      const int it_ = gg_ >> LOGNK, kt_ = gg_ & (NK - 1); \
      int m0_, n0_; tile_coords(it_ * G + off, NTN, m0_, n0_); \
      const int k0_ = ((MODE == 0) ? kt_ : ((kt_ + 20) & 31)) * 64; \
      const u16* gx_ = X + (size_t)(m0_ + rowoff) * K + coloff + k0_; \
      const u16* gw_ = W + (size_t)(n0_ + rowoff) * K + coloff + k0_; \
      _Pragma("unroll") for (int i = 0; i < 4; ++i) { \
        rx[S][i] = *(const u32x4*)(gx_ + (size_t)i * 32 * K); \
        rw[S][i] = *(const u32x4*)(gw_ + (size_t)i * 32 * K); } }
#define LSTORE(S, buf_) { \
      u16* dX_ = sX + (buf_) * 128 * 72; u16* dW_ = sW + (buf_) * 128 * 72; \
      _Pragma("unroll") for (int i = 0; i < 4; ++i) { \
        *(u32x4*)(dX_ + soff + i * 32 * 72) = rx[S][i]; \
        *(u32x4*)(dW_ + soff + i * 32 * 72) = rw[S][i]; } }
    GLOAD(0, 0); GLOAD(1, 1);
    LSTORE(0, 0);
    __syncthreads();
#pragma unroll 1
    for (int g0 = 0; g0 < total; g0 += 2) {
#pragma unroll
      for (int s = 0; s < 2; ++s) {
        const int g = g0 + s;
        {
          const int kt = g & (NK - 1), it = g >> LOGNK;
          if (kt == 0) {
#pragma unroll
            for (int a = 0; a < 4; ++a)
#pragma unroll
              for (int b = 0; b < 4; ++b) acc[a][b] = (f32x4){0.f, 0.f, 0.f, 0.f};
          }
          if (MODE == 1 && kt == 12) {
            int m0, n0; tile_coords(it * G + off, NTN, m0, n0);
            const float* SSQ = (const float*)(p.ws + WS_SSQ);
#pragma unroll
            for (int mt = 0; mt < 4; ++mt) {
              const int m = m0 + wm * 64 + mt * 16 + l15;
              const float4 s0 = *(const float4*)(SSQ + (size_t)m * 12), s1 = *(const float4*)(SSQ + (size_t)m * 12 + 4), s2 = *(const float4*)(SSQ + (size_t)m * 12 + 8);
              const float ss = s0.x + s0.y + s0.z + s0.w + s1.x + s1.y + s1.z + s1.w + s2.x + s2.y + s2.z + s2.w;
              const float rs = rsqrtf(ss * (1.f / 768.f) + 1e-5f);
#pragma unroll
              for (int nt = 0; nt < 4; ++nt) acc[nt][mt] *= rs;
            }
          }
          const u16* cX = sX + (g & 1) * 128 * 72;
          const u16* cW = sW + (g & 1) * 128 * 72;
          u16* dX = sX + ((g + 1) & 1) * 128 * 72;
          u16* dW = sW + ((g + 1) & 1) * 128 * 72;
#pragma unroll
          for (int ks = 0; ks < 2; ++ks) {
            bf16x8 wf[4], xf[4];
#pragma unroll
            for (int i = 0; i < 4; ++i) {
              wf[i] = ldfrag(cW, 72, wn * 64 + i * 16, ks * 32, lane);
              xf[i] = ldfrag(cX, 72, wm * 64 + i * 16, ks * 32, lane);
            }
            __builtin_amdgcn_sched_barrier(0);
#pragma unroll
            for (int nt = 0; nt < 4; ++nt) {
#pragma unroll
              for (int mt = 0; mt < 4; ++mt) acc[nt][mt] = mfma16(wf[nt], xf[mt], acc[nt][mt]);
              if (ks == 0) *(u32x4*)(dX + soff + nt * 32 * 72) = rx[(s + 1) & 1][nt];
              else         *(u32x4*)(dW + soff + nt * 32 * 72) = rw[(s + 1) & 1][nt];
              __builtin_amdgcn_sched_barrier(0);
            }
            if (ks == 0) { GLOAD(s, g + 2); __builtin_amdgcn_sched_barrier(0); }
          }
          __syncthreads();
          if (kt == NK - 1) {
            int m0, n0; tile_coords(it * G + off, NTN, m0, n0);
            if (MODE == 0) {
              u16* PROJ = (u16*)(p.ws + WS_PROJ);
              u16* eX = sX + (g & 1) * 128 * 72;
              u16* eW = sW + (g & 1) * 128 * 72;
#pragma unroll
              for (int mt = 0; mt < 4; ++mt) {
                const int ml = mt * 16 + l15;
                u16* eb = (wm == 0 ? eX : eW) + ml * 136;
#pragma unroll
                for (int nt = 0; nt < 4; ++nt) {
                  const int nl = wn * 64 + nt * 16 + quad * 4;
                  uint2 o; o.x = pack2(acc[nt][mt][0], acc[nt][mt][1]); o.y = pack2(acc[nt][mt][2], acc[nt][mt][3]);
                  *(uint2*)(eb + nl) = o;
                }
              }
              __syncthreads();
#pragma unroll
              for (int i = 0; i < 8; ++i) {
                const int row = (tid >> 4) + 16 * i, ch = tid & 15;
                const u16* eb = (row < 64 ? eX + row * 136 : eW + (row - 64) * 136) + ch * 8;
                *(u32x4*)(PROJ + (size_t)(m0 + row) * NPAD + n0 + ch * 8) = *(const u32x4*)eb;
              }
              {
                const int tn_ = n0 >> 7;
                const bool is_lru = (tn_ >= 10) && (tn_ < 16), is_ssd = (tn_ >= 28) && (tn_ < 38);
                if ((is_lru || is_ssd) && m0 < MP) {
                  const int o = tid & 15, rbase = (tid >> 4) * 8;
                  const int nch = is_lru ? 768 : 1280;
                  const int chn = (is_lru ? (n0 - C_XL) : (n0 - C_XBC)) + o * 8;
                  const float* cw = (is_lru ? (p.in[11] + layer * 4 * 768) : (p.in[18] + layer * 4 * 1280)) + chn;
                  const float* cb = (is_lru ? (p.in[12] + layer * 768) : (p.in[19] + layer * 1280)) + chn;
                  u16* dst = (u16*)(p.ws + (is_lru ? WS_XL : WS_XBC)) + chn;
                  float w0[8], w1[8], w2[8], w3[8], bs[8];
#pragma unroll
                  for (int h = 0; h < 2; ++h) {
                    const float4 a0 = *(const float4*)(cw + 0 * nch + 4 * h), a1 = *(const float4*)(cw + 1 * nch + 4 * h);
                    const float4 a2 = *(const float4*)(cw + 2 * nch + 4 * h), a3 = *(const float4*)(cw + 3 * nch + 4 * h);
                    const float4 b4 = *(const float4*)(cb + 4 * h);
                    w0[4 * h] = a0.x; w0[4 * h + 1] = a0.y; w0[4 * h + 2] = a0.z; w0[4 * h + 3] = a0.w;
                    w1[4 * h] = a1.x; w1[4 * h + 1] = a1.y; w1[4 * h + 2] = a1.z; w1[4 * h + 3] = a1.w;
                    w2[4 * h] = a2.x; w2[4 * h + 1] = a2.y; w2[4 * h + 2] = a2.z; w2[4 * h + 3] = a2.w;
                    w3[4 * h] = a3.x; w3[4 * h + 1] = a3.y; w3[4 * h + 2] = a3.z; w3[4 * h + 3] = a3.w;
                    bs[4 * h] = b4.x; bs[4 * h + 1] = b4.y; bs[4 * h + 2] = b4.z; bs[4 * h + 3] = b4.w;
                  }
                  float xa[8], xb[8], xc[8], xd[8], yv[8];
#pragma unroll
                  for (int c = 0; c < 8; ++c) { xa[c] = 0.f; xb[c] = 0.f; xc[c] = 0.f; }
                  if (rbase >= 8) {
                    const int r1 = rbase - 3, r2 = rbase - 2, r3 = rbase - 1;
                    unpack8(*(const uint4*)((r1 < 64 ? eX + r1 * 136 : eW + (r1 - 64) * 136) + o * 8), xa);
                    unpack8(*(const uint4*)((r2 < 64 ? eX + r2 * 136 : eW + (r2 - 64) * 136) + o * 8), xb);
                    unpack8(*(const uint4*)((r3 < 64 ? eX + r3 * 136 : eW + (r3 - 64) * 136) + o * 8), xc);
                  }
#pragma unroll
                  for (int i = 0; i < 8; ++i) {
                    const int row = rbase + i;
                    unpack8(*(const uint4*)((row < 64 ? eX + row * 136 : eW + (row - 64) * 136) + o * 8), xd);
#pragma unroll
                    for (int c = 0; c < 8; ++c) {
                      const float v = bs[c] + w0[c] * xa[c] + w1[c] * xb[c] + w2[c] * xc[c] + w3[c] * xd[c];
                      yv[c] = is_lru ? v : silu_f(v);
                    }
                    if (row >= 3) *(uint4*)(dst + (size_t)(m0 + row) * nch) = pack8(yv);
#pragma unroll
                    for (int c = 0; c < 8; ++c) { xa[c] = xb[c]; xb[c] = xc[c]; xc[c] = xd[c]; }
                  }
                }
              }
              __syncthreads();
            } else {
              float* PRE = (float*)(p.ws + WS_PRE);
              const float alpha = 1.681792830507429f;
#pragma unroll
              for (int mt = 0; mt < 4; ++mt) {
                const int m = m0 + wm * 64 + mt * 16 + l15;
                const float* xres = (m < MP) ? (p.in[0] + (size_t)m * 1024) : (p.in[1] + (size_t)(m - MP) * 1024);
                const u16* xrb = (const u16*)(p.ws + WS_XB) + (size_t)m * 1024;
#pragma unroll
                for (int nt = 0; nt < 4; ++nt) {
                  const int n = n0 + wn * 64 + nt * 16 + quad * 4;
                  float4 xr;
                  if (layer == 0) xr = *(const float4*)(xres + n);
                  else { const uint2 xb2 = *(const uint2*)(xrb + n); xr = make_float4(bflo(xb2.x), bfhi(xb2.x), bflo(xb2.y), bfhi(xb2.y)); }
                  float4 o;
                  o.x = alpha * xr.x + acc[nt][mt][0]; o.y = alpha * xr.y + acc[nt][mt][1];
                  o.z = alpha * xr.z + acc[nt][mt][2]; o.w = alpha * xr.w + acc[nt][mt][3];
                  *(float4*)(PRE + (size_t)m * 1024 + n) = o;
                }
              }
            }
          }
        }
      }
    }
#undef GLOAD
#undef LSTORE
  }
}

PH void ln_phase(const Params& p, int layer) {
  const int tid = opaque_tid(), lane = tid & 63, w = tid >> 6;
  const float* PRE = (const float*)(p.ws + WS_PRE);
  u16* Xb = (u16*)(p.ws + WS_XB);
  const float* g = p.in[24] + layer * 1024;
  const float* bb = p.in[25] + layer * 1024;
  f32x4 gg[4], bv[4], nv[4];
#pragma unroll
  for (int i = 0; i < 4; ++i) {
    gg[i] = *(const f32x4*)(g + i * 256 + lane * 4);
    bv[i] = *(const f32x4*)(bb + i * 256 + lane * 4);
  }
  const int stride = gridDim.x * 4;
  int row = blockIdx.x * 4 + w;
  if (row < MT) {
#pragma unroll
    for (int i = 0; i < 4; ++i) nv[i] = *(const f32x4*)(PRE + (size_t)row * 1024 + i * 256 + lane * 4);
  }
#pragma unroll 1
  for (; row < MT; row += stride) {
    f32x4 v[4];
#pragma unroll
    for (int i = 0; i < 4; ++i) v[i] = nv[i];
    {
      const int nrow = (row + stride < MT) ? (row + stride) : row;
#pragma unroll
      for (int i = 0; i < 4; ++i) nv[i] = *(const f32x4*)(PRE + (size_t)nrow * 1024 + i * 256 + lane * 4);
    }
    float s = 0.f;
#pragma unroll
    for (int i = 0; i < 4; ++i) s += v[i][0] + v[i][1] + v[i][2] + v[i][3];
#pragma unroll
    for (int d = 1; d < 64; d <<= 1) s += __shfl_xor(s, d);
    const float mu = s * (1.f / 1024.f);
    float q = 0.f;
#pragma unroll
    for (int i = 0; i < 4; ++i) {
      v[i] -= mu;
      q += v[i][0] * v[i][0] + v[i][1] * v[i][1] + v[i][2] * v[i][2] + v[i][3] * v[i][3];
    }
#pragma unroll
    for (int d = 1; d < 64; d <<= 1) q += __shfl_xor(q, d);
    const float rs = rsqrtf(q * (1.f / 1024.f) + 1e-5f);
#pragma unroll
    for (int i = 0; i < 4; ++i) {
      const int c = i * 256 + lane * 4;
      const f32x4 o = v[i] * rs * gg[i] + bv[i];
      if (layer == 3) {
        float* dst = (row < MP) ? (p.out + O_YP + (size_t)row * 1024) : (p.out + O_YS + (size_t)(row - MP) * 1024);
        *(f32x4*)(dst + c) = o;
      } else {
        uint2 ob; ob.x = pack2(o[0], o[1]); ob.y = pack2(o[2], o[3]);
        *(uint2*)(Xb + (size_t)row * 1024 + c) = ob;
      }
    }
  }
}

PH void conv_unit(const Params& p, int layer, int unit) {
  const int tid = opaque_tid();
  const int T = (unit < 128) ? unit : 128, ru = (unit < 128) ? 0 : (unit - 128);
  const bool lru = tid < 96;
  const int oo = lru ? tid : tid - 96;
  const int nch = lru ? 768 : 1280;
  const int srccol = (lru ? C_XL : C_XBC) + 8 * oo;
  const float* cw = (lru ? (p.in[11] + layer * 4 * 768) : (p.in[18] + layer * 4 * 1280)) + 8 * oo;
  const float* cb = (lru ? (p.in[12] + layer * 768) : (p.in[19] + layer * 1280)) + 8 * oo;
  const u16* PROJ = (const u16*)(p.ws + WS_PROJ);
  u16* dst = (u16*)(p.ws + (lru ? WS_XL : WS_XBC)) + 8 * oo;
  float w0[8], w1[8], w2[8], w3[8], bs[8];
#pragma unroll
  for (int h = 0; h < 2; ++h) {
    const float4 a0 = *(const float4*)(cw + 0 * nch + 4 * h), a1 = *(const float4*)(cw + 1 * nch + 4 * h);
    const float4 a2 = *(const float4*)(cw + 2 * nch + 4 * h), a3 = *(const float4*)(cw + 3 * nch + 4 * h);
    const float4 b4 = *(const float4*)(cb + 4 * h);
    w0[4 * h] = a0.x; w0[4 * h + 1] = a0.y; w0[4 * h + 2] = a0.z; w0[4 * h + 3] = a0.w;
    w1[4 * h] = a1.x; w1[4 * h + 1] = a1.y; w1[4 * h + 2] = a1.z; w1[4 * h + 3] = a1.w;
    w2[4 * h] = a2.x; w2[4 * h + 1] = a2.y; w2[4 * h + 2] = a2.z; w2[4 * h + 3] = a2.w;
    w3[4 * h] = a3.x; w3[4 * h + 1] = a3.y; w3[4 * h + 2] = a3.z; w3[4 * h + 3] = a3.w;
    bs[4 * h] = b4.x; bs[4 * h + 1] = b4.y; bs[4 * h + 2] = b4.z; bs[4 * h + 3] = b4.w;
  }
  float xa[8], xb[8], xc[8], xd[8], y[8];
  if (T < 128) {
    const int r0 = T * 128, pos0 = r0 & 2047, b = r0 >> 11;
    if (pos0 == 0) {
#pragma unroll
      for (int c = 0; c < 8; ++c) { xa[c] = 0.f; xb[c] = 0.f; xc[c] = 0.f; }
    } else {
      unpack8(*(const uint4*)(PROJ + (size_t)(r0 - 3) * NPAD + srccol), xa);
      unpack8(*(const uint4*)(PROJ + (size_t)(r0 - 2) * NPAD + srccol), xb);
      unpack8(*(const uint4*)(PROJ + (size_t)(r0 - 1) * NPAD + srccol), xc);
    }
#pragma unroll
    for (int i = 0; i < 3; ++i) {
      const int row = r0 + i;
      unpack8(*(const uint4*)(PROJ + (size_t)row * NPAD + srccol), xd);
#pragma unroll
      for (int c = 0; c < 8; ++c) {
        float v = bs[c] + w0[c] * xa[c] + w1[c] * xb[c] + w2[c] * xc[c] + w3[c] * xd[c];
        y[c] = lru ? v : silu_f(v);
      }
      *(uint4*)(dst + (size_t)row * nch) = pack8(y);
#pragma unroll
      for (int c = 0; c < 8; ++c) { xa[c] = xb[c]; xb[c] = xc[c]; xc[c] = xd[c]; }
    }
    if ((T & 15) == 15) {
#pragma unroll
      for (int j = 0; j < 3; ++j) {
        unpack8(*(const uint4*)(PROJ + (size_t)(b * 2048 + 2045 + j) * NPAD + srccol), xd);
        float* op = p.out + (lru ? (O_PLC + (size_t)((layer * 8 + b) * 3 + j) * 768) : (O_PSC + (size_t)((layer * 8 + b) * 3 + j) * 1280)) + 8 * oo;
        *(float4*)op = make_float4(xd[0], xd[1], xd[2], xd[3]);
        *(float4*)(op + 4) = make_float4(xd[4], xd[5], xd[6], xd[7]);
      }
    }
  } else {
#pragma unroll 2
    for (int i = 0; i < 16; ++i) {
      const int bi = ru * 16 + i, row = MP + bi;
      const float* st = (lru ? (p.in[4] + (size_t)(layer * 128 + bi) * 3 * 768) : (p.in[6] + (size_t)(layer * 128 + bi) * 3 * 1280)) + 8 * oo;
#pragma unroll
      for (int h = 0; h < 2; ++h) {
        const float4 a = *(const float4*)(st + 0 * nch + 4 * h), b4 = *(const float4*)(st + 1 * nch + 4 * h), c4 = *(const float4*)(st + 2 * nch + 4 * h);
        xa[4 * h] = a.x; xa[4 * h + 1] = a.y; xa[4 * h + 2] = a.z; xa[4 * h + 3] = a.w;
        xb[4 * h] = b4.x; xb[4 * h + 1] = b4.y; xb[4 * h + 2] = b4.z; xb[4 * h + 3] = b4.w;
        xc[4 * h] = c4.x; xc[4 * h + 1] = c4.y; xc[4 * h + 2] = c4.z; xc[4 * h + 3] = c4.w;
      }
      unpack8(*(const uint4*)(PROJ + (size_t)row * NPAD + srccol), xd);
#pragma unroll
      for (int c = 0; c < 8; ++c) {
        float v = bs[c] + w0[c] * xa[c] + w1[c] * xb[c] + w2[c] * xc[c] + w3[c] * xd[c];
        y[c] = lru ? v : silu_f(v);
      }
      *(uint4*)(dst + (size_t)row * nch) = pack8(y);
      float* op = p.out + (lru ? (O_SLC + (size_t)(layer * 128 + bi) * 3 * 768) : (O_SSC + (size_t)(layer * 128 + bi) * 3 * 1280)) + 8 * oo;
      *(float4*)(op) = make_float4(xb[0], xb[1], xb[2], xb[3]);
      *(float4*)(op + 4) = make_float4(xb[4], xb[5], xb[6], xb[7]);
      *(float4*)(op + nch) = make_float4(xc[0], xc[1], xc[2], xc[3]);
      *(float4*)(op + nch + 4) = make_float4(xc[4], xc[5], xc[6], xc[7]);
      *(float4*)(op + 2 * nch) = make_float4(xd[0], xd[1], xd[2], xd[3]);
      *(float4*)(op + 2 * nch + 4) = make_float4(xd[4], xd[5], xd[6], xd[7]);
    }
  }
}

PH void attn_prompt_item(const Params& p, int layer, int item) {
  SMEM;
  const int tid = opaque_tid(), lane = tid & 63, w = tid >> 6, quad = lane >> 4, l15 = lane & 15;
  const int b = item >> 5, nb = (item >> 1) & 15, kvh = item & 1;
  u16* Ks = (u16*)smem;
  u16* Vt = (u16*)(smem + 256 * 72 * 2);
  const u16* PROJ = (const u16*)(p.ws + WS_PROJ);
  u16* MIX = (u16*)(p.ws + WS_MIX);
  const float* ROPE = (const float*)(p.ws + WS_ROPE);
  {
    const int j = tid, t = nb * 128 - 128 + j;
    uint4 kq[8], vq[8];
    if (t >= 0) {
      const u16* src = PROJ + (size_t)(b * 2048 + t) * NPAD;
#pragma unroll
      for (int i = 0; i < 8; ++i) {
        kq[i] = *(const uint4*)(src + C_K + kvh * 64 + i * 8);
        vq[i] = *(const uint4*)(src + C_V + kvh * 64 + i * 8);
      }
    } else {
#pragma unroll
      for (int i = 0; i < 8; ++i) { kq[i] = make_uint4(0, 0, 0, 0); vq[i] = make_uint4(0, 0, 0, 0); }
    }
    float x1[8], x2[8];
    unpack8(kq[0], x1); unpack8(kq[1], x2);
    if (t >= 0) {
      const float* cs = ROPE + (size_t)t * 16;
#pragma unroll
      for (int i = 0; i < 8; ++i) {
        const float c = cs[2 * i], s = cs[2 * i + 1];
        const float r1 = x1[i] * c - x2[i] * s, r2 = x2[i] * c + x1[i] * s;
        x1[i] = r1; x2[i] = r2;
      }
    }
    kq[0] = pack8(x1); kq[1] = pack8(x2);
#pragma unroll
    for (int i = 0; i < 8; ++i) *(uint4*)(Ks + j * 72 + i * 8) = kq[i];
#pragma unroll
    for (int i = 0; i < 8; ++i) {
      Vt[(i * 8 + 0) * 264 + j] = (u16)(vq[i].x & 0xffffu); Vt[(i * 8 + 1) * 264 + j] = (u16)(vq[i].x >> 16);
      Vt[(i * 8 + 2) * 264 + j] = (u16)(vq[i].y & 0xffffu); Vt[(i * 8 + 3) * 264 + j] = (u16)(vq[i].y >> 16);
      Vt[(i * 8 + 4) * 264 + j] = (u16)(vq[i].z & 0xffffu); Vt[(i * 8 + 5) * 264 + j] = (u16)(vq[i].z >> 16);
      Vt[(i * 8 + 6) * 264 + j] = (u16)(vq[i].w & 0xffffu); Vt[(i * 8 + 7) * 264 + j] = (u16)(vq[i].w >> 16);
    }
    if (nb == 15 && j >= 128) {
      float* ok = p.out + O_PK + ((size_t)((layer * 8 + b) * 128 + (j - 128)) * 2 + kvh) * 64;
      float* ov = p.out + O_PV + ((size_t)((layer * 8 + b) * 128 + (j - 128)) * 2 + kvh) * 64;
      *(float4*)(ok + 0) = make_float4(x1[0], x1[1], x1[2], x1[3]);
      *(float4*)(ok + 4) = make_float4(x1[4], x1[5], x1[6], x1[7]);
      *(float4*)(ok + 8) = make_float4(x2[0], x2[1], x2[2], x2[3]);
      *(float4*)(ok + 12) = make_float4(x2[4], x2[5], x2[6], x2[7]);
#pragma unroll
      for (int i = 2; i < 8; ++i) {
        float f[8]; unpack8(kq[i], f);
        *(float4*)(ok + i * 8) = make_float4(f[0], f[1], f[2], f[3]);
        *(float4*)(ok + i * 8 + 4) = make_float4(f[4], f[5], f[6], f[7]);
      }
#pragma unroll
      for (int i = 0; i < 8; ++i) {
        float f[8]; unpack8(vq[i], f);
        *(float4*)(ov + i * 8) = make_float4(f[0], f[1], f[2], f[3]);
        *(float4*)(ov + i * 8 + 4) = make_float4(f[4], f[5], f[6], f[7]);
      }
    }
  }
  __syncthreads();
  const int h = kvh * 4 + w;
  const float sink = p.in[10][layer * 8 + h];
  u32x4 nq[2][3];
#pragma unroll
  for (int qt = 0; qt < 2; ++qt) {
    const u16* src = PROJ + (size_t)(b * 2048 + nb * 128 + qt * 16 + l15) * NPAD + h * 64;
    nq[qt][0] = *(const u32x4*)(src + quad * 8);
    nq[qt][1] = *(const u32x4*)(src + 32 + quad * 8);
    nq[qt][2] = *(const u32x4*)(src + (quad ^ 1) * 8);
  }
#pragma unroll 1
  for (int c = 0; c < 4; ++c) {
    const int q0 = 32 * c;
    u32x4 cq[2][3];
#pragma unroll
    for (int qt = 0; qt < 2; ++qt) { cq[qt][0] = nq[qt][0]; cq[qt][1] = nq[qt][1]; cq[qt][2] = nq[qt][2]; }
    {
      const int qn = 32 * ((c < 3) ? (c + 1) : c);
#pragma unroll
      for (int qt = 0; qt < 2; ++qt) {
        const u16* src = PROJ + (size_t)(b * 2048 + nb * 128 + qn + qt * 16 + l15) * NPAD + h * 64;
        nq[qt][0] = *(const u32x4*)(src + quad * 8);
        nq[qt][1] = *(const u32x4*)(src + 32 + quad * 8);
        nq[qt][2] = *(const u32x4*)(src + (quad ^ 1) * 8);
      }
    }
    uint2 gpre[2][4];
#pragma unroll
    for (int qt = 0; qt < 2; ++qt)
#pragma unroll
      for (int dt = 0; dt < 4; ++dt)
        gpre[qt][dt] = *(const uint2*)(PROJ + (size_t)(b * 2048 + nb * 128 + q0 + qt * 16 + l15) * NPAD + C_GA + h * 64 + dt * 16 + quad * 4);
    bf16x8 qf[2][2];
#pragma unroll
    for (int qt = 0; qt < 2; ++qt) {
      const int qi = q0 + qt * 16 + l15;
      const int tpos = nb * 128 + qi;
      float own[8], o1[8];
      unpack8v(cq[qt][0], own);
      unpack8v(cq[qt][1], o1);
      if (quad < 2) {
        float pr[8];
        unpack8v(cq[qt][2], pr);
        const float* cs = ROPE + (size_t)tpos * 16;
        const float sg = (quad == 0) ? -1.f : 1.f;
#pragma unroll
        for (int i = 0; i < 8; ++i) own[i] = own[i] * cs[2 * i] + sg * pr[i] * cs[2 * i + 1];
      }
#pragma unroll
      for (int i = 0; i < 8; ++i) { own[i] *= 0.125f; o1[i] *= 0.125f; }
      qf[qt][0] = __builtin_bit_cast(bf16x8, pack8(own));
      qf[qt][1] = __builtin_bit_cast(bf16x8, pack8(o1));
    }
    f32x4 s[10][2];
#pragma unroll
    for (int kt = 0; kt < 10; ++kt) { s[kt][0] = (f32x4){0.f, 0.f, 0.f, 0.f}; s[kt][1] = (f32x4){0.f, 0.f, 0.f, 0.f}; }
#pragma unroll
    for (int ks = 0; ks < 2; ++ks)
#pragma unroll
      for (int kt = 0; kt < 10; ++kt) {
        const bf16x8 af = ldfrag(Ks, 72, q0 + kt * 16, ks * 32, lane);
        s[kt][0] = mfma16(af, qf[0][ks], s[kt][0]);
        s[kt][1] = mfma16(af, qf[1][ks], s[kt][1]);
      }
    float inv[2];
    bf16x8 pf[5][2];
#pragma unroll
    for (int qt = 0; qt < 2; ++qt) {
      const int i = q0 + qt * 16 + l15;
      float mx = -INFINITY;
#pragma unroll
      for (int kt = 0; kt < 10; ++kt)
#pragma unroll
        for (int r = 0; r < 4; ++r) {
          const int j = q0 + kt * 16 + quad * 4 + r;
          const bool valid = (j >= i) && (j <= i + 128) && (nb > 0 || j >= 128);
          const float v = valid ? s[kt][qt][r] : -INFINITY;
          s[kt][qt][r] = v;
          mx = fmaxf(mx, v);
        }
      mx = fmaxf(mx, __shfl_xor(mx, 16));
      mx = fmaxf(mx, __shfl_xor(mx, 32));
      mx = fmaxf(mx, sink);
      float sum = 0.f;
#pragma unroll
      for (int kt = 0; kt < 10; ++kt)
#pragma unroll
        for (int r = 0; r < 4; ++r) {
          const float e = __expf(s[kt][qt][r] - mx);
          s[kt][qt][r] = e;
          sum += e;
        }
      sum += __shfl_xor(sum, 16);
      sum += __shfl_xor(sum, 32);
      inv[qt] = 1.f / (sum + __expf(sink - mx));
#pragma unroll
      for (int kk = 0; kk < 5; ++kk) pf[kk][qt] = packfrag(s[2 * kk][qt], s[2 * kk + 1][qt]);
    }
    f32x4 o[4][2];
#pragma unroll
    for (int dt = 0; dt < 4; ++dt) { o[dt][0] = (f32x4){0.f, 0.f, 0.f, 0.f}; o[dt][1] = (f32x4){0.f, 0.f, 0.f, 0.f}; }
#pragma unroll
    for (int kk = 0; kk < 5; ++kk)
#pragma unroll
      for (int dt = 0; dt < 4; ++dt) {
        const bf16x8 vf = ldfrag_perm(Vt, 264, dt * 16, q0 + kk * 32, lane);
        o[dt][0] = mfma16(vf, pf[kk][0], o[dt][0]);
        o[dt][1] = mfma16(vf, pf[kk][1], o[dt][1]);
      }
#pragma unroll
    for (int qt = 0; qt < 2; ++qt) {
      const int qi = q0 + qt * 16 + l15;
      const size_t row = (size_t)(b * 2048 + nb * 128 + qi);
#pragma unroll
      for (int dt = 0; dt < 4; ++dt) {
        const int col = h * 64 + dt * 16 + quad * 4;
        const uint2 gv = gpre[qt][dt];
        const float g0 = bflo(gv.x), g1 = bfhi(gv.x), g2 = bflo(gv.y), g3 = bfhi(gv.y);
        uint2 ov;
        ov.x = pack2(o[dt][qt][0] * inv[qt] * silu_f(g0), o[dt][qt][1] * inv[qt] * silu_f(g1));
        ov.y = pack2(o[dt][qt][2] * inv[qt] * silu_f(g2), o[dt][qt][3] * inv[qt] * silu_f(g3));
        *(uint2*)(MIX + row * 2048 + col) = ov;
      }
    }
  }
}

PH void attn_decode_item(const Params& p, int layer, int item) {
  SMEM;
  const int tid = opaque_tid(), lane = tid & 63, w = tid >> 6;
  const int b = item >> 1, kvh = item & 1;
  float* Kd = (float*)smem;
  float* Vd = Kd + 129 * 65;
  float* qs = Vd + 129 * 64;
  float* ps = qs + 256;
  const u16* PROJ = (const u16*)(p.ws + WS_PROJ);
  u16* MIX = (u16*)(p.ws + WS_MIX);
  const float* ROPE = (const float*)(p.ws + WS_ROPE) + (size_t)2048 * 16;
  const size_t row = (size_t)(MP + b);
  const float* ck = p.in[2] + (size_t)(layer * 128 + b) * 128 * 128;
  const float* cv = p.in[3] + (size_t)(layer * 128 + b) * 128 * 128;
  float* ok = p.out + O_SK + (size_t)(layer * 128 + b) * 128 * 128;
  float* ov = p.out + O_SV + (size_t)(layer * 128 + b) * 128 * 128;
#pragma unroll
  for (int i = 0; i < 8; ++i) {
    const int idx = tid + 256 * i, wi = idx >> 4, c4 = idx & 15;
    const float4 kv = *(const float4*)(ck + (size_t)(wi * 2 + kvh) * 64 + c4 * 4);
    const float4 vv = *(const float4*)(cv + (size_t)(wi * 2 + kvh) * 64 + c4 * 4);
    Kd[wi * 65 + c4 * 4 + 0] = kv.x; Kd[wi * 65 + c4 * 4 + 1] = kv.y; Kd[wi * 65 + c4 * 4 + 2] = kv.z; Kd[wi * 65 + c4 * 4 + 3] = kv.w;
    *(float4*)(Vd + wi * 64 + c4 * 4) = vv;
    if (wi >= 1) {
      *(float4*)(ok + (size_t)((wi - 1) * 2 + kvh) * 64 + c4 * 4) = kv;
      *(float4*)(ov + (size_t)((wi - 1) * 2 + kvh) * 64 + c4 * 4) = vv;
    }
  }
  if (tid < 64) {
    const int d = tid;
    float kx = bf2f(PROJ[row * NPAD + C_K + kvh * 64 + d]);
    if (d < 16) {
      const float pr = bf2f(PROJ[row * NPAD + C_K + kvh * 64 + (d ^ 8)]);
      const float c = ROPE[2 * (d & 7)], s = ROPE[2 * (d & 7) + 1];
      kx = (d < 8) ? (kx * c - pr * s) : (kx * c + pr * s);
    }
    const float vx = bf2f(PROJ[row * NPAD + C_V + kvh * 64 + d]);
    Kd[128 * 65 + d] = kx; Vd[128 * 64 + d] = vx;
    ok[(size_t)(127 * 2 + kvh) * 64 + d] = kx;
    ov[(size_t)(127 * 2 + kvh) * 64 + d] = vx;
  }
  {
    const int g = tid >> 6, d = tid & 63, h = kvh * 4 + g;
    float qx = bf2f(PROJ[row * NPAD + h * 64 + d]);
    if (d < 16) {
      const float pr = bf2f(PROJ[row * NPAD + h * 64 + (d ^ 8)]);
      const float c = ROPE[2 * (d & 7)], s = ROPE[2 * (d & 7) + 1];
      qx = (d < 8) ? (qx * c - pr * s) : (qx * c + pr * s);
    }
    qs[g * 64 + d] = qx * 0.125f;
  }
  __syncthreads();
  const int h = kvh * 4 + w;
  const float sink = p.in[10][layer * 8 + h];
  float s0 = 0.f, s1 = 0.f, s2 = 0.f;
  for (int d = 0; d < 64; ++d) {
    const float qv = qs[w * 64 + d];
    s0 += qv * Kd[lane * 65 + d];
    s1 += qv * Kd[(lane + 64) * 65 + d];
    s2 += qv * Kd[128 * 65 + d];
  }
  float mx = fmaxf(fmaxf(s0, s1), s2);
#pragma unroll
  for (int d = 1; d < 64; d <<= 1) mx = fmaxf(mx, __shfl_xor(mx, d));
  mx = fmaxf(mx, sink);
  const float e0 = __expf(s0 - mx), e1 = __expf(s1 - mx), e2 = __expf(s2 - mx);
  float sum = e0 + e1;
#pragma unroll
  for (int d = 1; d < 64; d <<= 1) sum += __shfl_xor(sum, d);
  const float inv = 1.f / (sum + e2 + __expf(sink - mx));
  ps[w * 132 + lane] = e0 * inv;
  ps[w * 132 + 64 + lane] = e1 * inv;
  if (lane == 0) ps[w * 132 + 128] = e2 * inv;
  __syncthreads();
  float o = 0.f;
  for (int k = 0; k < 129; ++k) o += ps[w * 132 + k] * Vd[k * 64 + lane];
  const float gt = bf2f(PROJ[row * NPAD + C_GA + h * 64 + lane]);
  MIX[row * 2048 + h * 64 + lane] = f2bf(o * silu_f(gt));
}

PH void lru_item(const Params& p, int layer, int b, int n, int dpart) {
  SMEM;
  const int tid = opaque_tid(), lane = tid & 63, w = tid >> 6, quad = lane >> 4, l15 = lane & 15;
  u16* xls = (u16*)smem;
  float* as_ = (float*)(smem + 26624);
  float* bs_ = (float*)(smem + 26624 + 16896);
  float* Pc = (float*)(smem + 60416);
  float* Hc = (float*)(smem + 61440);
  float* hprev = (float*)(smem + 62464);
  const u16* PROJ = (const u16*)(p.ws + WS_PROJ);
  const u16* XL = (const u16*)(p.ws + WS_XL);
  u16* MIX = (u16*)(p.ws + WS_MIX);
  const u16* WA = (const u16*)(p.ws + WS_WA) + (size_t)(layer * 8 + n) * 9216;
  const u16* WX = (const u16*)(p.ws + WS_WX) + (size_t)(layer * 8 + n) * 9216;
  bf16x8 wa[2][3], wx[2][3];
#pragma unroll
  for (int dt = 0; dt < 2; ++dt)
#pragma unroll
    for (int ks = 0; ks < 3; ++ks) {
      const int d = dpart * 32 + dt * 16 + l15, k = ks * 32 + quad * 8;
      wa[dt][ks] = *(const bf16x8*)(WA + d * 96 + k);
      wx[dt][ks] = *(const bf16x8*)(WX + d * 96 + k);
    }
  const int nchunks = (b >= 0) ? 16 : 1;
  const int sch = tid & 31, sub = tid >> 5;
  const int chg = n * 96 + dpart * 32 + sch;
  const float ba = p.in[14][layer * 768 + chg], bx = p.in[16][layer * 768 + chg];
  const float cl = -8.f * softplus_f(-p.in[17][layer * 768 + chg]);
  u32x4 pxl[6];
  u16 pgt[16];
  {
    const int nb_ = (b >= 0) ? (b * 2048) : MP;
#pragma unroll
    for (int i = 0; i < 6; ++i) {
      const int idx = tid + 256 * i, r = idx / 12, c16 = idx % 12;
      pxl[i] = *(const u32x4*)(XL + (size_t)(nb_ + r) * 768 + n * 96 + c16 * 8);
    }
#pragma unroll
    for (int t = 0; t < 16; ++t) pgt[t] = PROJ[(size_t)(nb_ + sub * 16 + t) * NPAD + C_GL + chg];
  }
#pragma unroll 1
  for (int c = 0; c < nchunks; ++c) {
    const int base = (b >= 0) ? (b * 2048 + c * 128) : MP;
#pragma unroll
    for (int i = 0; i < 6; ++i) {
      const int idx = tid + 256 * i, r = idx / 12, c16 = idx % 12;
      *(u32x4*)(xls + r * 104 + c16 * 8) = pxl[i];
    }
    u16 gcur[16];
#pragma unroll
    for (int t = 0; t < 16; ++t) gcur[t] = pgt[t];
    {
      const int nb_ = (c + 1 < nchunks) ? (base + 128) : base;
#pragma unroll
      for (int i = 0; i < 6; ++i) {
        const int idx = tid + 256 * i, r = idx / 12, c16 = idx % 12;
        pxl[i] = *(const u32x4*)(XL + (size_t)(nb_ + r) * 768 + n * 96 + c16 * 8);
      }
#pragma unroll
      for (int t = 0; t < 16; ++t) pgt[t] = PROJ[(size_t)(nb_ + sub * 16 + t) * NPAD + C_GL + chg];
    }
    __syncthreads();
    {
      f32x4 ra[2][2], rx[2][2];
#pragma unroll
      for (int dt = 0; dt < 2; ++dt)
#pragma unroll
        for (int tt = 0; tt < 2; ++tt) { ra[dt][tt] = (f32x4){0.f, 0.f, 0.f, 0.f}; rx[dt][tt] = (f32x4){0.f, 0.f, 0.f, 0.f}; }
#pragma unroll
      for (int ks = 0; ks < 3; ++ks)
#pragma unroll
        for (int tt = 0; tt < 2; ++tt) {
          const bf16x8 xf = ldfrag(xls, 104, (2 * w + tt) * 16, ks * 32, lane);
#pragma unroll
          for (int dt = 0; dt < 2; ++dt) {
            ra[dt][tt] = mfma16(wa[dt][ks], xf, ra[dt][tt]);
            rx[dt][tt] = mfma16(wx[dt][ks], xf, rx[dt][tt]);
          }
        }
#pragma unroll
      for (int dt = 0; dt < 2; ++dt)
#pragma unroll
        for (int tt = 0; tt < 2; ++tt)
#pragma unroll
          for (int r = 0; r < 4; ++r) {
            const int tok = (2 * w + tt) * 16 + l15, dl = dt * 16 + quad * 4 + r;
            as_[tok * 33 + dl] = ra[dt][tt][r];
            bs_[tok * 33 + dl] = rx[dt][tt][r];
          }
    }
    __syncthreads();
    float P = 1.f, H = 0.f;
#pragma unroll
    for (int t = 0; t < 16; ++t) {
      const int tok = sub * 16 + t;
      const float rg = sigmoid_f(as_[tok * 33 + sch] + ba);
      const float ig = sigmoid_f(bs_[tok * 33 + sch] + bx);
      const float la = cl * rg;
      const float xv = bf2f(xls[tok * 104 + dpart * 32 + sch]);
      const float a = __expf(la);
      const float bb = __builtin_amdgcn_sqrtf(-expm1f(2.f * la)) * ig * xv;
      as_[tok * 33 + sch] = a;
      bs_[tok * 33 + sch] = bb;
      H = a * H + bb; P *= a;
    }
    if (b >= 0) {
      Pc[sub * 32 + sch] = P; Hc[sub * 32 + sch] = H;
      __syncthreads();
      float carry = (c == 0) ? 0.f : hprev[(c & 1) * 32 + sch];
#pragma unroll
      for (int s = 0; s < 8; ++s) if (s < sub) carry = Pc[s * 32 + sch] * carry + Hc[s * 32 + sch];
      float hh = carry;
#pragma unroll
      for (int t = 0; t < 16; ++t) {
        const int tok = sub * 16 + t;
        const float a = as_[tok * 33 + sch], bb = bs_[tok * 33 + sch];
        hh = a * hh + bb;
        const size_t row = (size_t)(base + tok);
        const float g = bf2f(gcur[t]);
        MIX[row * 2048 + 512 + chg] = f2bf(hh * silu_f(g));
      }
      if (sub == 7) {
        hprev[((c + 1) & 1) * 32 + sch] = hh;
        if (c == 15) p.out[O_PLH + (size_t)(layer * 8 + b) * 768 + chg] = hh;
      }
    } else {
#pragma unroll
      for (int t = 0; t < 16; ++t) {
        const int tok = sub * 16 + t;
        const float a = as_[tok * 33 + sch], bb = bs_[tok * 33 + sch];
        const float h0 = p.in[5][(size_t)(layer * 128 + tok) * 768 + chg];
        const float hh = a * h0 + bb;
        const size_t row = (size_t)(MP + tok);
        const float g = bf2f(gcur[t]);
        MIX[row * 2048 + 512 + chg] = f2bf(hh * silu_f(g));
        p.out[O_SLH + (size_t)(layer * 128 + tok) * 768 + chg] = hh;
      }
    }
  }
}

constexpr int NSEG = 3;
template <int PROBE, int SONLY, int CPS>
DI void ssd_chunk_loop(const Params& p, int layer, int b, int e, int c0, f32x4 (&h)[8], float& dtot, bool write_final) {
  SMEM;
  const int tid = opaque_tid(), lane = tid & 63, w = tid >> 6, quad = lane >> 4, l15 = lane & 15;
  const int g = e / 6;
  u16* Cs = (u16*)smem;
  u16* Bs = (u16*)(smem + 17408);
  u16* Bt2 = (u16*)(smem + 34816);
  u16* Xt = (u16*)(smem + 53248);
  u16* Ms = (u16*)(smem + 62464);
  float* dt_s = (float*)(smem + 71680);
  float* acs_s = dt_s + 64;
  float* ssq_s = acs_s + 64;
  const u16* PROJ = (const u16*)(p.ws + WS_PROJ);
  const u16* XBC = (const u16*)(p.ws + WS_XBC);
  u16* MIX = (u16*)(p.ws + WS_MIX);
  float* SSQ = (float*)(p.ws + WS_SSQ);
  const float dtb = p.in[20][layer * 12 + e];
  const float ah = -__expf(p.in[21][layer * 12 + e]);
  const float Dv = p.in[22][layer * 12 + e];
  const bool do_store = !(PROBE & 1) || (dtb == 1234.5f);
  u32x4 pc[4], pb[4], px[2];
  u16 pru;
  {
    const int nb_ = b * 2048 + c0 * 64;
#pragma unroll
    for (int i = 0; i < 4; ++i) {
      const int idx = tid + 256 * i, r = idx >> 4, c16 = idx & 15;
      if (!SONLY) pc[i] = *(const u32x4*)(XBC + (size_t)(nb_ + r) * 1280 + 1024 + g * 128 + c16 * 8);
      pb[i] = *(const u32x4*)(XBC + (size_t)(nb_ + r) * 1280 + 768 + g * 128 + c16 * 8);
    }
#pragma unroll
    for (int i = 0; i < 2; ++i) {
      const int idx = tid + 256 * i, r = idx >> 3, c8 = idx & 7;
      px[i] = *(const u32x4*)(XBC + (size_t)(nb_ + r) * 1280 + e * 64 + c8 * 8);
    }
    pru = PROJ[(size_t)(nb_ + lane) * NPAD + C_DT + e];
  }
#pragma unroll 1
  for (int cc = c0; cc < c0 + CPS; ++cc) {
    const int base = b * 2048 + cc * 64;
#pragma unroll
    for (int i = 0; i < 4; ++i) {
      const int idx = tid + 256 * i, r = idx >> 4, c16 = idx & 15;
      if (!SONLY) *(u32x4*)(Cs + r * 136 + c16 * 8) = pc[i];
      *(u32x4*)(Bs + r * 136 + c16 * 8) = pb[i];
    }
    u32x4 xr[2];
    xr[0] = px[0]; xr[1] = px[1];
    if (w == 0) {
      const float dtv = softplus_f(bf2f(pru) + dtb);
      float a = dtv * ah;
#pragma unroll
      for (int d = 1; d < 64; d <<= 1) { const float t = __shfl_up(a, d); if (lane >= d) a += t; }
      dt_s[lane] = dtv; acs_s[lane] = a;
    }
    {
      const int nb_ = b * 2048 + ((cc + 1 < c0 + CPS) ? (cc + 1) : cc) * 64;
#pragma unroll
      for (int i = 0; i < 4; ++i) {
        const int idx = tid + 256 * i, r = idx >> 4, c16 = idx & 15;
        if (!SONLY) pc[i] = *(const u32x4*)(XBC + (size_t)(nb_ + r) * 1280 + 1024 + g * 128 + c16 * 8);
        pb[i] = *(const u32x4*)(XBC + (size_t)(nb_ + r) * 1280 + 768 + g * 128 + c16 * 8);
      }
#pragma unroll
      for (int i = 0; i < 2; ++i) {
        const int idx = tid + 256 * i, r = idx >> 3, c8 = idx & 7;
        px[i] = *(const u32x4*)(XBC + (size_t)(nb_ + r) * 1280 + e * 64 + c8 * 8);
      }
      pru = PROJ[(size_t)(nb_ + lane) * NPAD + C_DT + e];
    }
    uint2 dx[4], dz[4];
    if (!SONLY)
#pragma unroll
    for (int qt = 0; qt < 4; ++qt) {
      const size_t row = (size_t)(base + qt * 16 + l15);
      const int pcol = w * 16 + quad * 4;
      dx[qt] = *(const uint2*)(XBC + row * 1280 + e * 64 + pcol);
      dz[qt] = *(const uint2*)(PROJ + row * NPAD + C_Z + e * 64 + pcol);
    }
    __syncthreads();
    dtot += acs_s[63];
    if (!(PROBE & 2)) {
#pragma unroll
    for (int i = 0; i < 2; ++i) {
      const int idx = tid + 256 * i, r = idx >> 3, c8 = idx & 7;
      const float dtv = dt_s[r];
      float f[8]; unpack8v(xr[i], f);
#pragma unroll
      for (int j = 0; j < 8; ++j) Xt[(c8 * 8 + j) * 72 + r] = f2bf(f[j] * dtv);
    }
    {
      const int q = tid & 63, ng = tid >> 6;
      const float dte = __expf(acs_s[63] - acs_s[q]);
#pragma unroll
      for (int i = 0; i < 8; ++i) {
        const uint2 v = *(const uint2*)(Bs + q * 136 + ng * 32 + i * 4);
        Bt2[(ng * 32 + i * 4 + 0) * 72 + q] = f2bf(bflo(v.x) * dte);
        Bt2[(ng * 32 + i * 4 + 1) * 72 + q] = f2bf(bfhi(v.x) * dte);
        Bt2[(ng * 32 + i * 4 + 2) * 72 + q] = f2bf(bflo(v.y) * dte);
        Bt2[(ng * 32 + i * 4 + 3) * 72 + q] = f2bf(bfhi(v.y) * dte);
      }
    }
    }
    __syncthreads();
    if (!(PROBE & 4) && !SONLY) {
      const int q = w * 16 + l15;
      const float aq = acs_s[q];
      bf16x8 cfr[4];
#pragma unroll
      for (int ks = 0; ks < 4; ++ks) cfr[ks] = ldfrag(Cs, 136, w * 16, ks * 32, lane);
#pragma unroll
      for (int st = 0; st < 4; ++st) {
        uint2 ov;
        const int s0 = st * 16 + quad * 4;
        {
          f32x4 acc = (f32x4){0.f, 0.f, 0.f, 0.f};
#pragma unroll
          for (int ks = 0; ks < 4; ++ks) acc = mfma16(ldfrag(Bs, 136, st * 16, ks * 32, lane), cfr[ks], acc);
          float v[4];
#pragma unroll
          for (int r = 0; r < 4; ++r) { const int s = s0 + r; v[r] = (s <= q) ? acc[r] * __expf(fminf(aq - acs_s[s], 0.f)) : 0.f; }
          ov.x = pack2(v[0], v[1]); ov.y = pack2(v[2], v[3]);
        }
        *(uint2*)(Ms + q * 72 + s0) = ov;
      }
    }
    f32x4 y[4];
#pragma unroll
    for (int qt = 0; qt < 4; ++qt) y[qt] = (f32x4){0.f, 0.f, 0.f, 0.f};
    if (!(PROBE & 4) && !SONLY)
#pragma unroll
    for (int kk = 0; kk < 4; ++kk) {
      const bf16x8 hf = packfrag(h[2 * kk], h[2 * kk + 1]);
#pragma unroll
      for (int qt = 0; qt < 4; ++qt) y[qt] = mfma16(hf, ldfrag_perm(Cs, 136, qt * 16, kk * 32, lane), y[qt]);
    }
    if (!SONLY) {
#pragma unroll
    for (int qt = 0; qt < 4; ++qt) y[qt] *= __expf(acs_s[qt * 16 + l15]);
    __syncthreads();
    }
    if (!(PROBE & 8) && !SONLY)
#pragma unroll
    for (int qt = 0; qt < 4; ++qt)
#pragma unroll
      for (int ks = 0; ks < 2; ++ks)
        if (ks == 0 || qt >= 2) y[qt] = mfma16(ldfrag(Xt, 72, w * 16, ks * 32, lane), ldfrag(Ms, 72, qt * 16, ks * 32, lane), y[qt]);
    if (!(PROBE & 8)) {
      const float cd = __expf(acs_s[63]);
#pragma unroll
      for (int nt = 0; nt < 8; ++nt) h[nt] *= cd;
#pragma unroll
      for (int ks = 0; ks < 2; ++ks) {
        const bf16x8 xf = ldfrag(Xt, 72, w * 16, ks * 32, lane);
#pragma unroll
        for (int nt = 0; nt < 8; ++nt) h[nt] = mfma16(ldfrag(Bt2, 72, nt * 16, ks * 32, lane), xf, h[nt]);
      }
    }
    if (!SONLY)
#pragma unroll
    for (int qt = 0; qt < 4; ++qt) {
      const int q = qt * 16 + l15;
      const size_t row = (size_t)(base + q);
      const int pcol = w * 16 + quad * 4;
      const uint2 xv = dx[qt];
      const uint2 zv = dz[qt];
      const float y0 = (y[qt][0] + Dv * bflo(xv.x)) * silu_f(bflo(zv.x));
      const float y1 = (y[qt][1] + Dv * bfhi(xv.x)) * silu_f(bfhi(zv.x));
      const float y2 = (y[qt][2] + Dv * bflo(xv.y)) * silu_f(bflo(zv.y));
      const float y3 = (y[qt][3] + Dv * bfhi(xv.y)) * silu_f(bfhi(zv.y));
      uint2 ov; ov.x = pack2(y0, y1); ov.y = pack2(y2, y3);
      if (do_store) *(uint2*)(MIX + row * 2048 + 1280 + e * 64 + pcol) = ov;
      float ss = y0 * y0 + y1 * y1 + y2 * y2 + y3 * y3;
      ss += __shfl_xor(ss, 16);
      ss += __shfl_xor(ss, 32);
      if (quad == 0) ssq_s[w * 64 + q] = ss;
    }
    __syncthreads();
    if (do_store && !SONLY) if (tid < 64) SSQ[(size_t)(base + tid) * 12 + e] = ssq_s[tid] + ssq_s[64 + tid] + ssq_s[128 + tid] + ssq_s[192 + tid];
  }
  if (do_store && write_final) {
    float* oh = p.out + O_PSH + (size_t)((layer * 8 + b) * 12 + e) * 64 * 128;
    const int pidx = w * 16 + l15;
#pragma unroll
    for (int nt = 0; nt < 8; ++nt) {
      const int n = nt * 16 + quad * 4;
      *(float4*)(oh + (size_t)pidx * 128 + n) = make_float4(h[nt][0], h[nt][1], h[nt][2], h[nt][3]);
    }
  }
}


DI unsigned flag_ld(unsigned* f) { return __hip_atomic_load(f, __ATOMIC_RELAXED, __HIP_MEMORY_SCOPE_AGENT); }
template <int PROBE>
PH void ssd_prompt_item(const Params& p, int layer, int b, int e, int seg) {
  const int tid = opaque_tid(), lane = tid & 63, w = tid >> 6, quad = lane >> 4, l15 = lane & 15;
  float* SEND = (float*)(p.ws + WS_SEND) + (size_t)((layer * 96 + b * 12 + e) * NSEG) * 8192;
  unsigned* SFLAG = (unsigned*)(p.ws + WS_SFLAG) + (layer * 96 + b * 12 + e) * NSEG;
  f32x4 h[8];
#pragma unroll
  for (int i = 0; i < 8; ++i) h[i] = (f32x4){0.f, 0.f, 0.f, 0.f};
  float dtot = 0.f;
  const size_t eoff = (size_t)(w * 16 + l15) * 128 + quad * 4;
  if (seg < NSEG - 1) ssd_chunk_loop<PROBE, 1, 10>(p, layer, b, e, seg * 10, h, dtot, false);
  if (seg > 0) {
    if (tid == 0) {
      unsigned sp = 0;
      while (flag_ld(SFLAG + seg - 1) == 0u) { __builtin_amdgcn_s_sleep(2); if (++sp > (1u << 22)) break; }
    }
    __syncthreads();
    __builtin_amdgcn_fence(__ATOMIC_ACQUIRE, "agent");
    asm volatile("s_waitcnt vmcnt(0)" ::: "memory");
    const float* hin = SEND + (size_t)(seg - 1) * 8192 + eoff;
    const float fdec = __expf(dtot);
#pragma unroll
    for (int nt = 0; nt < 8; ++nt) {
      const float4 v = *(const float4*)(hin + nt * 16);
      const f32x4 hv = (f32x4){v.x, v.y, v.z, v.w};
      if (seg < NSEG - 1) {
        const f32x4 he = fdec * hv + h[nt];
        *(float4*)(SEND + (size_t)seg * 8192 + eoff + nt * 16) = make_float4(he[0], he[1], he[2], he[3]);
      }
      h[nt] = hv;
    }
  } else {
#pragma unroll
    for (int nt = 0; nt < 8; ++nt) {
      *(float4*)(SEND + eoff + nt * 16) = make_float4(h[nt][0], h[nt][1], h[nt][2], h[nt][3]);
      h[nt] = (f32x4){0.f, 0.f, 0.f, 0.f};
    }
  }
  if (seg < NSEG - 1) {
    __builtin_amdgcn_fence(__ATOMIC_RELEASE, "agent");
    asm volatile("s_waitcnt vmcnt(0)" ::: "memory");
    __syncthreads();
    if (tid == 0) __hip_atomic_store(SFLAG + seg, 1u, __ATOMIC_RELAXED, __HIP_MEMORY_SCOPE_AGENT);
  }
  float dummy = 0.f;
  if (seg < NSEG - 1) ssd_chunk_loop<PROBE, 0, 10>(p, layer, b, e, seg * 10, h, dummy, false);
  else ssd_chunk_loop<PROBE, 0, 12>(p, layer, b, e, 20, h, dummy, true);
}

PH void ssd_decode_item(const Params& p, int layer, int b, int e) {
  SMEM;
  const int tid = opaque_tid();
  const int g = e / 6;
  float* xs_s = (float*)smem;
  float* Bv = xs_s + 64;
  float* Cv = Bv + 128;
  float* ys = Cv + 128;
  const u16* PROJ = (const u16*)(p.ws + WS_PROJ);
  const u16* XBC = (const u16*)(p.ws + WS_XBC);
  u16* MIX = (u16*)(p.ws + WS_MIX);
  float* SSQ = (float*)(p.ws + WS_SSQ);
  const size_t row = (size_t)(MP + b);
  const float* h0 = p.in[7] + (size_t)((layer * 128 + b) * 12 + e) * 64 * 128;
  float* h1 = p.out + O_SSH + (size_t)((layer * 128 + b) * 12 + e) * 64 * 128;
  const int n4 = tid & 31;
  f32x4 hv[8];
  u16 zv[8];
#pragma unroll
  for (int i = 0; i < 8; ++i) {
    const int pidx = (tid >> 5) + 8 * i;
    hv[i] = *(const f32x4*)(h0 + (size_t)pidx * 128 + n4 * 4);
    zv[i] = PROJ[row * NPAD + C_Z + e * 64 + pidx];
  }
  const u16 xsr = XBC[row * 1280 + e * 64 + (tid & 63)];
  const u16 bvr = XBC[row * 1280 + 768 + g * 128 + (tid & 127)];
  const u16 cvr = XBC[row * 1280 + 1024 + g * 128 + (tid & 127)];
  const float dtv = softplus_f(bf2f(PROJ[row * NPAD + C_DT + e]) + p.in[20][layer * 12 + e]);
  const float dA = __expf(dtv * (-__expf(p.in[21][layer * 12 + e])));
  const float Dv = p.in[22][layer * 12 + e];
  if (tid < 64) xs_s[tid] = bf2f(xsr);
  if (tid < 128) { Bv[tid] = bf2f(bvr); Cv[tid] = bf2f(cvr); }
  __syncthreads();
  const float4 Bq = *(const float4*)(Bv + n4 * 4), Cq = *(const float4*)(Cv + n4 * 4);
#pragma unroll
  for (int i = 0; i < 8; ++i) {
    const int pidx = (tid >> 5) + 8 * i;
    const float xsv = xs_s[pidx];
    const float xdt = dtv * xsv;
    f32x4 hn;
    hn[0] = dA * hv[i][0] + xdt * Bq.x; hn[1] = dA * hv[i][1] + xdt * Bq.y; hn[2] = dA * hv[i][2] + xdt * Bq.z; hn[3] = dA * hv[i][3] + xdt * Bq.w;
    *(f32x4*)(h1 + (size_t)pidx * 128 + n4 * 4) = hn;
    float part = Cq.x * hn[0] + Cq.y * hn[1] + Cq.z * hn[2] + Cq.w * hn[3];
#pragma unroll
    for (int d = 1; d < 32; d <<= 1) part += __shfl_xor(part, d);
    if (n4 == 0) ys[pidx] = (part + Dv * xsv) * silu_f(bf2f(zv[i]));
  }
  __syncthreads();
  if (tid < 64) {
    const float v = ys[tid];
    MIX[row * 2048 + 1280 + e * 64 + tid] = f2bf(v);
    float ss = v * v;
#pragma unroll
    for (int d = 1; d < 64; d <<= 1) ss += __shfl_xor(ss, d);
    if (tid == 0) SSQ[row * 12 + e] = ss;
  }
}

#define XB_TMO      128
#define XB_XCNT(j)  (256  + 64 * (j))
#define XB_XSUB(j)  (1280 + 64 * (j))
#define XB_XGEN(j)  (2304 + 64 * (j))
#define XB_TOP      3328
#define XB_TOPGEN   3392
#define XCD_BAR_WORDS 3456
#define XB_SPIN_CAP (1u << 18)
#define LAS __attribute__((address_space(3)))
DI unsigned xb_ld(unsigned* p)              { return __hip_atomic_load(p, __ATOMIC_RELAXED, __HIP_MEMORY_SCOPE_AGENT); }
DI unsigned xb_add(unsigned* p, unsigned v) { return __hip_atomic_fetch_add(p, v, __ATOMIC_RELAXED, __HIP_MEMORY_SCOPE_AGENT); }
DI unsigned xb_xcc_id() { return (unsigned)__builtin_amdgcn_s_getreg((3 << 11) | 20) & 0xFu; }
#define XB_SPIN(cond, bar) do { unsigned _sp = 0; while (cond) { __builtin_amdgcn_s_sleep(1); \
    if ((++_sp & 255u) == 0u) { if (xb_ld(&(bar)[XB_TMO])) break; if (_sp > XB_SPIN_CAP) { atomicAdd(&(bar)[XB_TMO], 1u); break; } } } } while (0)
struct XcdBarrier { unsigned* bar; unsigned x; volatile LAS unsigned* st; };
DI XcdBarrier xcd_barrier_post(unsigned* bar, volatile LAS unsigned* st) {
  XcdBarrier b; b.bar = bar; b.x = xb_xcc_id(); b.st = st;
  if (threadIdx.x == 0) (void)xb_add(&bar[XB_XCNT(b.x)], 1u);
  return b;
}
DI void xcd_barrier_complete(unsigned* bar, unsigned x, unsigned& nloc, unsigned& nx) {
  const unsigned G = gridDim.x * gridDim.y * gridDim.z;
  unsigned sum, cnt, mine, sp = 0u;
  for (;;) {
    sum = 0u; cnt = 0u; mine = 0u;
#pragma unroll
    for (unsigned j = 0; j < 16; ++j) { const unsigned c = xb_ld(&bar[XB_XCNT(j)]); sum += c; cnt += (c > 0u) ? 1u : 0u; mine = (j == x) ? c : mine; }
    if (sum == G) break;
    __builtin_amdgcn_s_sleep(1);
    if ((++sp & 255u) == 0u) { if (xb_ld(&bar[XB_TMO])) break; if (sp > XB_SPIN_CAP) { atomicAdd(&bar[XB_TMO], 1u); break; } }
  }
  nloc = mine > 0u ? mine : 1u; nx = cnt > 0u ? cnt : 1u;
}
DI void xcd_barrier(const XcdBarrier& b) {
  asm volatile("s_waitcnt vmcnt(0)" ::: "memory");
  __syncthreads();
  if (threadIdx.x == 0) {
    unsigned* bar = b.bar;
    __builtin_amdgcn_s_waitcnt(0);
    unsigned nloc = b.st[0], nx = b.st[1];
    if (nloc == 0u) { xcd_barrier_complete(bar, b.x, nloc, nx); b.st[0] = nloc; b.st[1] = nx; }
    const unsigned old = xb_add(&bar[XB_XSUB(b.x)], 1u);
    const unsigned gen = old / nloc;
    if (old + 1u == (gen + 1u) * nloc) {
      __builtin_amdgcn_fence(__ATOMIC_RELEASE, "agent");
      asm volatile("s_waitcnt vmcnt(0)" ::: "memory");
      const unsigned og = xb_add(&bar[XB_TOP], 1u);
      const unsigned tg = og / nx;
      if (og + 1u == (tg + 1u) * nx) xb_add(&bar[XB_TOPGEN], 1u);
      else XB_SPIN(xb_ld(&bar[XB_TOPGEN]) == tg, bar);
      __builtin_amdgcn_fence(__ATOMIC_ACQUIRE, "agent");
      xb_add(&bar[XB_XGEN(b.x)], 1u);
      asm volatile("s_waitcnt vmcnt(0)" ::: "memory");
    } else {
      XB_SPIN(xb_ld(&bar[XB_XGEN(b.x)]) == gen, bar);
      __builtin_amdgcn_fence(__ATOMIC_ACQUIRE, "agent");
      asm volatile("s_waitcnt vmcnt(0)" ::: "memory");
    }
  }
  __syncthreads();
}

#define REP_PREP 1
#define REP_G0 1
#define REP_2A 1
#define REP_2B 1
#define REP_G1 1
#define REP_LN 1
#define REP_SYNC 0
#define PROBE_SSD 0
#define PROBE_2B_LO 0
#define PROBE_2B_HI 96
__global__ void __launch_bounds__(256, 2) mega(Params p) {
  __shared__ int slot;
  __shared__ uint4 xb_words;
  cg::grid_group grid = cg::this_grid();
  unsigned* ctr = (unsigned*)(p.ws + WS_CTR);
  if (threadIdx.x == 0) xb_words = make_uint4(0u, 0u, 0u, 0u);
  __syncthreads();
  XcdBarrier xb = xcd_barrier_post((unsigned*)(p.ws + WS_BAR), (volatile LAS unsigned*)&xb_words);
  if (p.ws == nullptr) grid.sync();
  for (int rep = 0; rep < REP_PREP; ++rep) { phase_prep(p); xcd_barrier(xb); }
#pragma unroll 1
  for (int layer = 0; layer < 4; ++layer) {
    for (int rep = 0; rep < REP_G0; ++rep) { gemm_phase<0>(p, layer); xcd_barrier(xb); }
    for (int rep = 0; rep < REP_2A; ++rep) {
      for (;;) {
        int it = next_item(ctr + layer * 2 + 8 * rep, &slot);
        if (it >= 136 + 512) break;
        it = (it < 512) ? (it + 136) : (it - 512);
        if (it < 136) conv_unit(p, layer, it);
        else if (it < 392) attn_prompt_item(p, layer, it - 136);
        else attn_decode_item(p, layer, it - 392);
      }
      xcd_barrier(xb);
    }
    for (int rep = 0; rep < REP_2B; ++rep) {
      for (;;) {
        int it = next_item(ctr + layer * 2 + 1 + 8 * rep, &slot);
        if (rep > 0) { it += PROBE_2B_LO; if (it >= PROBE_2B_HI) break; }
        if (it >= 288 + 192 + 24 + 1536) break;
        it = (it < 192) ? (it + 384) : ((it < 480) ? (it - 192) : (it + 608));
        if (it < 384) { const int v = it % 96; ssd_prompt_item<0>(p, layer, v / 12, v % 12, it / 96); }
        else if (it < 576) { const int v = it - 384; lru_item(p, layer, v / 24, (v % 24) / 3, v % 3); }
        else if (it < 832) attn_prompt_item(p, layer, it - 576);
        else if (it < 1088) attn_decode_item(p, layer, it - 832);
        else if (it < 1112) { const int v = it - 1088; lru_item(p, layer, -1, v / 3, v % 3); }
        else { const int v = it - 1112; ssd_decode_item(p, layer, v / 12, v % 12); }
      }
      xcd_barrier(xb);
    }
    for (int rep = 0; rep < REP_G1; ++rep) { gemm_phase<1>(p, layer); xcd_barrier(xb); }
    for (int rep = 0; rep < REP_LN; ++rep) { ln_phase(p, layer); xcd_barrier(xb); }
    for (int rep = 0; rep < REP_SYNC; ++rep) xcd_barrier(xb);
  }
}

extern "C" void kernel_launch(void* const* d_in, const int* in_sizes, int n_in,
                              void* d_out, int out_size, void* d_ws, size_t ws_size,
                              hipStream_t stream) {
  static int grid_blocks = 0;
  if (grid_blocks == 0) {
    if (n_in != 26 || ws_size < WS_END) { fprintf(stderr, "kernel_launch: unexpected n_in %d or ws_size %zu (< %zu)\n", n_in, ws_size, (size_t)WS_END); grid_blocks = -1; return; }
    int dev = 0, cus = 0, per_cu = 0;
    hipGetDevice(&dev);
    hipDeviceGetAttribute(&cus, hipDeviceAttributeMultiprocessorCount, dev);
    if (hipFuncSetAttribute((const void*)mega, hipFuncAttributeMaxDynamicSharedMemorySize, LDS_BYTES) != hipSuccess) { fprintf(stderr, "kernel_launch: hipFuncSetAttribute failed\n"); grid_blocks = -1; return; }
    if (hipOccupancyMaxActiveBlocksPerMultiprocessor(&per_cu, (const void*)mega, 256, LDS_BYTES) != hipSuccess || per_cu < 1) { fprintf(stderr, "kernel_launch: occupancy query failed (%d)\n", per_cu); grid_blocks = -1; return; }
    if (per_cu > 2) per_cu = 2;
    grid_blocks = cus * per_cu;
  }
  if (grid_blocks < 0) return;
  Params p{};
  for (int i = 0; i < 26; ++i) p.in[i] = (const float*)d_in[i];
  p.out = (float*)d_out;
  p.ws = (char*)d_ws;
  if (hipMemsetAsync((char*)d_ws + WS_BAR, 0, 16384, stream) != hipSuccess) { fprintf(stderr, "kernel_launch: memset of barrier words failed\n"); return; }
  void* args[] = {&p};
  hipError_t e = hipLaunchCooperativeKernel((const void*)mega, dim3(grid_blocks), dim3(256), args, LDS_BYTES, stream);
  if (e != hipSuccess) fprintf(stderr, "cooperative launch failed: %s (grid %d)\n", hipGetErrorString(e), grid_blocks);
}
```

```cpp
#include <hip/hip_runtime.h>
#include <hip/hip_cooperative_groups.h>
#include <cstdio>
namespace cg = cooperative_groups;

#define DI __device__ __forceinline__
#define PH __device__ __forceinline__
#define SMEM extern __shared__ __attribute__((aligned(16))) char smem[]
typedef unsigned short u16;
using bf16x8 = __attribute__((ext_vector_type(8))) short;
using f32x4 = __attribute__((ext_vector_type(4))) float;
using u32x4 = __attribute__((ext_vector_type(4))) unsigned;

constexpr int MP = 16384, MT = 16512;
constexpr int NPAD = 4992;
constexpr int C_K = 512, C_V = 640, C_GA = 768, C_XL = 1280, C_GL = 2048, C_Z = 2816, C_XBC = 3584, C_DT = 4864;
constexpr int LDS_BYTES = 73728;

constexpr size_t WS_WIN = 0;
constexpr size_t WS_WOUT = WS_WIN + (size_t)4 * NPAD * 1024 * 2;
constexpr size_t WS_WA = WS_WOUT + (size_t)4 * 1024 * 2048 * 2;
constexpr size_t WS_WX = WS_WA + (size_t)4 * 8 * 96 * 96 * 2;
constexpr size_t WS_XB = WS_WX + (size_t)4 * 8 * 96 * 96 * 2;
constexpr size_t WS_XF = WS_XB + (size_t)MT * 1024 * 2;
constexpr size_t WS_PRE = WS_XF + (size_t)MT * 1024 * 4;
constexpr size_t WS_PROJ = WS_PRE + (size_t)MT * 1024 * 4;
constexpr size_t WS_XL = WS_PROJ + (size_t)MT * NPAD * 2;
constexpr size_t WS_XBC = WS_XL + (size_t)MT * 768 * 2;
constexpr size_t WS_MIX = WS_XBC + (size_t)MT * 1280 * 2;
constexpr size_t WS_SSQ = WS_MIX + (size_t)MT * 2048 * 2;
constexpr size_t WS_ROPE = WS_SSQ + (size_t)MT * 12 * 4;
constexpr size_t WS_CTR = WS_ROPE + 131328;
constexpr size_t WS_SFLAG = WS_CTR + 256;
constexpr size_t WS_SEND = WS_SFLAG + 8192;
constexpr size_t WS_BAR = WS_SEND + (size_t)4 * 96 * 4 * 8192 * 4;
constexpr size_t WS_END = WS_BAR + 16384;

constexpr size_t O_YP = 0;
constexpr size_t O_YS = O_YP + (size_t)8 * 2048 * 1024;
constexpr size_t O_PK = O_YS + (size_t)128 * 1024;
constexpr size_t O_PV = O_PK + (size_t)4 * 8 * 128 * 2 * 64;
constexpr size_t O_PLC = O_PV + (size_t)4 * 8 * 128 * 2 * 64;
constexpr size_t O_PLH = O_PLC + (size_t)4 * 8 * 3 * 768;
constexpr size_t O_PSC = O_PLH + (size_t)4 * 8 * 768;
constexpr size_t O_PSH = O_PSC + (size_t)4 * 8 * 3 * 1280;
constexpr size_t O_SK = O_PSH + (size_t)4 * 8 * 12 * 64 * 128;
constexpr size_t O_SV = O_SK + (size_t)4 * 128 * 128 * 2 * 64;
constexpr size_t O_SLC = O_SV + (size_t)4 * 128 * 128 * 2 * 64;
constexpr size_t O_SLH = O_SLC + (size_t)4 * 128 * 3 * 768;
constexpr size_t O_SSC = O_SLH + (size_t)4 * 128 * 768;
constexpr size_t O_SSH = O_SSC + (size_t)4 * 128 * 3 * 1280;

struct Params {
  const float* in[26];
  float* out;
  char* ws;
};

typedef __bf16 bf2_t __attribute__((ext_vector_type(2)));
typedef float fl2_t __attribute__((ext_vector_type(2)));
DI u16 f2bf(float x) { return __builtin_bit_cast(u16, (__bf16)x); }
DI float bf2f(u16 b) { return __uint_as_float(((unsigned)b) << 16); }
DI unsigned pack2(float a, float b) { fl2_t v = {a, b}; return __builtin_bit_cast(unsigned, __builtin_convertvector(v, bf2_t)); }
DI float bflo(unsigned u) { return __uint_as_float(u << 16); }
DI float bfhi(unsigned u) { return __uint_as_float(u & 0xffff0000u); }
DI void unpack8(uint4 v, float* f) {
  f[0] = bflo(v.x); f[1] = bfhi(v.x); f[2] = bflo(v.y); f[3] = bfhi(v.y);
  f[4] = bflo(v.z); f[5] = bfhi(v.z); f[6] = bflo(v.w); f[7] = bfhi(v.w);
}
DI void unpack8v(u32x4 v, float* f) {
  f[0] = bflo(v[0]); f[1] = bfhi(v[0]); f[2] = bflo(v[1]); f[3] = bfhi(v[1]);
  f[4] = bflo(v[2]); f[5] = bfhi(v[2]); f[6] = bflo(v[3]); f[7] = bfhi(v[3]);
}
DI uint4 pack8(const float* f) {
  uint4 v; v.x = pack2(f[0], f[1]); v.y = pack2(f[2], f[3]); v.z = pack2(f[4], f[5]); v.w = pack2(f[6], f[7]); return v;
}
DI f32x4 mfma16(bf16x8 a, bf16x8 b, f32x4 c) { return __builtin_amdgcn_mfma_f32_16x16x32_bf16(a, b, c, 0, 0, 0); }
DI bf16x8 ldfrag(const u16* base, int ld, int row0, int k0, int lane) {
  return *(const bf16x8*)(base + (row0 + (lane & 15)) * ld + k0 + (lane >> 4) * 8);
}
DI bf16x8 ldfrag_perm(const u16* base, int ld, int row0, int k0, int lane) {
  const u16* pp = base + (row0 + (lane & 15)) * ld + k0 + (lane >> 4) * 4;
  uint2 a = *(const uint2*)pp; uint2 b = *(const uint2*)(pp + 16);
  uint4 v; v.x = a.x; v.y = a.y; v.z = b.x; v.w = b.y;
  return __builtin_bit_cast(bf16x8, v);
}
DI bf16x8 packfrag(f32x4 t0, f32x4 t1) {
  uint4 v; v.x = pack2(t0[0], t0[1]); v.y = pack2(t0[2], t0[3]); v.z = pack2(t1[0], t1[1]); v.w = pack2(t1[2], t1[3]);
  return __builtin_bit_cast(bf16x8, v);
}
DI float silu_f(float x) { return x * __builtin_amdgcn_rcpf(1.f + __expf(-x)); }
DI float sigmoid_f(float x) { return __builtin_amdgcn_rcpf(1.f + __expf(-x)); }
DI float softplus_f(float x) { return x > 20.f ? x : log1pf(__expf(x)); }

DI int opaque_tid() { int t = threadIdx.x; asm volatile("" : "+v"(t)); return t; }
DI int next_item(unsigned* ctr, int* slot) {
  __syncthreads();
  if (threadIdx.x == 0) *slot = (int)atomicAdd(ctr, 1u);
  __syncthreads();
  return *slot;
}

PH void phase_prep(const Params& p) {
  SMEM;
  const int tid = opaque_tid();
  float* tile = (float*)smem;
  u16* WinT = (u16*)(p.ws + WS_WIN);
  u16* WoutT = (u16*)(p.ws + WS_WOUT);
  u16* Xb = (u16*)(p.ws + WS_XB);
  float* ROPE = (float*)(p.ws + WS_ROPE);
  unsigned* ctr = (unsigned*)(p.ws + WS_CTR);
  if (blockIdx.x == 0 && tid < 64) ctr[tid] = 0u;
  if (blockIdx.x == 1) { unsigned* sf = (unsigned*)(p.ws + WS_SFLAG); for (int i = tid; i < 2048; i += 256) sf[i] = 0u; }
  constexpr int U_WIN = 4 * 16 * 78;
  constexpr int U_WOUT = 4 * 32 * 16;
  constexpr int U_LW = 64;
  constexpr int U_XB = MT * 1024 / 2048;
  constexpr int U_ROPE = 65;
  constexpr int U_TOT = U_WIN + U_WOUT + U_LW + U_XB + U_ROPE;
  for (int u = blockIdx.x; u < U_TOT; u += gridDim.x) {
    if (u < U_WIN) {
      const int l = u / (16 * 78), r = u % (16 * 78), kt = r / 78, nt = r % 78;
      const float* src = p.in[8] + (size_t)l * 1024 * 4876;
#pragma unroll
      for (int i = 0; i < 16; ++i) {
        const int k = (tid >> 6) + 4 * i, n = nt * 64 + (tid & 63);
        tile[k * 65 + (tid & 63)] = (n < 4876) ? src[(size_t)(kt * 64 + k) * 4876 + n] : 0.f;
      }
      __syncthreads();
      u16* dst = WinT + (size_t)l * NPAD * 1024;
#pragma unroll
      for (int i = 0; i < 8; ++i) {
        const int nn = (tid >> 5) + 8 * i, k = (tid & 31) * 2;
        *(unsigned*)(dst + (size_t)(nt * 64 + nn) * 1024 + kt * 64 + k) = pack2(tile[k * 65 + nn], tile[(k + 1) * 65 + nn]);
      }
      __syncthreads();
    } else if (u < U_WIN + U_WOUT) {
      const int v = u - U_WIN;
      const int l = v / (32 * 16), r = v % (32 * 16), kt = r / 16, nt = r % 16;
      const float* src = p.in[9] + (size_t)l * 2048 * 1024;
      const float* ng = p.in[23] + l * 768;
#pragma unroll
      for (int i = 0; i < 16; ++i) {
        const int k = (tid >> 6) + 4 * i, kg = kt * 64 + k;
        const float sc = (kg >= 1280) ? ng[kg - 1280] : 1.f;
        tile[k * 65 + (tid & 63)] = src[(size_t)kg * 1024 + nt * 64 + (tid & 63)] * sc;
      }
      __syncthreads();
      u16* dst = WoutT + (size_t)l * 1024 * 2048;
#pragma unroll
      for (int i = 0; i < 8; ++i) {
        const int nn = (tid >> 5) + 8 * i, k = (tid & 31) * 2;
        *(unsigned*)(dst + (size_t)(nt * 64 + nn) * 2048 + kt * 64 + k) = pack2(tile[k * 65 + nn], tile[(k + 1) * 65 + nn]);
      }
      __syncthreads();
    } else if (u < U_WIN + U_WOUT + U_LW) {
      const int v = u - U_WIN - U_WOUT;
      const int l = v / 16, rem = v % 16, n = rem / 2, which = rem % 2;
      const float* src = (which ? p.in[15] : p.in[13]) + (size_t)(l * 8 + n) * 9216;
      u16* dst = (u16*)(p.ws + (which ? WS_WX : WS_WA)) + (size_t)(l * 8 + n) * 9216;
      for (int e = tid; e < 9216; e += 256) {
        const int d = e / 96, c = e % 96;
        dst[e] = f2bf(src[c * 96 + d]);
      }
    } else if (u < U_WIN + U_WOUT + U_LW + U_XB) {
      const int v = u - U_WIN - U_WOUT - U_LW;
      const size_t ge = (size_t)v * 2048 + (size_t)tid * 8;
      const float* src = (ge < (size_t)MP * 1024) ? (p.in[0] + ge) : (p.in[1] + (ge - (size_t)MP * 1024));
      const float4 a = *(const float4*)src, b = *(const float4*)(src + 4);
      uint4 o; o.x = pack2(a.x, a.y); o.y = pack2(a.z, a.w); o.z = pack2(b.x, b.y); o.w = pack2(b.z, b.w);
      *(uint4*)(Xb + ge) = o;
    } else {
      const int v = u - U_WIN - U_WOUT - U_LW - U_XB;
      const int e = v * 256 + tid;
      if (e < 2049 * 8) {
        const int pi = e >> 3, i = e & 7;
        const double pos = (pi < 2048) ? (double)pi : 8192.0;
        const double inv = pow(500000.0, -(double)i / 8.0);
        double sn, cs; sincos(pos * inv, &sn, &cs);
        ROPE[e * 2 + 0] = (float)cs; ROPE[e * 2 + 1] = (float)sn;
      }
    }
  }
}

DI void tile_coords(int t, int NTN, int& m0, int& n0) {
  const int panel = t / (8 * NTN), within = t % (8 * NTN);
  int tm, tn;
  if (panel < 16) { tn = within >> 3; tm = panel * 8 + (within & 7); } else { tm = 128; tn = t - 16 * 8 * NTN; }
  m0 = tm * 128; n0 = tn * 128;
}
template <int MODE>
PH void gemm_phase(const Params& p, int layer) {
  SMEM;
  constexpr int K = (MODE == 0) ? 1024 : 2048;
  constexpr int NTN = (MODE == 0) ? 39 : 8;
  constexpr int NK = K / 64;
  constexpr int LOGNK = (MODE == 0) ? 4 : 5;
  const u16* X = (const u16*)(p.ws + (MODE == 0 ? WS_XB : WS_MIX));
  const u16* W = (const u16*)(p.ws + (MODE == 0 ? WS_WIN : WS_WOUT)) + (size_t)layer * (MODE == 0 ? (size_t)NPAD * 1024 : (size_t)1024 * 2048);
  u16* sX = (u16*)smem;
  u16* sW = sX + 2 * 128 * 72;
  const int tid = opaque_tid(), lane = tid & 63, w = tid >> 6, quad = lane >> 4, l15 = lane & 15;
  const int wn = w >> 1, wm = w & 1;
  const int ntiles = 129 * NTN;
  const int G = gridDim.x, bid = blockIdx.x;
  const int off = ((G & 7) == 0) ? ((bid & 7) * (G >> 3) + (bid >> 3)) : bid;
  if (off < ntiles) {
    const int nt_b = (ntiles - off + G - 1) / G;
    const int total = nt_b << LOGNK;
    const int soff = (tid >> 3) * 72 + (tid & 7) * 8;
    const int rowoff = tid >> 3, coloff = (tid & 7) * 8;
    f32x4 acc[4][4];
    u32x4 rx[2][4], rw[2][4];
#define GLOAD(S, g_) { \
      const int gg_ = ((g_) < total) ? (g_) : (total - 1); \
      const int it_ = gg_ >> LOGNK, kt_ = gg_ & (NK - 1); \
      int m0_, n0_; tile_coords(it_ * G + off, NTN, m0_, n0_); \
      const int k0_ = ((MODE == 0) ? kt_ : ((kt_ + 20) & 31)) * 64; \
      const u16* gx_ = X + (size_t)(m0_ + rowoff) * K + coloff + k0_; \
      const u16* gw_ = W + (size_t)(n0_ + rowoff) * K + coloff + k0_; \
      _Pragma("unroll") for (int i = 0; i < 4; ++i) { \
        rx[S][i] = *(const u32x4*)(gx_ + (size_t)i * 32 * K); \
        rw[S][i] = *(const u32x4*)(gw_ + (size_t)i * 32 * K); } }
#define LSTORE(S, buf_) { \
      u16* dX_ = sX + (buf_) * 128 * 72; u16* dW_ = sW + (buf_) * 128 * 72; \
      _Pragma("unroll") for (int i = 0; i < 4; ++i) { \
        *(u32x4*)(dX_ + soff + i * 32 * 72) = rx[S][i]; \
        *(u32x4*)(dW_ + soff + i * 32 * 72) = rw[S][i]; } }
    GLOAD(0, 0); GLOAD(1, 1);
    LSTORE(0, 0);
    __syncthreads();
#pragma unroll 1
    for (int g0 = 0; g0 < total; g0 += 2) {
#pragma unroll
      for (int s = 0; s < 2; ++s) {
        const int g = g0 + s;
        {
          const int kt = g & (NK - 1), it = g >> LOGNK;
          if (kt == 0) {
#pragma unroll
            for (int a = 0; a < 4; ++a)
#pragma unroll
              for (int b = 0; b < 4; ++b) acc[a][b] = (f32x4){0.f, 0.f, 0.f, 0.f};
          }
          if (MODE == 1 && kt == 12) {
            int m0, n0; tile_coords(it * G + off, NTN, m0, n0);
            const float* SSQ = (const float*)(p.ws + WS_SSQ);
#pragma unroll
            for (int mt = 0; mt < 4; ++mt) {
              const int m = m0 + wm * 64 + mt * 16 + l15;
              const float4 s0 = *(const float4*)(SSQ + (size_t)m * 12), s1 = *(const float4*)(SSQ + (size_t)m * 12 + 4), s2 = *(const float4*)(SSQ + (size_t)m * 12 + 8);
              const float ss = s0.x + s0.y + s0.z + s0.w + s1.x + s1.y + s1.z + s1.w + s2.x + s2.y + s2.z + s2.w;
              const float rs = rsqrtf(ss * (1.f / 768.f) + 1e-5f);
#pragma unroll
              for (int nt = 0; nt < 4; ++nt) acc[nt][mt] *= rs;
            }
          }
          const u16* cX = sX + (g & 1) * 128 * 72;
          const u16* cW = sW + (g & 1) * 128 * 72;
          u16* dX = sX + ((g + 1) & 1) * 128 * 72;
          u16* dW = sW + ((g + 1) & 1) * 128 * 72;
#pragma unroll
          for (int ks = 0; ks < 2; ++ks) {
            bf16x8 wf[4], xf[4];
#pragma unroll
            for (int i = 0; i < 4; ++i) {
              wf[i] = ldfrag(cW, 72, wn * 64 + i * 16, ks * 32, lane);
              xf[i] = ldfrag(cX, 72, wm * 64 + i * 16, ks * 32, lane);
            }
            __builtin_amdgcn_sched_barrier(0);
#pragma unroll
            for (int nt = 0; nt < 4; ++nt) {
#pragma unroll
              for (int mt = 0; mt < 4; ++mt) acc[nt][mt] = mfma16(wf[nt], xf[mt], acc[nt][mt]);
              if (ks == 0) *(u32x4*)(dX + soff + nt * 32 * 72) = rx[(s + 1) & 1][nt];
              else         *(u32x4*)(dW + soff + nt * 32 * 72) = rw[(s + 1) & 1][nt];
              __builtin_amdgcn_sched_barrier(0);
            }
            if (ks == 0) { GLOAD(s, g + 2); __builtin_amdgcn_sched_barrier(0); }
          }
          __syncthreads();
          if (kt == NK - 1) {
            int m0, n0; tile_coords(it * G + off, NTN, m0, n0);
            if (MODE == 0) {
              u16* PROJ = (u16*)(p.ws + WS_PROJ);
              u16* eX = sX + (g & 1) * 128 * 72;
              u16* eW = sW + (g & 1) * 128 * 72;
#pragma unroll
              for (int mt = 0; mt < 4; ++mt) {
                const int ml = mt * 16 + l15;
                u16* eb = (wm == 0 ? eX : eW) + ml * 136;
#pragma unroll
                for (int nt = 0; nt < 4; ++nt) {
                  const int nl = wn * 64 + nt * 16 + quad * 4;
                  uint2 o; o.x = pack2(acc[nt][mt][0], acc[nt][mt][1]); o.y = pack2(acc[nt][mt][2], acc[nt][mt][3]);
                  *(uint2*)(eb + nl) = o;
                }
              }
              __syncthreads();
#pragma unroll
              for (int i = 0; i < 8; ++i) {
                const int row = (tid >> 4) + 16 * i, ch = tid & 15;
                const u16* eb = (row < 64 ? eX + row * 136 : eW + (row - 64) * 136) + ch * 8;
                *(u32x4*)(PROJ + (size_t)(m0 + row) * NPAD + n0 + ch * 8) = *(const u32x4*)eb;
              }
              {
                const int tn_ = n0 >> 7;
                const bool is_lru = (tn_ >= 10) && (tn_ < 16), is_ssd = (tn_ >= 28) && (tn_ < 38);
                if ((is_lru || is_ssd) && m0 < MP) {
                  const int o = tid & 15, rbase = (tid >> 4) * 8;
                  const int nch = is_lru ? 768 : 1280;
                  const int chn = (is_lru ? (n0 - C_XL) : (n0 - C_XBC)) + o * 8;
                  const float* cw = (is_lru ? (p.in[11] + layer * 4 * 768) : (p.in[18] + layer * 4 * 1280)) + chn;
                  const float* cb = (is_lru ? (p.in[12] + layer * 768) : (p.in[19] + layer * 1280)) + chn;
                  u16* dst = (u16*)(p.ws + (is_lru ? WS_XL : WS_XBC)) + chn;
                  float w0[8], w1[8], w2[8], w3[8], bs[8];
#pragma unroll
                  for (int h = 0; h < 2; ++h) {
                    const float4 a0 = *(const float4*)(cw + 0 * nch + 4 * h), a1 = *(const float4*)(cw + 1 * nch + 4 * h);
                    const float4 a2 = *(const float4*)(cw + 2 * nch + 4 * h), a3 = *(const float4*)(cw + 3 * nch + 4 * h);
                    const float4 b4 = *(const float4*)(cb + 4 * h);
                    w0[4 * h] = a0.x; w0[4 * h + 1] = a0.y; w0[4 * h + 2] = a0.z; w0[4 * h + 3] = a0.w;
                    w1[4 * h] = a1.x; w1[4 * h + 1] = a1.y; w1[4 * h + 2] = a1.z; w1[4 * h + 3] = a1.w;
                    w2[4 * h] = a2.x; w2[4 * h + 1] = a2.y; w2[4 * h + 2] = a2.z; w2[4 * h + 3] = a2.w;
                    w3[4 * h] = a3.x; w3[4 * h + 1] = a3.y; w3[4 * h + 2] = a3.z; w3[4 * h + 3] = a3.w;
                    bs[4 * h] = b4.x; bs[4 * h + 1] = b4.y; bs[4 * h + 2] = b4.z; bs[4 * h + 3] = b4.w;
                  }
                  float xa[8], xb[8], xc[8], xd[8], yv[8];
#pragma unroll
                  for (int c = 0; c < 8; ++c) { xa[c] = 0.f; xb[c] = 0.f; xc[c] = 0.f; }
                  if (rbase >= 8) {
                    const int r1 = rbase - 3, r2 = rbase - 2, r3 = rbase - 1;
                    unpack8(*(const uint4*)((r1 < 64 ? eX + r1 * 136 : eW + (r1 - 64) * 136) + o * 8), xa);
                    unpack8(*(const uint4*)((r2 < 64 ? eX + r2 * 136 : eW + (r2 - 64) * 136) + o * 8), xb);
                    unpack8(*(const uint4*)((r3 < 64 ? eX + r3 * 136 : eW + (r3 - 64) * 136) + o * 8), xc);
                  }
#pragma unroll
                  for (int i = 0; i < 8; ++i) {
                    const int row = rbase + i;
                    unpack8(*(const uint4*)((row < 64 ? eX + row * 136 : eW + (row - 64) * 136) + o * 8), xd);
#pragma unroll
                    for (int c = 0; c < 8; ++c) {
                      const float v = bs[c] + w0[c] * xa[c] + w1[c] * xb[c] + w2[c] * xc[c] + w3[c] * xd[c];
                      yv[c] = is_lru ? v : silu_f(v);
                    }
                    if (row >= 3) *(uint4*)(dst + (size_t)(m0 + row) * nch) = pack8(yv);
#pragma unroll
                    for (int c = 0; c < 8; ++c) { xa[c] = xb[c]; xb[c] = xc[c]; xc[c] = xd[c]; }
                  }
                }
              }
              __syncthreads();
            } else {
              float* PRE = (float*)(p.ws + WS_PRE);
              const float alpha = 1.681792830507429f;
#pragma unroll
              for (int mt = 0; mt < 4; ++mt) {
                const int m = m0 + wm * 64 + mt * 16 + l15;
                const float* xres = (m < MP) ? (p.in[0] + (size_t)m * 1024) : (p.in[1] + (size_t)(m - MP) * 1024);
                const u16* xrb = (const u16*)(p.ws + WS_XB) + (size_t)m * 1024;
#pragma unroll
                for (int nt = 0; nt < 4; ++nt) {
                  const int n = n0 + wn * 64 + nt * 16 + quad * 4;
                  float4 xr;
                  if (layer == 0) xr = *(const float4*)(xres + n);
                  else { const uint2 xb2 = *(const uint2*)(xrb + n); xr = make_float4(bflo(xb2.x), bfhi(xb2.x), bflo(xb2.y), bfhi(xb2.y)); }
                  float4 o;
                  o.x = alpha * xr.x + acc[nt][mt][0]; o.y = alpha * xr.y + acc[nt][mt][1];
                  o.z = alpha * xr.z + acc[nt][mt][2]; o.w = alpha * xr.w + acc[nt][mt][3];
                  *(float4*)(PRE + (size_t)m * 1024 + n) = o;
                }
              }
            }
          }
        }
      }
    }
#undef GLOAD
#undef LSTORE
  }
}

PH void ln_phase(const Params& p, int layer) {
  const int tid = opaque_tid(), lane = tid & 63, w = tid >> 6;
  const float* PRE = (const float*)(p.ws + WS_PRE);
  u16* Xb = (u16*)(p.ws + WS_XB);
  const float* g = p.in[24] + layer * 1024;
  const float* bb = p.in[25] + layer * 1024;
  f32x4 gg[4], bv[4], nv[4];
#pragma unroll
  for (int i = 0; i < 4; ++i) {
    gg[i] = *(const f32x4*)(g + i * 256 + lane * 4);
    bv[i] = *(const f32x4*)(bb + i * 256 + lane * 4);
  }
  const int stride = gridDim.x * 4;
  int row = blockIdx.x * 4 + w;
  if (row < MT) {
#pragma unroll
    for (int i = 0; i < 4; ++i) nv[i] = *(const f32x4*)(PRE + (size_t)row * 1024 + i * 256 + lane * 4);
  }
#pragma unroll 1
  for (; row < MT; row += stride) {
    f32x4 v[4];
#pragma unroll
    for (int i = 0; i < 4; ++i) v[i] = nv[i];
    {
      const int nrow = (row + stride < MT) ? (row + stride) : row;
#pragma unroll
      for (int i = 0; i < 4; ++i) nv[i] = *(const f32x4*)(PRE + (size_t)nrow * 1024 + i * 256 + lane * 4);
    }
    float s = 0.f;
#pragma unroll
    for (int i = 0; i < 4; ++i) s += v[i][0] + v[i][1] + v[i][2] + v[i][3];
#pragma unroll
    for (int d = 1; d < 64; d <<= 1) s += __shfl_xor(s, d);
    const float mu = s * (1.f / 1024.f);
    float q = 0.f;
#pragma unroll
    for (int i = 0; i < 4; ++i) {
      v[i] -= mu;
      q += v[i][0] * v[i][0] + v[i][1] * v[i][1] + v[i][2] * v[i][2] + v[i][3] * v[i][3];
    }
#pragma unroll
    for (int d = 1; d < 64; d <<= 1) q += __shfl_xor(q, d);
    const float rs = rsqrtf(q * (1.f / 1024.f) + 1e-5f);
#pragma unroll
    for (int i = 0; i < 4; ++i) {
      const int c = i * 256 + lane * 4;
      const f32x4 o = v[i] * rs * gg[i] + bv[i];
      if (layer == 3) {
        float* dst = (row < MP) ? (p.out + O_YP + (size_t)row * 1024) : (p.out + O_YS + (size_t)(row - MP) * 1024);
        *(f32x4*)(dst + c) = o;
      } else {
        uint2 ob; ob.x = pack2(o[0], o[1]); ob.y = pack2(o[2], o[3]);
        *(uint2*)(Xb + (size_t)row * 1024 + c) = ob;
      }
    }
  }
}

PH void conv_unit(const Params& p, int layer, int unit) {
  const int tid = opaque_tid();
  const int T = (unit < 128) ? unit : 128, ru = (unit < 128) ? 0 : (unit - 128);
  const bool lru = tid < 96;
  const int oo = lru ? tid : tid - 96;
  const int nch = lru ? 768 : 1280;
  const int srccol = (lru ? C_XL : C_XBC) + 8 * oo;
  const float* cw = (lru ? (p.in[11] + layer * 4 * 768) : (p.in[18] + layer * 4 * 1280)) + 8 * oo;
  const float* cb = (lru ? (p.in[12] + layer * 768) : (p.in[19] + layer * 1280)) + 8 * oo;
  const u16* PROJ = (const u16*)(p.ws + WS_PROJ);
  u16* dst = (u16*)(p.ws + (lru ? WS_XL : WS_XBC)) + 8 * oo;
  float w0[8], w1[8], w2[8], w3[8], bs[8];
#pragma unroll
  for (int h = 0; h < 2; ++h) {
    const float4 a0 = *(const float4*)(cw + 0 * nch + 4 * h), a1 = *(const float4*)(cw + 1 * nch + 4 * h);
    const float4 a2 = *(const float4*)(cw + 2 * nch + 4 * h), a3 = *(const float4*)(cw + 3 * nch + 4 * h);
    const float4 b4 = *(const float4*)(cb + 4 * h);
    w0[4 * h] = a0.x; w0[4 * h + 1] = a0.y; w0[4 * h + 2] = a0.z; w0[4 * h + 3] = a0.w;
    w1[4 * h] = a1.x; w1[4 * h + 1] = a1.y; w1[4 * h + 2] = a1.z; w1[4 * h + 3] = a1.w;
    w2[4 * h] = a2.x; w2[4 * h + 1] = a2.y; w2[4 * h + 2] = a2.z; w2[4 * h + 3] = a2.w;
    w3[4 * h] = a3.x; w3[4 * h + 1] = a3.y; w3[4 * h + 2] = a3.z; w3[4 * h + 3] = a3.w;
    bs[4 * h] = b4.x; bs[4 * h + 1] = b4.y; bs[4 * h + 2] = b4.z; bs[4 * h + 3] = b4.w;
  }
  float xa[8], xb[8], xc[8], xd[8], y[8];
  if (T < 128) {
    const int r0 = T * 128, pos0 = r0 & 2047, b = r0 >> 11;
    if (pos0 == 0) {
#pragma unroll
      for (int c = 0; c < 8; ++c) { xa[c] = 0.f; xb[c] = 0.f; xc[c] = 0.f; }
    } else {
      unpack8(*(const uint4*)(PROJ + (size_t)(r0 - 3) * NPAD + srccol), xa);
      unpack8(*(const uint4*)(PROJ + (size_t)(r0 - 2) * NPAD + srccol), xb);
      unpack8(*(const uint4*)(PROJ + (size_t)(r0 - 1) * NPAD + srccol), xc);
    }
#pragma unroll
    for (int i = 0; i < 3; ++i) {
      const int row = r0 + i;
      unpack8(*(const uint4*)(PROJ + (size_t)row * NPAD + srccol), xd);
#pragma unroll
      for (int c = 0; c < 8; ++c) {
        float v = bs[c] + w0[c] * xa[c] + w1[c] * xb[c] + w2[c] * xc[c] + w3[c] * xd[c];
        y[c] = lru ? v : silu_f(v);
      }
      *(uint4*)(dst + (size_t)row * nch) = pack8(y);
#pragma unroll
      for (int c = 0; c < 8; ++c) { xa[c] = xb[c]; xb[c] = xc[c]; xc[c] = xd[c]; }
    }
    if ((T & 15) == 15) {
#pragma unroll
      for (int j = 0; j < 3; ++j) {
        unpack8(*(const uint4*)(PROJ + (size_t)(b * 2048 + 2045 + j) * NPAD + srccol), xd);
        float* op = p.out + (lru ? (O_PLC + (size_t)((layer * 8 + b) * 3 + j) * 768) : (O_PSC + (size_t)((layer * 8 + b) * 3 + j) * 1280)) + 8 * oo;
        *(float4*)op = make_float4(xd[0], xd[1], xd[2], xd[3]);
        *(float4*)(op + 4) = make_float4(xd[4], xd[5], xd[6], xd[7]);
      }
    }
  } else {
#pragma unroll 2
    for (int i = 0; i < 16; ++i) {
      const int bi = ru * 16 + i, row = MP + bi;
      const float* st = (lru ? (p.in[4] + (size_t)(layer * 128 + bi) * 3 * 768) : (p.in[6] + (size_t)(layer * 128 + bi) * 3 * 1280)) + 8 * oo;
#pragma unroll
      for (int h = 0; h < 2; ++h) {
        const float4 a = *(const float4*)(st + 0 * nch + 4 * h), b4 = *(const float4*)(st + 1 * nch + 4 * h), c4 = *(const float4*)(st + 2 * nch + 4 * h);
        xa[4 * h] = a.x; xa[4 * h + 1] = a.y; xa[4 * h + 2] = a.z; xa[4 * h + 3] = a.w;
        xb[4 * h] = b4.x; xb[4 * h + 1] = b4.y; xb[4 * h + 2] = b4.z; xb[4 * h + 3] = b4.w;
        xc[4 * h] = c4.x; xc[4 * h + 1] = c4.y; xc[4 * h + 2] = c4.z; xc[4 * h + 3] = c4.w;
      }
      unpack8(*(const uint4*)(PROJ + (size_t)row * NPAD + srccol), xd);
#pragma unroll
      for (int c = 0; c < 8; ++c) {
        float v = bs[c] + w0[c] * xa[c] + w1[c] * xb[c] + w2[c] * xc[c] + w3[c] * xd[c];
        y[c] = lru ? v : silu_f(v);
      }
      *(uint4*)(dst + (size_t)row * nch) = pack8(y);
      float* op = p.out + (lru ? (O_SLC + (size_t)(layer * 128 + bi) * 3 * 768) : (O_SSC + (size_t)(layer * 128 + bi) * 3 * 1280)) + 8 * oo;
      *(float4*)(op) = make_float4(xb[0], xb[1], xb[2], xb[3]);
      *(float4*)(op + 4) = make_float4(xb[4], xb[5], xb[6], xb[7]);
      *(float4*)(op + nch) = make_float4(xc[0], xc[1], xc[2], xc[3]);
      *(float4*)(op + nch + 4) = make_float4(xc[4], xc[5], xc[6], xc[7]);
      *(float4*)(op + 2 * nch) = make_float4(xd[0], xd[1], xd[2], xd[3]);
      *(float4*)(op + 2 * nch + 4) = make_float4(xd[4], xd[5], xd[6], xd[7]);
    }
  }
}

PH void attn_prompt_item(const Params& p, int layer, int item) {
  SMEM;
  const int tid = opaque_tid(), lane = tid & 63, w = tid >> 6, quad = lane >> 4, l15 = lane & 15;
  const int b = item >> 5, nb = (item >> 1) & 15, kvh = item & 1;
  u16* Ks = (u16*)smem;
  u16* Vt = (u16*)(smem + 256 * 72 * 2);
  const u16* PROJ = (const u16*)(p.ws + WS_PROJ);
  u16* MIX = (u16*)(p.ws + WS_MIX);
  const float* ROPE = (const float*)(p.ws + WS_ROPE);
  {
    const int j = tid, t = nb * 128 - 128 + j;
    uint4 kq[8], vq[8];
    if (t >= 0) {
      const u16* src = PROJ + (size_t)(b * 2048 + t) * NPAD;
#pragma unroll
      for (int i = 0; i < 8; ++i) {
        kq[i] = *(const uint4*)(src + C_K + kvh * 64 + i * 8);
        vq[i] = *(const uint4*)(src + C_V + kvh * 64 + i * 8);
      }
    } else {
#pragma unroll
      for (int i = 0; i < 8; ++i) { kq[i] = make_uint4(0, 0, 0, 0); vq[i] = make_uint4(0, 0, 0, 0); }
    }
    float x1[8], x2[8];
    unpack8(kq[0], x1); unpack8(kq[1], x2);
    if (t >= 0) {
      const float* cs = ROPE + (size_t)t * 16;
#pragma unroll
      for (int i = 0; i < 8; ++i) {
        const float c = cs[2 * i], s = cs[2 * i + 1];
        const float r1 = x1[i] * c - x2[i] * s, r2 = x2[i] * c + x1[i] * s;
        x1[i] = r1; x2[i] = r2;
      }
    }
    kq[0] = pack8(x1); kq[1] = pack8(x2);
#pragma unroll
    for (int i = 0; i < 8; ++i) *(uint4*)(Ks + j * 72 + i * 8) = kq[i];
#pragma unroll
    for (int i = 0; i < 8; ++i) {
      Vt[(i * 8 + 0) * 264 + j] = (u16)(vq[i].x & 0xffffu); Vt[(i * 8 + 1) * 264 + j] = (u16)(vq[i].x >> 16);
      Vt[(i * 8 + 2) * 264 + j] = (u16)(vq[i].y & 0xffffu); Vt[(i * 8 + 3) * 264 + j] = (u16)(vq[i].y >> 16);
      Vt[(i * 8 + 4) * 264 + j] = (u16)(vq[i].z & 0xffffu); Vt[(i * 8 + 5) * 264 + j] = (u16)(vq[i].z >> 16);
      Vt[(i * 8 + 6) * 264 + j] = (u16)(vq[i].w & 0xffffu); Vt[(i * 8 + 7) * 264 + j] = (u16)(vq[i].w >> 16);
    }
    if (nb == 15 && j >= 128) {
      float* ok = p.out + O_PK + ((size_t)((layer * 8 + b) * 128 + (j - 128)) * 2 + kvh) * 64;
      float* ov = p.out + O_PV + ((size_t)((layer * 8 + b) * 128 + (j - 128)) * 2 + kvh) * 64;
      *(float4*)(ok + 0) = make_float4(x1[0], x1[1], x1[2], x1[3]);
      *(float4*)(ok + 4) = make_float4(x1[4], x1[5], x1[6], x1[7]);
      *(float4*)(ok + 8) = make_float4(x2[0], x2[1], x2[2], x2[3]);
      *(float4*)(ok + 12) = make_float4(x2[4], x2[5], x2[6], x2[7]);
#pragma unroll
      for (int i = 2; i < 8; ++i) {
        float f[8]; unpack8(kq[i], f);
        *(float4*)(ok + i * 8) = make_float4(f[0], f[1], f[2], f[3]);
        *(float4*)(ok + i * 8 + 4) = make_float4(f[4], f[5], f[6], f[7]);
      }
#pragma unroll
      for (int i = 0; i < 8; ++i) {
        float f[8]; unpack8(vq[i], f);
        *(float4*)(ov + i * 8) = make_float4(f[0], f[1], f[2], f[3]);
        *(float4*)(ov + i * 8 + 4) = make_float4(f[4], f[5], f[6], f[7]);
      }
    }
  }
  __syncthreads();
  const int h = kvh * 4 + w;
  const float sink = p.in[10][layer * 8 + h];
  u32x4 nq[2][3];
#pragma unroll
  for (int qt = 0; qt < 2; ++qt) {
    const u16* src = PROJ + (size_t)(b * 2048 + nb * 128 + qt * 16 + l15) * NPAD + h * 64;
    nq[qt][0] = *(const u32x4*)(src + quad * 8);
    nq[qt][1] = *(const u32x4*)(src + 32 + quad * 8);
    nq[qt][2] = *(const u32x4*)(src + (quad ^ 1) * 8);
  }
#pragma unroll 1
  for (int c = 0; c < 4; ++c) {
    const int q0 = 32 * c;
    u32x4 cq[2][3];
#pragma unroll
    for (int qt = 0; qt < 2; ++qt) { cq[qt][0] = nq[qt][0]; cq[qt][1] = nq[qt][1]; cq[qt][2] = nq[qt][2]; }
    {
      const int qn = 32 * ((c < 3) ? (c + 1) : c);
#pragma unroll
      for (int qt = 0; qt < 2; ++qt) {
        const u16* src = PROJ + (size_t)(b * 2048 + nb * 128 + qn + qt * 16 + l15) * NPAD + h * 64;
        nq[qt][0] = *(const u32x4*)(src + quad * 8);
        nq[qt][1] = *(const u32x4*)(src + 32 + quad * 8);
        nq[qt][2] = *(const u32x4*)(src + (quad ^ 1) * 8);
      }
    }
    uint2 gpre[2][4];
#pragma unroll
    for (int qt = 0; qt < 2; ++qt)
#pragma unroll
      for (int dt = 0; dt < 4; ++dt)
        gpre[qt][dt] = *(const uint2*)(PROJ + (size_t)(b * 2048 + nb * 128 + q0 + qt * 16 + l15) * NPAD + C_GA + h * 64 + dt * 16 + quad * 4);
    bf16x8 qf[2][2];
#pragma unroll
    for (int qt = 0; qt < 2; ++qt) {
      const int qi = q0 + qt * 16 + l15;
      const int tpos = nb * 128 + qi;
      float own[8], o1[8];
      unpack8v(cq[qt][0], own);
      unpack8v(cq[qt][1], o1);
      if (quad < 2) {
        float pr[8];
        unpack8v(cq[qt][2], pr);
        const float* cs = ROPE + (size_t)tpos * 16;
        const float sg = (quad == 0) ? -1.f : 1.f;
#pragma unroll
        for (int i = 0; i < 8; ++i) own[i] = own[i] * cs[2 * i] + sg * pr[i] * cs[2 * i + 1];
      }
#pragma unroll
      for (int i = 0; i < 8; ++i) { own[i] *= 0.125f; o1[i] *= 0.125f; }
      qf[qt][0] = __builtin_bit_cast(bf16x8, pack8(own));
      qf[qt][1] = __builtin_bit_cast(bf16x8, pack8(o1));
    }
    f32x4 s[10][2];
#pragma unroll
    for (int kt = 0; kt < 10; ++kt) { s[kt][0] = (f32x4){0.f, 0.f, 0.f, 0.f}; s[kt][1] = (f32x4){0.f, 0.f, 0.f, 0.f}; }
#pragma unroll
    for (int ks = 0; ks < 2; ++ks)
#pragma unroll
      for (int kt = 0; kt < 10; ++kt) {
        const bf16x8 af = ldfrag(Ks, 72, q0 + kt * 16, ks * 32, lane);
        s[kt][0] = mfma16(af, qf[0][ks], s[kt][0]);
        s[kt][1] = mfma16(af, qf[1][ks], s[kt][1]);
      }
    float inv[2];
    bf16x8 pf[5][2];
#pragma unroll
    for (int qt = 0; qt < 2; ++qt) {
      const int i = q0 + qt * 16 + l15;
      float mx = -INFINITY;
#pragma unroll
      for (int kt = 0; kt < 10; ++kt)
#pragma unroll
        for (int r = 0; r < 4; ++r) {
          const int j = q0 + kt * 16 + quad * 4 + r;
          const bool valid = (j >= i) && (j <= i + 128) && (nb > 0 || j >= 128);
          const float v = valid ? s[kt][qt][r] : -INFINITY;
          s[kt][qt][r] = v;
          mx = fmaxf(mx, v);
        }
      mx = fmaxf(mx, __shfl_xor(mx, 16));
      mx = fmaxf(mx, __shfl_xor(mx, 32));
      mx = fmaxf(mx, sink);
      float sum = 0.f;
#pragma unroll
      for (int kt = 0; kt < 10; ++kt)
#pragma unroll
        for (int r = 0; r < 4; ++r) {
          const float e = __expf(s[kt][qt][r] - mx);
          s[kt][qt][r] = e;
          sum += e;
        }
      sum += __shfl_xor(sum, 16);
      sum += __shfl_xor(sum, 32);
      inv[qt] = 1.f / (sum + __expf(sink - mx));
#pragma unroll
      for (int kk = 0; kk < 5; ++kk) pf[kk][qt] = packfrag(s[2 * kk][qt], s[2 * kk + 1][qt]);
    }
    f32x4 o[4][2];
#pragma unroll
    for (int dt = 0; dt < 4; ++dt) { o[dt][0] = (f32x4){0.f, 0.f, 0.f, 0.f}; o[dt][1] = (f32x4){0.f, 0.f, 0.f, 0.f}; }
#pragma unroll
    for (int kk = 0; kk < 5; ++kk)
#pragma unroll
      for (int dt = 0; dt < 4; ++dt) {
        const bf16x8 vf = ldfrag_perm(Vt, 264, dt * 16, q0 + kk * 32, lane);
        o[dt][0] = mfma16(vf, pf[kk][0], o[dt][0]);
        o[dt][1] = mfma16(vf, pf[kk][1], o[dt][1]);
      }
#pragma unroll
    for (int qt = 0; qt < 2; ++qt) {
      const int qi = q0 + qt * 16 + l15;
      const size_t row = (size_t)(b * 2048 + nb * 128 + qi);
#pragma unroll
      for (int dt = 0; dt < 4; ++dt) {
        const int col = h * 64 + dt * 16 + quad * 4;
        const uint2 gv = gpre[qt][dt];
        const float g0 = bflo(gv.x), g1 = bfhi(gv.x), g2 = bflo(gv.y), g3 = bfhi(gv.y);
        uint2 ov;
        ov.x = pack2(o[dt][qt][0] * inv[qt] * silu_f(g0), o[dt][qt][1] * inv[qt] * silu_f(g1));
        ov.y = pack2(o[dt][qt][2] * inv[qt] * silu_f(g2), o[dt][qt][3] * inv[qt] * silu_f(g3));
        *(uint2*)(MIX + row * 2048 + col) = ov;
      }
    }
  }
}

PH void attn_decode_item(const Params& p, int layer, int item) {
  SMEM;
  const int tid = opaque_tid(), lane = tid & 63, w = tid >> 6;
  const int b = item >> 1, kvh = item & 1;
  float* Kd = (float*)smem;
  float* Vd = Kd + 129 * 65;
  float* qs = Vd + 129 * 64;
  float* ps = qs + 256;
  const u16* PROJ = (const u16*)(p.ws + WS_PROJ);
  u16* MIX = (u16*)(p.ws + WS_MIX);
  const float* ROPE = (const float*)(p.ws + WS_ROPE) + (size_t)2048 * 16;
  const size_t row = (size_t)(MP + b);
  const float* ck = p.in[2] + (size_t)(layer * 128 + b) * 128 * 128;
  const float* cv = p.in[3] + (size_t)(layer * 128 + b) * 128 * 128;
  float* ok = p.out + O_SK + (size_t)(layer * 128 + b) * 128 * 128;
  float* ov = p.out + O_SV + (size_t)(layer * 128 + b) * 128 * 128;
#pragma unroll
  for (int i = 0; i < 8; ++i) {
    const int idx = tid + 256 * i, wi = idx >> 4, c4 = idx & 15;
    const float4 kv = *(const float4*)(ck + (size_t)(wi * 2 + kvh) * 64 + c4 * 4);
    const float4 vv = *(const float4*)(cv + (size_t)(wi * 2 + kvh) * 64 + c4 * 4);
    Kd[wi * 65 + c4 * 4 + 0] = kv.x; Kd[wi * 65 + c4 * 4 + 1] = kv.y; Kd[wi * 65 + c4 * 4 + 2] = kv.z; Kd[wi * 65 + c4 * 4 + 3] = kv.w;
    *(float4*)(Vd + wi * 64 + c4 * 4) = vv;
    if (wi >= 1) {
      *(float4*)(ok + (size_t)((wi - 1) * 2 + kvh) * 64 + c4 * 4) = kv;
      *(float4*)(ov + (size_t)((wi - 1) * 2 + kvh) * 64 + c4 * 4) = vv;
    }
  }
  if (tid < 64) {
    const int d = tid;
    float kx = bf2f(PROJ[row * NPAD + C_K + kvh * 64 + d]);
    if (d < 16) {
      const float pr = bf2f(PROJ[row * NPAD + C_K + kvh * 64 + (d ^ 8)]);
      const float c = ROPE[2 * (d & 7)], s = ROPE[2 * (d & 7) + 1];
      kx = (d < 8) ? (kx * c - pr * s) : (kx * c + pr * s);
    }
    const float vx = bf2f(PROJ[row * NPAD + C_V + kvh * 64 + d]);
    Kd[128 * 65 + d] = kx; Vd[128 * 64 + d] = vx;
    ok[(size_t)(127 * 2 + kvh) * 64 + d] = kx;
    ov[(size_t)(127 * 2 + kvh) * 64 + d] = vx;
  }
  {
    const int g = tid >> 6, d = tid & 63, h = kvh * 4 + g;
    float qx = bf2f(PROJ[row * NPAD + h * 64 + d]);
    if (d < 16) {
      const float pr = bf2f(PROJ[row * NPAD + h * 64 + (d ^ 8)]);
      const float c = ROPE[2 * (d & 7)], s = ROPE[2 * (d & 7) + 1];
      qx = (d < 8) ? (qx * c - pr * s) : (qx * c + pr * s);
    }
    qs[g * 64 + d] = qx * 0.125f;
  }
  __syncthreads();
  const int h = kvh * 4 + w;
  const float sink = p.in[10][layer * 8 + h];
  float s0 = 0.f, s1 = 0.f, s2 = 0.f;
  for (int d = 0; d < 64; ++d) {
    const float qv = qs[w * 64 + d];
    s0 += qv * Kd[lane * 65 + d];
    s1 += qv * Kd[(lane + 64) * 65 + d];
    s2 += qv * Kd[128 * 65 + d];
  }
  float mx = fmaxf(fmaxf(s0, s1), s2);
#pragma unroll
  for (int d = 1; d < 64; d <<= 1) mx = fmaxf(mx, __shfl_xor(mx, d));
  mx = fmaxf(mx, sink);
  const float e0 = __expf(s0 - mx), e1 = __expf(s1 - mx), e2 = __expf(s2 - mx);
  float sum = e0 + e1;
#pragma unroll
  for (int d = 1; d < 64; d <<= 1) sum += __shfl_xor(sum, d);
  const float inv = 1.f / (sum + e2 + __expf(sink - mx));
  ps[w * 132 + lane] = e0 * inv;
  ps[w * 132 + 64 + lane] = e1 * inv;
  if (lane == 0) ps[w * 132 + 128] = e2 * inv;
  __syncthreads();
  float o = 0.f;
  for (int k = 0; k < 129; ++k) o += ps[w * 132 + k] * Vd[k * 64 + lane];
  const float gt = bf2f(PROJ[row * NPAD + C_GA + h * 64 + lane]);
  MIX[row * 2048 + h * 64 + lane] = f2bf(o * silu_f(gt));
}

PH void lru_item(const Params& p, int layer, int b, int n, int dpart) {
  SMEM;
  const int tid = opaque_tid(), lane = tid & 63, w = tid >> 6, quad = lane >> 4, l15 = lane & 15;
  u16* xls = (u16*)smem;
  float* as_ = (float*)(smem + 26624);
  float* bs_ = (float*)(smem + 26624 + 16896);
  float* Pc = (float*)(smem + 60416);
  float* Hc = (float*)(smem + 61440);
  float* hprev = (float*)(smem + 62464);
  const u16* PROJ = (const u16*)(p.ws + WS_PROJ);
  const u16* XL = (const u16*)(p.ws + WS_XL);
  u16* MIX = (u16*)(p.ws + WS_MIX);
  const u16* WA = (const u16*)(p.ws + WS_WA) + (size_t)(layer * 8 + n) * 9216;
  const u16* WX = (const u16*)(p.ws + WS_WX) + (size_t)(layer * 8 + n) * 9216;
  bf16x8 wa[2][3], wx[2][3];
#pragma unroll
  for (int dt = 0; dt < 2; ++dt)
#pragma unroll
    for (int ks = 0; ks < 3; ++ks) {
      const int d = dpart * 32 + dt * 16 + l15, k = ks * 32 + quad * 8;
      wa[dt][ks] = *(const bf16x8*)(WA + d * 96 + k);
      wx[dt][ks] = *(const bf16x8*)(WX + d * 96 + k);
    }
  const int nchunks = (b >= 0) ? 16 : 1;
  const int sch = tid & 31, sub = tid >> 5;
  const int chg = n * 96 + dpart * 32 + sch;
  const float ba = p.in[14][layer * 768 + chg], bx = p.in[16][layer * 768 + chg];
  const float cl = -8.f * softplus_f(-p.in[17][layer * 768 + chg]);
  u32x4 pxl[6];
  u16 pgt[16];
  {
    const int nb_ = (b >= 0) ? (b * 2048) : MP;
#pragma unroll
    for (int i = 0; i < 6; ++i) {
      const int idx = tid + 256 * i, r = idx / 12, c16 = idx % 12;
      pxl[i] = *(const u32x4*)(XL + (size_t)(nb_ + r) * 768 + n * 96 + c16 * 8);
    }
#pragma unroll
    for (int t = 0; t < 16; ++t) pgt[t] = PROJ[(size_t)(nb_ + sub * 16 + t) * NPAD + C_GL + chg];
  }
#pragma unroll 1
  for (int c = 0; c < nchunks; ++c) {
    const int base = (b >= 0) ? (b * 2048 + c * 128) : MP;
#pragma unroll
    for (int i = 0; i < 6; ++i) {
      const int idx = tid + 256 * i, r = idx / 12, c16 = idx % 12;
      *(u32x4*)(xls + r * 104 + c16 * 8) = pxl[i];
    }
    u16 gcur[16];
#pragma unroll
    for (int t = 0; t < 16; ++t) gcur[t] = pgt[t];
    {
      const int nb_ = (c + 1 < nchunks) ? (base + 128) : base;
#pragma unroll
      for (int i = 0; i < 6; ++i) {
        const int idx = tid + 256 * i, r = idx / 12, c16 = idx % 12;
        pxl[i] = *(const u32x4*)(XL + (size_t)(nb_ + r) * 768 + n * 96 + c16 * 8);
      }
#pragma unroll
      for (int t = 0; t < 16; ++t) pgt[t] = PROJ[(size_t)(nb_ + sub * 16 + t) * NPAD + C_GL + chg];
    }
    __syncthreads();
    {
      f32x4 ra[2][2], rx[2][2];
#pragma unroll
      for (int dt = 0; dt < 2; ++dt)
#pragma unroll
        for (int tt = 0; tt < 2; ++tt) { ra[dt][tt] = (f32x4){0.f, 0.f, 0.f, 0.f}; rx[dt][tt] = (f32x4){0.f, 0.f, 0.f, 0.f}; }
#pragma unroll
      for (int ks = 0; ks < 3; ++ks)
#pragma unroll
        for (int tt = 0; tt < 2; ++tt) {
          const bf16x8 xf = ldfrag(xls, 104, (2 * w + tt) * 16, ks * 32, lane);
#pragma unroll
          for (int dt = 0; dt < 2; ++dt) {
            ra[dt][tt] = mfma16(wa[dt][ks], xf, ra[dt][tt]);
            rx[dt][tt] = mfma16(wx[dt][ks], xf, rx[dt][tt]);
          }
        }
#pragma unroll
      for (int dt = 0; dt < 2; ++dt)
#pragma unroll
        for (int tt = 0; tt < 2; ++tt)
#pragma unroll
          for (int r = 0; r < 4; ++r) {
            const int tok = (2 * w + tt) * 16 + l15, dl = dt * 16 + quad * 4 + r;
            as_[tok * 33 + dl] = ra[dt][tt][r];
            bs_[tok * 33 + dl] = rx[dt][tt][r];
          }
    }
    __syncthreads();
    float P = 1.f, H = 0.f;
#pragma unroll
    for (int t = 0; t < 16; ++t) {
      const int tok = sub * 16 + t;
      const float rg = sigmoid_f(as_[tok * 33 + sch] + ba);
      const float ig = sigmoid_f(bs_[tok * 33 + sch] + bx);
      const float la = cl * rg;
      const float xv = bf2f(xls[tok * 104 + dpart * 32 + sch]);
      const float a = __expf(la);
      const float bb = __builtin_amdgcn_sqrtf(-expm1f(2.f * la)) * ig * xv;
      as_[tok * 33 + sch] = a;
      bs_[tok * 33 + sch] = bb;
      H = a * H + bb; P *= a;
    }
    if (b >= 0) {
      Pc[sub * 32 + sch] = P; Hc[sub * 32 + sch] = H;
      __syncthreads();
      float carry = (c == 0) ? 0.f : hprev[(c & 1) * 32 + sch];
#pragma unroll
      for (int s = 0; s < 8; ++s) if (s < sub) carry = Pc[s * 32 + sch] * carry + Hc[s * 32 + sch];
      float hh = carry;
#pragma unroll
      for (int t = 0; t < 16; ++t) {
        const int tok = sub * 16 + t;
        const float a = as_[tok * 33 + sch], bb = bs_[tok * 33 + sch];
        hh = a * hh + bb;
        const size_t row = (size_t)(base + tok);
        const float g = bf2f(gcur[t]);
        MIX[row * 2048 + 512 + chg] = f2bf(hh * silu_f(g));
      }
      if (sub == 7) {
        hprev[((c + 1) & 1) * 32 + sch] = hh;
        if (c == 15) p.out[O_PLH + (size_t)(layer * 8 + b) * 768 + chg] = hh;
      }
    } else {
#pragma unroll
      for (int t = 0; t < 16; ++t) {
        const int tok = sub * 16 + t;
        const float a = as_[tok * 33 + sch], bb = bs_[tok * 33 + sch];
        const float h0 = p.in[5][(size_t)(layer * 128 + tok) * 768 + chg];
        const float hh = a * h0 + bb;
        const size_t row = (size_t)(MP + tok);
        const float g = bf2f(gcur[t]);
        MIX[row * 2048 + 512 + chg] = f2bf(hh * silu_f(g));
        p.out[O_SLH + (size_t)(layer * 128 + tok) * 768 + chg] = hh;
      }
    }
  }
}

constexpr int NSEG = 3;
template <int PROBE, int SONLY, int CPS>
DI void ssd_chunk_loop(const Params& p, int layer, int b, int e, int c0, f32x4 (&h)[8], float& dtot, bool write_final) {
  SMEM;
  const int tid = opaque_tid(), lane = tid & 63, w = tid >> 6, quad = lane >> 4, l15 = lane & 15;
  const int g = e / 6;
  u16* Cs = (u16*)smem;
  u16* Bs = (u16*)(smem + 17408);
  u16* Bt2 = (u16*)(smem + 34816);
  u16* Xt = (u16*)(smem + 53248);
  u16* Ms = (u16*)(smem + 62464);
  float* dt_s = (float*)(smem + 71680);
  float* acs_s = dt_s + 64;
  float* ssq_s = acs_s + 64;
  const u16* PROJ = (const u16*)(p.ws + WS_PROJ);
  const u16* XBC = (const u16*)(p.ws + WS_XBC);
  u16* MIX = (u16*)(p.ws + WS_MIX);
  float* SSQ = (float*)(p.ws + WS_SSQ);
  const float dtb = p.in[20][layer * 12 + e];
  const float ah = -__expf(p.in[21][layer * 12 + e]);
  const float Dv = p.in[22][layer * 12 + e];
  const bool do_store = !(PROBE & 1) || (dtb == 1234.5f);
  u32x4 pc[4], pb[4], px[2];
  u16 pru;
  {
    const int nb_ = b * 2048 + c0 * 64;
#pragma unroll
    for (int i = 0; i < 4; ++i) {
      const int idx = tid + 256 * i, r = idx >> 4, c16 = idx & 15;
      if (!SONLY) pc[i] = *(const u32x4*)(XBC + (size_t)(nb_ + r) * 1280 + 1024 + g * 128 + c16 * 8);
      pb[i] = *(const u32x4*)(XBC + (size_t)(nb_ + r) * 1280 + 768 + g * 128 + c16 * 8);
    }
#pragma unroll
    for (int i = 0; i < 2; ++i) {
      const int idx = tid + 256 * i, r = idx >> 3, c8 = idx & 7;
      px[i] = *(const u32x4*)(XBC + (size_t)(nb_ + r) * 1280 + e * 64 + c8 * 8);
    }
    pru = PROJ[(size_t)(nb_ + lane) * NPAD + C_DT + e];
  }
#pragma unroll 1
  for (int cc = c0; cc < c0 + CPS; ++cc) {
    const int base = b * 2048 + cc * 64;
#pragma unroll
    for (int i = 0; i < 4; ++i) {
      const int idx = tid + 256 * i, r = idx >> 4, c16 = idx & 15;
      if (!SONLY) *(u32x4*)(Cs + r * 136 + c16 * 8) = pc[i];
      *(u32x4*)(Bs + r * 136 + c16 * 8) = pb[i];
    }
    u32x4 xr[2];
    xr[0] = px[0]; xr[1] = px[1];
    if (w == 0) {
      const float dtv = softplus_f(bf2f(pru) + dtb);
      float a = dtv * ah;
#pragma unroll
      for (int d = 1; d < 64; d <<= 1) { const float t = __shfl_up(a, d); if (lane >= d) a += t; }
      dt_s[lane] = dtv; acs_s[lane] = a;
    }
    {
      const int nb_ = b * 2048 + ((cc + 1 < c0 + CPS) ? (cc + 1) : cc) * 64;
#pragma unroll
      for (int i = 0; i < 4; ++i) {
        const int idx = tid + 256 * i, r = idx >> 4, c16 = idx & 15;
        if (!SONLY) pc[i] = *(const u32x4*)(XBC + (size_t)(nb_ + r) * 1280 + 1024 + g * 128 + c16 * 8);
        pb[i] = *(const u32x4*)(XBC + (size_t)(nb_ + r) * 1280 + 768 + g * 128 + c16 * 8);
      }
#pragma unroll
      for (int i = 0; i < 2; ++i) {
        const int idx = tid + 256 * i, r = idx >> 3, c8 = idx & 7;
        px[i] = *(const u32x4*)(XBC + (size_t)(nb_ + r) * 1280 + e * 64 + c8 * 8);
      }
      pru = PROJ[(size_t)(nb_ + lane) * NPAD + C_DT + e];
    }
    uint2 dx[4], dz[4];
    if (!SONLY)
#pragma unroll
    for (int qt = 0; qt < 4; ++qt) {
      const size_t row = (size_t)(base + qt * 16 + l15);
      const int pcol = w * 16 + quad * 4;
      dx[qt] = *(const uint2*)(XBC + row * 1280 + e * 64 + pcol);
      dz[qt] = *(const uint2*)(PROJ + row * NPAD + C_Z + e * 64 + pcol);
    }
    __syncthreads();
    dtot += acs_s[63];
    if (!(PROBE & 2)) {
#pragma unroll
    for (int i = 0; i < 2; ++i) {
      const int idx = tid + 256 * i, r = idx >> 3, c8 = idx & 7;
      const float dtv = dt_s[r];
      float f[8]; unpack8v(xr[i], f);
#pragma unroll
      for (int j = 0; j < 8; ++j) Xt[(c8 * 8 + j) * 72 + r] = f2bf(f[j] * dtv);
    }
    {
      const int q = tid & 63, ng = tid >> 6;
      const float dte = __expf(acs_s[63] - acs_s[q]);
#pragma unroll
      for (int i = 0; i < 8; ++i) {
        const uint2 v = *(const uint2*)(Bs + q * 136 + ng * 32 + i * 4);
        Bt2[(ng * 32 + i * 4 + 0) * 72 + q] = f2bf(bflo(v.x) * dte);
        Bt2[(ng * 32 + i * 4 + 1) * 72 + q] = f2bf(bfhi(v.x) * dte);
        Bt2[(ng * 32 + i * 4 + 2) * 72 + q] = f2bf(bflo(v.y) * dte);
        Bt2[(ng * 32 + i * 4 + 3) * 72 + q] = f2bf(bfhi(v.y) * dte);
      }
    }
    }
    __syncthreads();
    if (!(PROBE & 4) && !SONLY) {
      const int q = w * 16 + l15;
      const float aq = acs_s[q];
      bf16x8 cfr[4];
#pragma unroll
      for (int ks = 0; ks < 4; ++ks) cfr[ks] = ldfrag(Cs, 136, w * 16, ks * 32, lane);
#pragma unroll
      for (int st = 0; st < 4; ++st) {
        uint2 ov;
        const int s0 = st * 16 + quad * 4;
        {
          f32x4 acc = (f32x4){0.f, 0.f, 0.f, 0.f};
#pragma unroll
          for (int ks = 0; ks < 4; ++ks) acc = mfma16(ldfrag(Bs, 136, st * 16, ks * 32, lane), cfr[ks], acc);
          float v[4];
#pragma unroll
          for (int r = 0; r < 4; ++r) { const int s = s0 + r; v[r] = (s <= q) ? acc[r] * __expf(fminf(aq - acs_s[s], 0.f)) : 0.f; }
          ov.x = pack2(v[0], v[1]); ov.y = pack2(v[2], v[3]);
        }
        *(uint2*)(Ms + q * 72 + s0) = ov;
      }
    }
    f32x4 y[4];
#pragma unroll
    for (int qt = 0; qt < 4; ++qt) y[qt] = (f32x4){0.f, 0.f, 0.f, 0.f};
    if (!(PROBE & 4) && !SONLY)
#pragma unroll
    for (int kk = 0; kk < 4; ++kk) {
      const bf16x8 hf = packfrag(h[2 * kk], h[2 * kk + 1]);
#pragma unroll
      for (int qt = 0; qt < 4; ++qt) y[qt] = mfma16(hf, ldfrag_perm(Cs, 136, qt * 16, kk * 32, lane), y[qt]);
    }
    if (!SONLY) {
#pragma unroll
    for (int qt = 0; qt < 4; ++qt) y[qt] *= __expf(acs_s[qt * 16 + l15]);
    __syncthreads();
    }
    if (!(PROBE & 8) && !SONLY)
#pragma unroll
    for (int qt = 0; qt < 4; ++qt)
#pragma unroll
      for (int ks = 0; ks < 2; ++ks)
        if (ks == 0 || qt >= 2) y[qt] = mfma16(ldfrag(Xt, 72, w * 16, ks * 32, lane), ldfrag(Ms, 72, qt * 16, ks * 32, lane), y[qt]);
    if (!(PROBE & 8)) {
      const float cd = __expf(acs_s[63]);
#pragma unroll
      for (int nt = 0; nt < 8; ++nt) h[nt] *= cd;
#pragma unroll
      for (int ks = 0; ks < 2; ++ks) {
        const bf16x8 xf = ldfrag(Xt, 72, w * 16, ks * 32, lane);
#pragma unroll
        for (int nt = 0; nt < 8; ++nt) h[nt] = mfma16(ldfrag(Bt2, 72, nt * 16, ks * 32, lane), xf, h[nt]);
      }
    }
    if (!SONLY)
#pragma unroll
    for (int qt = 0; qt < 4; ++qt) {
      const int q = qt * 16 + l15;
      const size_t row = (size_t)(base + q);
      const int pcol = w * 16 + quad * 4;
      const uint2 xv = dx[qt];
      const uint2 zv = dz[qt];
      const float y0 = (y[qt][0] + Dv * bflo(xv.x)) * silu_f(bflo(zv.x));
      const float y1 = (y[qt][1] + Dv * bfhi(xv.x)) * silu_f(bfhi(zv.x));
      const float y2 = (y[qt][2] + Dv * bflo(xv.y)) * silu_f(bflo(zv.y));
      const float y3 = (y[qt][3] + Dv * bfhi(xv.y)) * silu_f(bfhi(zv.y));
      uint2 ov; ov.x = pack2(y0, y1); ov.y = pack2(y2, y3);
      if (do_store) *(uint2*)(MIX + row * 2048 + 1280 + e * 64 + pcol) = ov;
      float ss = y0 * y0 + y1 * y1 + y2 * y2 + y3 * y3;
      ss += __shfl_xor(ss, 16);
      ss += __shfl_xor(ss, 32);
      if (quad == 0) ssq_s[w * 64 + q] = ss;
    }
    __syncthreads();
    if (do_store && !SONLY) if (tid < 64) SSQ[(size_t)(base + tid) * 12 + e] = ssq_s[tid] + ssq_s[64 + tid] + ssq_s[128 + tid] + ssq_s[192 + tid];
  }
  if (do_store && write_final) {
    float* oh = p.out + O_PSH + (size_t)((layer * 8 + b) * 12 + e) * 64 * 128;
    const int pidx = w * 16 + l15;
#pragma unroll
    for (int nt = 0; nt < 8; ++nt) {
      const int n = nt * 16 + quad * 4;
      *(float4*)(oh + (size_t)pidx * 128 + n) = make_float4(h[nt][0], h[nt][1], h[nt][2], h[nt][3]);
    }
  }
}


DI unsigned flag_ld(unsigned* f) { return __hip_atomic_load(f, __ATOMIC_RELAXED, __HIP_MEMORY_SCOPE_AGENT); }
template <int PROBE>
PH void ssd_prompt_item(const Params& p, int layer, int b, int e, int seg) {
  const int tid = opaque_tid(), lane = tid & 63, w = tid >> 6, quad = lane >> 4, l15 = lane & 15;
  float* SEND = (float*)(p.ws + WS_SEND) + (size_t)((layer * 96 + b * 12 + e) * NSEG) * 8192;
  unsigned* SFLAG = (unsigned*)(p.ws + WS_SFLAG) + (layer * 96 + b * 12 + e) * NSEG;
  f32x4 h[8];
#pragma unroll
  for (int i = 0; i < 8; ++i) h[i] = (f32x4){0.f, 0.f, 0.f, 0.f};
  float dtot = 0.f;
  const size_t eoff = (size_t)(w * 16 + l15) * 128 + quad * 4;
  if (seg < NSEG - 1) ssd_chunk_loop<PROBE, 1, 10>(p, layer, b, e, seg * 10, h, dtot, false);
  if (seg > 0) {
    if (tid == 0) {
      unsigned sp = 0;
      while (flag_ld(SFLAG + seg - 1) == 0u) { __builtin_amdgcn_s_sleep(2); if (++sp > (1u << 22)) break; }
    }
    __syncthreads();
    __builtin_amdgcn_fence(__ATOMIC_ACQUIRE, "agent");
    asm volatile("s_waitcnt vmcnt(0)" ::: "memory");
    const float* hin = SEND + (size_t)(seg - 1) * 8192 + eoff;
    const float fdec = __expf(dtot);
#pragma unroll
    for (int nt = 0; nt < 8; ++nt) {
      const float4 v = *(const float4*)(hin + nt * 16);
      const f32x4 hv = (f32x4){v.x, v.y, v.z, v.w};
      if (seg < NSEG - 1) {
        const f32x4 he = fdec * hv + h[nt];
        *(float4*)(SEND + (size_t)seg * 8192 + eoff + nt * 16) = make_float4(he[0], he[1], he[2], he[3]);
      }
      h[nt] = hv;
    }
  } else {
#pragma unroll
    for (int nt = 0; nt < 8; ++nt) {
      *(float4*)(SEND + eoff + nt * 16) = make_float4(h[nt][0], h[nt][1], h[nt][2], h[nt][3]);
      h[nt] = (f32x4){0.f, 0.f, 0.f, 0.f};
    }
  }
  if (seg < NSEG - 1) {
    __builtin_amdgcn_fence(__ATOMIC_RELEASE, "agent");
    asm volatile("s_waitcnt vmcnt(0)" ::: "memory");
    __syncthreads();
    if (tid == 0) __hip_atomic_store(SFLAG + seg, 1u, __ATOMIC_RELAXED, __HIP_MEMORY_SCOPE_AGENT);
  }
  float dummy = 0.f;
  if (seg < NSEG - 1) ssd_chunk_loop<PROBE, 0, 10>(p, layer, b, e, seg * 10, h, dummy, false);
  else ssd_chunk_loop<PROBE, 0, 12>(p, layer, b, e, 20, h, dummy, true);
}

PH void ssd_decode_item(const Params& p, int layer, int b, int e) {
  SMEM;
  const int tid = opaque_tid();
  const int g = e / 6;
  float* xs_s = (float*)smem;
  float* Bv = xs_s + 64;
  float* Cv = Bv + 128;
  float* ys = Cv + 128;
  const u16* PROJ = (const u16*)(p.ws + WS_PROJ);
  const u16* XBC = (const u16*)(p.ws + WS_XBC);
  u16* MIX = (u16*)(p.ws + WS_MIX);
  float* SSQ = (float*)(p.ws + WS_SSQ);
  const size_t row = (size_t)(MP + b);
  const float* h0 = p.in[7] + (size_t)((layer * 128 + b) * 12 + e) * 64 * 128;
  float* h1 = p.out + O_SSH + (size_t)((layer * 128 + b) * 12 + e) * 64 * 128;
  const int n4 = tid & 31;
  f32x4 hv[8];
  u16 zv[8];
#pragma unroll
  for (int i = 0; i < 8; ++i) {
    const int pidx = (tid >> 5) + 8 * i;
    hv[i] = *(const f32x4*)(h0 + (size_t)pidx * 128 + n4 * 4);
    zv[i] = PROJ[row * NPAD + C_Z + e * 64 + pidx];
  }
  const u16 xsr = XBC[row * 1280 + e * 64 + (tid & 63)];
  const u16 bvr = XBC[row * 1280 + 768 + g * 128 + (tid & 127)];
  const u16 cvr = XBC[row * 1280 + 1024 + g * 128 + (tid & 127)];
  const float dtv = softplus_f(bf2f(PROJ[row * NPAD + C_DT + e]) + p.in[20][layer * 12 + e]);
  const float dA = __expf(dtv * (-__expf(p.in[21][layer * 12 + e])));
  const float Dv = p.in[22][layer * 12 + e];
  if (tid < 64) xs_s[tid] = bf2f(xsr);
  if (tid < 128) { Bv[tid] = bf2f(bvr); Cv[tid] = bf2f(cvr); }
  __syncthreads();
  const float4 Bq = *(const float4*)(Bv + n4 * 4), Cq = *(const float4*)(Cv + n4 * 4);
#pragma unroll
  for (int i = 0; i < 8; ++i) {
    const int pidx = (tid >> 5) + 8 * i;
    const float xsv = xs_s[pidx];
    const float xdt = dtv * xsv;
    f32x4 hn;
    hn[0] = dA * hv[i][0] + xdt * Bq.x; hn[1] = dA * hv[i][1] + xdt * Bq.y; hn[2] = dA * hv[i][2] + xdt * Bq.z; hn[3] = dA * hv[i][3] + xdt * Bq.w;
    *(f32x4*)(h1 + (size_t)pidx * 128 + n4 * 4) = hn;
    float part = Cq.x * hn[0] + Cq.y * hn[1] + Cq.z * hn[2] + Cq.w * hn[3];
#pragma unroll
    for (int d = 1; d < 32; d <<= 1) part += __shfl_xor(part, d);
    if (n4 == 0) ys[pidx] = (part + Dv * xsv) * silu_f(bf2f(zv[i]));
  }
  __syncthreads();
  if (tid < 64) {
    const float v = ys[tid];
    MIX[row * 2048 + 1280 + e * 64 + tid] = f2bf(v);
    float ss = v * v;
#pragma unroll
    for (int d = 1; d < 64; d <<= 1) ss += __shfl_xor(ss, d);
    if (tid == 0) SSQ[row * 12 + e] = ss;
  }
}

#define XB_TMO      128
#define XB_XCNT(j)  (256  + 64 * (j))
#define XB_XSUB(j)  (1280 + 64 * (j))
#define XB_XGEN(j)  (2304 + 64 * (j))
#define XB_TOP      3328
#define XB_TOPGEN   3392
#define XCD_BAR_WORDS 3456
#define XB_SPIN_CAP (1u << 18)
#define LAS __attribute__((address_space(3)))
DI unsigned xb_ld(unsigned* p)              { return __hip_atomic_load(p, __ATOMIC_RELAXED, __HIP_MEMORY_SCOPE_AGENT); }
DI unsigned xb_add(unsigned* p, unsigned v) { return __hip_atomic_fetch_add(p, v, __ATOMIC_RELAXED, __HIP_MEMORY_SCOPE_AGENT); }
DI unsigned xb_xcc_id() { return (unsigned)__builtin_amdgcn_s_getreg((3 << 11) | 20) & 0xFu; }
#define XB_SPIN(cond, bar) do { unsigned _sp = 0; while (cond) { __builtin_amdgcn_s_sleep(1); \
    if ((++_sp & 255u) == 0u) { if (xb_ld(&(bar)[XB_TMO])) break; if (_sp > XB_SPIN_CAP) { atomicAdd(&(bar)[XB_TMO], 1u); break; } } } } while (0)
struct XcdBarrier { unsigned* bar; unsigned x; volatile LAS unsigned* st; };
DI XcdBarrier xcd_barrier_post(unsigned* bar, volatile LAS unsigned* st) {
  XcdBarrier b; b.bar = bar; b.x = xb_xcc_id(); b.st = st;
  if (threadIdx.x == 0) (void)xb_add(&bar[XB_XCNT(b.x)], 1u);
  return b;
}
DI void xcd_barrier_complete(unsigned* bar, unsigned x, unsigned& nloc, unsigned& nx) {
  const unsigned G = gridDim.x * gridDim.y * gridDim.z;
  unsigned sum, cnt, mine, sp = 0u;
  for (;;) {
    sum = 0u; cnt = 0u; mine = 0u;
#pragma unroll
    for (unsigned j = 0; j < 16; ++j) { const unsigned c = xb_ld(&bar[XB_XCNT(j)]); sum += c; cnt += (c > 0u) ? 1u : 0u; mine = (j == x) ? c : mine; }
    if (sum == G) break;
    __builtin_amdgcn_s_sleep(1);
    if ((++sp & 255u) == 0u) { if (xb_ld(&bar[XB_TMO])) break; if (sp > XB_SPIN_CAP) { atomicAdd(&bar[XB_TMO], 1u); break; } }
  }
  nloc = mine > 0u ? mine : 1u; nx = cnt > 0u ? cnt : 1u;
}
DI void xcd_barrier(const XcdBarrier& b) {
  asm volatile("s_waitcnt vmcnt(0)" ::: "memory");
  __syncthreads();
  if (threadIdx.x == 0) {
    unsigned* bar = b.bar;
    __builtin_amdgcn_s_waitcnt(0);
    unsigned nloc = b.st[0], nx = b.st[1];
    if (nloc == 0u) { xcd_barrier_complete(bar, b.x, nloc, nx); b.st[0] = nloc; b.st[1] = nx; }
    const unsigned old = xb_add(&bar[XB_XSUB(b.x)], 1u);
    const unsigned gen = old / nloc;
    if (old + 1u == (gen + 1u) * nloc) {
      __builtin_amdgcn_fence(__ATOMIC_RELEASE, "agent");
      asm volatile("s_waitcnt vmcnt(0)" ::: "memory");
      const unsigned og = xb_add(&bar[XB_TOP], 1u);
      const unsigned tg = og / nx;
      if (og + 1u == (tg + 1u) * nx) xb_add(&bar[XB_TOPGEN], 1u);
      else XB_SPIN(xb_ld(&bar[XB_TOPGEN]) == tg, bar);
      __builtin_amdgcn_fence(__ATOMIC_ACQUIRE, "agent");
      xb_add(&bar[XB_XGEN(b.x)], 1u);
      asm volatile("s_waitcnt vmcnt(0)" ::: "memory");
    } else {
      XB_SPIN(xb_ld(&bar[XB_XGEN(b.x)]) == gen, bar);
      __builtin_amdgcn_fence(__ATOMIC_ACQUIRE, "agent");
      asm volatile("s_waitcnt vmcnt(0)" ::: "memory");
    }
  }
  __syncthreads();
}

#define REP_PREP 1
#define REP_G0 1
#define REP_2A 1
#define REP_2B 1
#define REP_G1 1
#define REP_LN 1
#define REP_SYNC 0
#define PROBE_SSD 0
#define PROBE_2B_LO 0
#define PROBE_2B_HI 96
__global__ void __launch_bounds__(256, 2) mega(Params p) {
  __shared__ int slot;
  __shared__ uint4 xb_words;
  cg::grid_group grid = cg::this_grid();
  unsigned* ctr = (unsigned*)(p.ws + WS_CTR);
  if (threadIdx.x == 0) xb_words = make_uint4(0u, 0u, 0u, 0u);
  __syncthreads();
  XcdBarrier xb = xcd_barrier_post((unsigned*)(p.ws + WS_BAR), (volatile LAS unsigned*)&xb_words);
  if (p.ws == nullptr) grid.sync();
  for (int rep = 0; rep < REP_PREP; ++rep) { phase_prep(p); xcd_barrier(xb); }
#pragma unroll 1
  for (int layer = 0; layer < 4; ++layer) {
    for (int rep = 0; rep < REP_G0; ++rep) { gemm_phase<0>(p, layer); xcd_barrier(xb); }
    for (int rep = 0; rep < REP_2A; ++rep) {
      bool first = true;
      for (;;) {
        int it;
        if (first) { it = (int)blockIdx.x; first = false; }
        else it = next_item(ctr + layer * 2 + 8 * rep, &slot) + (int)gridDim.x;
        if (it >= 136 + 512) break;
        it = (it < 512) ? (it + 136) : (it - 512);
        if (it < 136) conv_unit(p, layer, it);
        else if (it < 392) attn_prompt_item(p, layer, it - 136);
        else attn_decode_item(p, layer, it - 392);
      }
      xcd_barrier(xb);
    }
    for (int rep = 0; rep < REP_2B; ++rep) {
      bool first = true;
      for (;;) {
        int it;
        if (first) { it = (int)blockIdx.x; first = false; }
        else it = next_item(ctr + layer * 2 + 1 + 8 * rep, &slot) + (int)gridDim.x;
        if (rep > 0) { it += PROBE_2B_LO; if (it >= PROBE_2B_HI) break; }
        if (it >= 288 + 192 + 24 + 1536) break;
        it = (it < 192) ? (it + 384) : ((it < 480) ? (it - 192) : (it + 608));
        if (it < 384) { const int v = it % 96; ssd_prompt_item<0>(p, layer, v / 12, v % 12, it / 96); }
        else if (it < 576) { const int v = it - 384; lru_item(p, layer, v / 24, (v % 24) / 3, v % 3); }
        else if (it < 832) attn_prompt_item(p, layer, it - 576);
        else if (it < 1088) attn_decode_item(p, layer, it - 832);
        else if (it < 1112) { const int v = it - 1088; lru_item(p, layer, -1, v / 3, v % 3); }
        else { const int v = it - 1112; ssd_decode_item(p, layer, v / 12, v % 12); }
      }
      xcd_barrier(xb);
    }
    for (int rep = 0; rep < REP_G1; ++rep) { gemm_phase<1>(p, layer); xcd_barrier(xb); }
    for (int rep = 0; rep < REP_LN; ++rep) { ln_phase(p, layer); xcd_barrier(xb); }
    for (int rep = 0; rep < REP_SYNC; ++rep) xcd_barrier(xb);
  }
}

extern "C" void kernel_launch(void* const* d_in, const int* in_sizes, int n_in,
                              void* d_out, int out_size, void* d_ws, size_t ws_size,
                              hipStream_t stream) {
  static int grid_blocks = 0;
  if (grid_blocks == 0) {
    if (n_in != 26 || ws_size < WS_END) { fprintf(stderr, "kernel_launch: unexpected n_in %d or ws_size %zu (< %zu)\n", n_in, ws_size, (size_t)WS_END); grid_blocks = -1; return; }
    int dev = 0, cus = 0, per_cu = 0;
    hipGetDevice(&dev);
    hipDeviceGetAttribute(&cus, hipDeviceAttributeMultiprocessorCount, dev);
    if (hipFuncSetAttribute((const void*)mega, hipFuncAttributeMaxDynamicSharedMemorySize, LDS_BYTES) != hipSuccess) { fprintf(stderr, "kernel_launch: hipFuncSetAttribute failed\n"); grid_blocks = -1; return; }
    if (hipOccupancyMaxActiveBlocksPerMultiprocessor(&per_cu, (const void*)mega, 256, LDS_BYTES) != hipSuccess || per_cu < 1) { fprintf(stderr, "kernel_launch: occupancy query failed (%d)\n", per_cu); grid_blocks = -1; return; }
    if (per_cu > 2) per_cu = 2;
    grid_blocks = cus * per_cu;
  }
  if (grid_blocks < 0) return;
  Params p{};
  for (int i = 0; i < 26; ++i) p.in[i] = (const float*)d_in[i];
  p.out = (float*)d_out;
  p.ws = (char*)d_ws;
  if (hipMemsetAsync((char*)d_ws + WS_BAR, 0, 16384, stream) != hipSuccess) { fprintf(stderr, "kernel_launch: memset of barrier words failed\n"); return; }
  void* args[] = {&p};
  hipError_t e = hipLaunchCooperativeKernel((const void*)mega, dim3(grid_blocks), dim3(256), args, LDS_BYTES, stream);
  if (e != hipSuccess) fprintf(stderr, "cooperative launch failed: %s (grid %d)\n", hipGetErrorString(e), grid_blocks);
}
```

```cpp
#include <hip/hip_runtime.h>
#include <hip/hip_cooperative_groups.h>
#include <cstdio>
namespace cg = cooperative_groups;

#define DI __device__ __forceinline__
#define PH __device__ __forceinline__
#define SMEM extern __shared__ __attribute__((aligned(16))) char smem[]
typedef unsigned short u16;
using bf16x8 = __attribute__((ext_vector_type(8))) short;
using f32x4 = __attribute__((ext_vector_type(4))) float;
using u32x4 = __attribute__((ext_vector_type(4))) unsigned;

constexpr int MP = 16384, MT = 16512;
constexpr int NPAD = 4992;
constexpr int C_K = 512, C_V = 640, C_GA = 768, C_XL = 1280, C_GL = 2048, C_Z = 2816, C_XBC = 3584, C_DT = 4864;
constexpr int LDS_BYTES = 73728;

constexpr size_t WS_WIN = 0;
constexpr size_t WS_WOUT = WS_WIN + (size_t)4 * NPAD * 1024 * 2;
constexpr size_t WS_WA = WS_WOUT + (size_t)4 * 1024 * 2048 * 2;
constexpr size_t WS_WX = WS_WA + (size_t)4 * 8 * 96 * 96 * 2;
constexpr size_t WS_XB = WS_WX + (size_t)4 * 8 * 96 * 96 * 2;
constexpr size_t WS_XF = WS_XB + (size_t)MT * 1024 * 2;
constexpr size_t WS_PRE = WS_XF + (size_t)MT * 1024 * 4;
constexpr size_t WS_PROJ = WS_PRE + (size_t)MT * 1024 * 4;
constexpr size_t WS_XL = WS_PROJ + (size_t)MT * NPAD * 2;
constexpr size_t WS_XBC = WS_XL + (size_t)MT * 768 * 2;
constexpr size_t WS_MIX = WS_XBC + (size_t)MT * 1280 * 2;
constexpr size_t WS_SSQ = WS_MIX + (size_t)MT * 2048 * 2;
constexpr size_t WS_ROPE = WS_SSQ + (size_t)MT * 12 * 4;
constexpr size_t WS_CTR = WS_ROPE + 131328;
constexpr size_t WS_SFLAG = WS_CTR + 256;
constexpr size_t WS_SEND = WS_SFLAG + 8192;
constexpr size_t WS_BAR = WS_SEND + (size_t)4 * 96 * 4 * 8192 * 4;
constexpr size_t WS_END = WS_BAR + 16384;

constexpr size_t O_YP = 0;
constexpr size_t O_YS = O_YP + (size_t)8 * 2048 * 1024;
constexpr size_t O_PK = O_YS + (size_t)128 * 1024;
constexpr size_t O_PV = O_PK + (size_t)4 * 8 * 128 * 2 * 64;
constexpr size_t O_PLC = O_PV + (size_t)4 * 8 * 128 * 2 * 64;
constexpr size_t O_PLH = O_PLC + (size_t)4 * 8 * 3 * 768;
constexpr size_t O_PSC = O_PLH + (size_t)4 * 8 * 768;
constexpr size_t O_PSH = O_PSC + (size_t)4 * 8 * 3 * 1280;
constexpr size_t O_SK = O_PSH + (size_t)4 * 8 * 12 * 64 * 128;
constexpr size_t O_SV = O_SK + (size_t)4 * 128 * 128 * 2 * 64;
constexpr size_t O_SLC = O_SV + (size_t)4 * 128 * 128 * 2 * 64;
constexpr size_t O_SLH = O_SLC + (size_t)4 * 128 * 3 * 768;
constexpr size_t O_SSC = O_SLH + (size_t)4 * 128 * 768;
constexpr size_t O_SSH = O_SSC + (size_t)4 * 128 * 3 * 1280;

struct Params {
  const float* in[26];
  float* out;
  char* ws;
};

typedef __bf16 bf2_t __attribute__((ext_vector_type(2)));
typedef float fl2_t __attribute__((ext_vector_type(2)));
DI u16 f2bf(float x) { return __builtin_bit_cast(u16, (__bf16)x); }
DI float bf2f(u16 b) { return __uint_as_float(((unsigned)b) << 16); }
DI unsigned pack2(float a, float b) { fl2_t v = {a, b}; return __builtin_bit_cast(unsigned, __builtin_convertvector(v, bf2_t)); }
DI float bflo(unsigned u) { return __uint_as_float(u << 16); }
DI float bfhi(unsigned u) { return __uint_as_float(u & 0xffff0000u); }
DI void unpack8(uint4 v, float* f) {
  f[0] = bflo(v.x); f[1] = bfhi(v.x); f[2] = bflo(v.y); f[3] = bfhi(v.y);
  f[4] = bflo(v.z); f[5] = bfhi(v.z); f[6] = bflo(v.w); f[7] = bfhi(v.w);
}
DI void unpack8v(u32x4 v, float* f) {
  f[0] = bflo(v[0]); f[1] = bfhi(v[0]); f[2] = bflo(v[1]); f[3] = bfhi(v[1]);
  f[4] = bflo(v[2]); f[5] = bfhi(v[2]); f[6] = bflo(v[3]); f[7] = bfhi(v[3]);
}
DI uint4 pack8(const float* f) {
  uint4 v; v.x = pack2(f[0], f[1]); v.y = pack2(f[2], f[3]); v.z = pack2(f[4], f[5]); v.w = pack2(f[6], f[7]); return v;
}
DI f32x4 mfma16(bf16x8 a, bf16x8 b, f32x4 c) { return __builtin_amdgcn_mfma_f32_16x16x32_bf16(a, b, c, 0, 0, 0); }
DI bf16x8 ldfrag(const u16* base, int ld, int row0, int k0, int lane) {
  return *(const bf16x8*)(base + (row0 + (lane & 15)) * ld + k0 + (lane >> 4) * 8);
}
DI bf16x8 ldfrag_perm(const u16* base, int ld, int row0, int k0, int lane) {
  const u16* pp = base + (row0 + (lane & 15)) * ld + k0 + (lane >> 4) * 4;
  uint2 a = *(const uint2*)pp; uint2 b = *(const uint2*)(pp + 16);
  uint4 v; v.x = a.x; v.y = a.y; v.z = b.x; v.w = b.y;
  return __builtin_bit_cast(bf16x8, v);
}
DI bf16x8 packfrag(f32x4 t0, f32x4 t1) {
  uint4 v; v.x = pack2(t0[0], t0[1]); v.y = pack2(t0[2], t0[3]); v.z = pack2(t1[0], t1[1]); v.w = pack2(t1[2], t1[3]);
  return __builtin_bit_cast(bf16x8, v);
}
DI float silu_f(float x) { return x * __builtin_amdgcn_rcpf(1.f + __expf(-x)); }
DI float sigmoid_f(float x) { return __builtin_amdgcn_rcpf(1.f + __expf(-x)); }
DI float softplus_f(float x) { return x > 20.f ? x : log1pf(__expf(x)); }

DI int opaque_tid() { int t = threadIdx.x; asm volatile("" : "+v"(t)); return t; }
DI int next_item(unsigned* ctr, int* slot) {
  __syncthreads();
  if (threadIdx.x == 0) *slot = (int)atomicAdd(ctr, 1u);
  __syncthreads();
  return *slot;
}

PH void phase_prep(const Params& p) {
  SMEM;
  const int tid = opaque_tid();
  float* tile = (float*)smem;
  u16* WinT = (u16*)(p.ws + WS_WIN);
  u16* WoutT = (u16*)(p.ws + WS_WOUT);
  u16* Xb = (u16*)(p.ws + WS_XB);
  float* ROPE = (float*)(p.ws + WS_ROPE);
  unsigned* ctr = (unsigned*)(p.ws + WS_CTR);
  if (blockIdx.x == 0 && tid < 64) ctr[tid] = 0u;
  if (blockIdx.x == 1) { unsigned* sf = (unsigned*)(p.ws + WS_SFLAG); for (int i = tid; i < 2048; i += 256) sf[i] = 0u; }
  constexpr int U_WIN = 4 * 16 * 78;
  constexpr int U_WOUT = 4 * 32 * 16;
  constexpr int U_LW = 64;
  constexpr int U_XB = MT * 1024 / 2048;
  constexpr int U_ROPE = 65;
  constexpr int U_TOT = U_WIN + U_WOUT + U_LW + U_XB + U_ROPE;
  for (int u = blockIdx.x; u < U_TOT; u += gridDim.x) {
    if (u < U_WIN) {
      const int l = u / (16 * 78), r = u % (16 * 78), kt = r / 78, nt = r % 78;
      const float* src = p.in[8] + (size_t)l * 1024 * 4876;
#pragma unroll
      for (int i = 0; i < 16; ++i) {
        const int k = (tid >> 6) + 4 * i, n = nt * 64 + (tid & 63);
        tile[k * 65 + (tid & 63)] = (n < 4876) ? src[(size_t)(kt * 64 + k) * 4876 + n] : 0.f;
      }
      __syncthreads();
      u16* dst = WinT + (size_t)l * NPAD * 1024;
#pragma unroll
      for (int i = 0; i < 8; ++i) {
        const int nn = (tid >> 5) + 8 * i, k = (tid & 31) * 2;
        *(unsigned*)(dst + (size_t)(nt * 64 + nn) * 1024 + kt * 64 + k) = pack2(tile[k * 65 + nn], tile[(k + 1) * 65 + nn]);
      }
      __syncthreads();
    } else if (u < U_WIN + U_WOUT) {
      const int v = u - U_WIN;
      const int l = v / (32 * 16), r = v % (32 * 16), kt = r / 16, nt = r % 16;
      const float* src = p.in[9] + (size_t)l * 2048 * 1024;
      const float* ng = p.in[23] + l * 768;
#pragma unroll
      for (int i = 0; i < 16; ++i) {
        const int k = (tid >> 6) + 4 * i, kg = kt * 64 + k;
        const float sc = (kg >= 1280) ? ng[kg - 1280] : 1.f;
        tile[k * 65 + (tid & 63)] = src[(size_t)kg * 1024 + nt * 64 + (tid & 63)] * sc;
      }
      __syncthreads();
      u16* dst = WoutT + (size_t)l * 1024 * 2048;
#pragma unroll
      for (int i = 0; i < 8; ++i) {
        const int nn = (tid >> 5) + 8 * i, k = (tid & 31) * 2;
        *(unsigned*)(dst + (size_t)(nt * 64 + nn) * 2048 + kt * 64 + k) = pack2(tile[k * 65 + nn], tile[(k + 1) * 65 + nn]);
      }
      __syncthreads();
    } else if (u < U_WIN + U_WOUT + U_LW) {
      const int v = u - U_WIN - U_WOUT;
      const int l = v / 16, rem = v % 16, n = rem / 2, which = rem % 2;
      const float* src = (which ? p.in[15] : p.in[13]) + (size_t)(l * 8 + n) * 9216;
      u16* dst = (u16*)(p.ws + (which ? WS_WX : WS_WA)) + (size_t)(l * 8 + n) * 9216;
      for (int e = tid; e < 9216; e += 256) {
        const int d = e / 96, c = e % 96;
        dst[e] = f2bf(src[c * 96 + d]);
      }
    } else if (u < U_WIN + U_WOUT + U_LW + U_XB) {
      const int v = u - U_WIN - U_WOUT - U_LW;
      const size_t ge = (size_t)v * 2048 + (size_t)tid * 8;
      const float* src = (ge < (size_t)MP * 1024) ? (p.in[0] + ge) : (p.in[1] + (ge - (size_t)MP * 1024));
      const float4 a = *(const float4*)src, b = *(const float4*)(src + 4);
      uint4 o; o.x = pack2(a.x, a.y); o.y = pack2(a.z, a.w); o.z = pack2(b.x, b.y); o.w = pack2(b.z, b.w);
      *(uint4*)(Xb + ge) = o;
    } else {
      const int v = u - U_WIN - U_WOUT - U_LW - U_XB;
      const int e = v * 256 + tid;
      if (e < 2049 * 8) {
        const int pi = e >> 3, i = e & 7;
        const double pos = (pi < 2048) ? (double)pi : 8192.0;
        const double inv = pow(500000.0, -(double)i / 8.0);
        double sn, cs; sincos(pos * inv, &sn, &cs);
        ROPE[e * 2 + 0] = (float)cs; ROPE[e * 2 + 1] = (float)sn;
      }
    }
  }
}

DI void tile_coords(int t, int NTN, int& m0, int& n0) {
  const int panel = t / (8 * NTN), within = t % (8 * NTN);
  int tm, tn;
  if (panel < 16) { tn = within >> 3; tm = panel * 8 + (within & 7); } else { tm = 128; tn = t - 16 * 8 * NTN; }
  m0 = tm * 128; n0 = tn * 128;
}
template <int MODE>
PH void gemm_phase(const Params& p, int layer) {
  SMEM;
  constexpr int K = (MODE == 0) ? 1024 : 2048;
  constexpr int NTN = (MODE == 0) ? 39 : 8;
  constexpr int NK = K / 64;
  constexpr int LOGNK = (MODE == 0) ? 4 : 5;
  const u16* X = (const u16*)(p.ws + (MODE == 0 ? WS_XB : WS_MIX));
  const u16* W = (const u16*)(p.ws + (MODE == 0 ? WS_WIN : WS_WOUT)) + (size_t)layer * (MODE == 0 ? (size_t)NPAD * 1024 : (size_t)1024 * 2048);
  u16* sX = (u16*)smem;
  u16* sW = sX + 2 * 128 * 72;
  const int tid = opaque_tid(), lane = tid & 63, w = tid >> 6, quad = lane >> 4, l15 = lane & 15;
  const int wn = w >> 1, wm = w & 1;
  const int ntiles = 129 * NTN;
  const int G = gridDim.x, bid = blockIdx.x;
  const int off = ((G & 7) == 0) ? ((bid & 7) * (G >> 3) + (bid >> 3)) : bid;
  if (off < ntiles) {
    const int nt_b = (ntiles - off + G - 1) / G;
    const int total = nt_b << LOGNK;
    const int soff = (tid >> 3) * 72 + (tid & 7) * 8;
    const int rowoff = tid >> 3, coloff = (tid & 7) * 8;
    f32x4 acc[4][4];
    u32x4 rx[2][4], rw[2][4];
#define GLOAD(S, g_) { \
      const int gg_ = ((g_) < total) ? (g_) : (total - 1); \
      const int it_ = gg_ >> LOGNK, kt_ = gg_ & (NK - 1); \
      int m0_, n0_; tile_coords(it_ * G + off, NTN, m0_, n0_); \
      const int k0_ = ((MODE == 0) ? kt_ : ((kt_ + 20) & 31)) * 64; \
      const u16* gx_ = X + (size_t)(m0_ + rowoff) * K + coloff + k0_; \
      const u16* gw_ = W + (size_t)(n0_ + rowoff) * K + coloff + k0_; \
      _Pragma("unroll") for (int i = 0; i < 4; ++i) { \
        rx[S][i] = *(const u32x4*)(gx_ + (size_t)i * 32 * K); \
        rw[S][i] = *(const u32x4*)(gw_ + (size_t)i * 32 * K); } }
#define LSTORE(S, buf_) { \
      u16* dX_ = sX + (buf_) * 128 * 72; u16* dW_ = sW + (buf_) * 128 * 72; \
      _Pragma("unroll") for (int i = 0; i < 4; ++i) { \
        *(u32x4*)(dX_ + soff + i * 32 * 72) = rx[S][i]; \
        *(u32x4*)(dW_ + soff + i * 32 * 72) = rw[S][i]; } }
    GLOAD(0, 0); GLOAD(1, 1);
    LSTORE(0, 0);
    __syncthreads();
#pragma unroll 1
    for (int g0 = 0; g0 < total; g0 += 2) {
#pragma unroll
      for (int s = 0; s < 2; ++s) {
        const int g = g0 + s;
        {
          const int kt = g & (NK - 1), it = g >> LOGNK;
          if (kt == 0) {
#pragma unroll
            for (int a = 0; a < 4; ++a)
#pragma unroll
              for (int b = 0; b < 4; ++b) acc[a][b] = (f32x4){0.f, 0.f, 0.f, 0.f};
          }
          if (MODE == 1 && kt == 12) {
            int m0, n0; tile_coords(it * G + off, NTN, m0, n0);
            const float* SSQ = (const float*)(p.ws + WS_SSQ);
#pragma unroll
            for (int mt = 0; mt < 4; ++mt) {
              const int m = m0 + wm * 64 + mt * 16 + l15;
              const float4 s0 = *(const float4*)(SSQ + (size_t)m * 12), s1 = *(const float4*)(SSQ + (size_t)m * 12 + 4), s2 = *(const float4*)(SSQ + (size_t)m * 12 + 8);
              const float ss = s0.x + s0.y + s0.z + s0.w + s1.x + s1.y + s1.z + s1.w + s2.x + s2.y + s2.z + s2.w;
              const float rs = rsqrtf(ss * (1.f / 768.f) + 1e-5f);
#pragma unroll
              for (int nt = 0; nt < 4; ++nt) acc[nt][mt] *= rs;
            }
          }
          const u16* cX = sX + (g & 1) * 128 * 72;
          const u16* cW = sW + (g & 1) * 128 * 72;
          u16* dX = sX + ((g + 1) & 1) * 128 * 72;
          u16* dW = sW + ((g + 1) & 1) * 128 * 72;
#pragma unroll
          for (int ks = 0; ks < 2; ++ks) {
            bf16x8 wf[4], xf[4];
#pragma unroll
            for (int i = 0; i < 4; ++i) {
              wf[i] = ldfrag(cW, 72, wn * 64 + i * 16, ks * 32, lane);
              xf[i] = ldfrag(cX, 72, wm * 64 + i * 16, ks * 32, lane);
            }
            __builtin_amdgcn_sched_barrier(0);
#pragma unroll
            for (int nt = 0; nt < 4; ++nt) {
#pragma unroll
              for (int mt = 0; mt < 4; ++mt) acc[nt][mt] = mfma16(wf[nt], xf[mt], acc[nt][mt]);
              if (ks == 0) *(u32x4*)(dX + soff + nt * 32 * 72) = rx[(s + 1) & 1][nt];
              else         *(u32x4*)(dW + soff + nt * 32 * 72) = rw[(s + 1) & 1][nt];
              __builtin_amdgcn_sched_barrier(0);
            }
            if (ks == 0) { GLOAD(s, g + 2); __builtin_amdgcn_sched_barrier(0); }
          }
          __syncthreads();
          if (kt == NK - 1) {
            int m0, n0; tile_coords(it * G + off, NTN, m0, n0);
            if (MODE == 0) {
              u16* PROJ = (u16*)(p.ws + WS_PROJ);
              u16* eX = sX + (g & 1) * 128 * 72;
              u16* eW = sW + (g & 1) * 128 * 72;
#pragma unroll
              for (int mt = 0; mt < 4; ++mt) {
                const int ml = mt * 16 + l15;
                u16* eb = (wm == 0 ? eX : eW) + ml * 136;
#pragma unroll
                for (int nt = 0; nt < 4; ++nt) {
                  const int nl = wn * 64 + nt * 16 + quad * 4;
                  uint2 o; o.x = pack2(acc[nt][mt][0], acc[nt][mt][1]); o.y = pack2(acc[nt][mt][2], acc[nt][mt][3]);
                  *(uint2*)(eb + nl) = o;
                }
              }
              __syncthreads();
#pragma unroll
              for (int i = 0; i < 8; ++i) {
                const int row = (tid >> 4) + 16 * i, ch = tid & 15;
                const u16* eb = (row < 64 ? eX + row * 136 : eW + (row - 64) * 136) + ch * 8;
                *(u32x4*)(PROJ + (size_t)(m0 + row) * NPAD + n0 + ch * 8) = *(const u32x4*)eb;
              }
              {
                const int tn_ = n0 >> 7;
                const bool is_lru = (tn_ >= 10) && (tn_ < 16), is_ssd = (tn_ >= 28) && (tn_ < 38);
                if ((is_lru || is_ssd) && m0 < MP) {
                  const int o = tid & 15, rbase = (tid >> 4) * 8;
                  const int nch = is_lru ? 768 : 1280;
                  const int chn = (is_lru ? (n0 - C_XL) : (n0 - C_XBC)) + o * 8;
                  const float* cw = (is_lru ? (p.in[11] + layer * 4 * 768) : (p.in[18] + layer * 4 * 1280)) + chn;
                  const float* cb = (is_lru ? (p.in[12] + layer * 768) : (p.in[19] + layer * 1280)) + chn;
                  u16* dst = (u16*)(p.ws + (is_lru ? WS_XL : WS_XBC)) + chn;
                  float w0[8], w1[8], w2[8], w3[8], bs[8];
#pragma unroll
                  for (int h = 0; h < 2; ++h) {
                    const float4 a0 = *(const float4*)(cw + 0 * nch + 4 * h), a1 = *(const float4*)(cw + 1 * nch + 4 * h);
                    const float4 a2 = *(const float4*)(cw + 2 * nch + 4 * h), a3 = *(const float4*)(cw + 3 * nch + 4 * h);
                    const float4 b4 = *(const float4*)(cb + 4 * h);
                    w0[4 * h] = a0.x; w0[4 * h + 1] = a0.y; w0[4 * h + 2] = a0.z; w0[4 * h + 3] = a0.w;
                    w1[4 * h] = a1.x; w1[4 * h + 1] = a1.y; w1[4 * h + 2] = a1.z; w1[4 * h + 3] = a1.w;
                    w2[4 * h] = a2.x; w2[4 * h + 1] = a2.y; w2[4 * h + 2] = a2.z; w2[4 * h + 3] = a2.w;
                    w3[4 * h] = a3.x; w3[4 * h + 1] = a3.y; w3[4 * h + 2] = a3.z; w3[4 * h + 3] = a3.w;
                    bs[4 * h] = b4.x; bs[4 * h + 1] = b4.y; bs[4 * h + 2] = b4.z; bs[4 * h + 3] = b4.w;
                  }
                  float xa[8], xb[8], xc[8], xd[8], yv[8];
#pragma unroll
                  for (int c = 0; c < 8; ++c) { xa[c] = 0.f; xb[c] = 0.f; xc[c] = 0.f; }
                  if (rbase >= 8) {
                    const int r1 = rbase - 3, r2 = rbase - 2, r3 = rbase - 1;
                    unpack8(*(const uint4*)((r1 < 64 ? eX + r1 * 136 : eW + (r1 - 64) * 136) + o * 8), xa);
                    unpack8(*(const uint4*)((r2 < 64 ? eX + r2 * 136 : eW + (r2 - 64) * 136) + o * 8), xb);
                    unpack8(*(const uint4*)((r3 < 64 ? eX + r3 * 136 : eW + (r3 - 64) * 136) + o * 8), xc);
                  }
#pragma unroll
                  for (int i = 0; i < 8; ++i) {
                    const int row = rbase + i;
                    unpack8(*(const uint4*)((row < 64 ? eX + row * 136 : eW + (row - 64) * 136) + o * 8), xd);
#pragma unroll
                    for (int c = 0; c < 8; ++c) {
                      const float v = bs[c] + w0[c] * xa[c] + w1[c] * xb[c] + w2[c] * xc[c] + w3[c] * xd[c];
                      yv[c] = is_lru ? v : silu_f(v);
                    }
                    if (row >= 3) *(uint4*)(dst + (size_t)(m0 + row) * nch) = pack8(yv);
#pragma unroll
                    for (int c = 0; c < 8; ++c) { xa[c] = xb[c]; xb[c] = xc[c]; xc[c] = xd[c]; }
                  }
                }
              }
              __syncthreads();
            } else {
              float* PRE = (float*)(p.ws + WS_PRE);
              const float alpha = 1.681792830507429f;
#pragma unroll
              for (int mt = 0; mt < 4; ++mt) {
                const int m = m0 + wm * 64 + mt * 16 + l15;
                const float* xres = (m < MP) ? (p.in[0] + (size_t)m * 1024) : (p.in[1] + (size_t)(m - MP) * 1024);
                const u16* xrb = (const u16*)(p.ws + WS_XB) + (size_t)m * 1024;
#pragma unroll
                for (int nt = 0; nt < 4; ++nt) {
                  const int n = n0 + wn * 64 + nt * 16 + quad * 4;
                  float4 xr;
                  if (layer == 0) xr = *(const float4*)(xres + n);
                  else { const uint2 xb2 = *(const uint2*)(xrb + n); xr = make_float4(bflo(xb2.x), bfhi(xb2.x), bflo(xb2.y), bfhi(xb2.y)); }
                  float4 o;
                  o.x = alpha * xr.x + acc[nt][mt][0]; o.y = alpha * xr.y + acc[nt][mt][1];
                  o.z = alpha * xr.z + acc[nt][mt][2]; o.w = alpha * xr.w + acc[nt][mt][3];
                  *(float4*)(PRE + (size_t)m * 1024 + n) = o;
                }
              }
            }
          }
        }
      }
    }
#undef GLOAD
#undef LSTORE
  }
}

PH void ln_phase(const Params& p, int layer) {
  const int tid = opaque_tid(), lane = tid & 63, w = tid >> 6;
  const float* PRE = (const float*)(p.ws + WS_PRE);
  u16* Xb = (u16*)(p.ws + WS_XB);
  const float* g = p.in[24] + layer * 1024;
  const float* bb = p.in[25] + layer * 1024;
  f32x4 gg[4], bv[4], nv[4];
#pragma unroll
  for (int i = 0; i < 4; ++i) {
    gg[i] = *(const f32x4*)(g + i * 256 + lane * 4);
    bv[i] = *(const f32x4*)(bb + i * 256 + lane * 4);
  }
  const int stride = gridDim.x * 4;
  int row = blockIdx.x * 4 + w;
  if (row < MT) {
#pragma unroll
    for (int i = 0; i < 4; ++i) nv[i] = *(const f32x4*)(PRE + (size_t)row * 1024 + i * 256 + lane * 4);
  }
#pragma unroll 1
  for (; row < MT; row += stride) {
    f32x4 v[4];
#pragma unroll
    for (int i = 0; i < 4; ++i) v[i] = nv[i];
    {
      const int nrow = (row + stride < MT) ? (row + stride) : row;
#pragma unroll
      for (int i = 0; i < 4; ++i) nv[i] = *(const f32x4*)(PRE + (size_t)nrow * 1024 + i * 256 + lane * 4);
    }
    float s = 0.f;
#pragma unroll
    for (int i = 0; i < 4; ++i) s += v[i][0] + v[i][1] + v[i][2] + v[i][3];
#pragma unroll
    for (int d = 1; d < 64; d <<= 1) s += __shfl_xor(s, d);
    const float mu = s * (1.f / 1024.f);
    float q = 0.f;
#pragma unroll
    for (int i = 0; i < 4; ++i) {
      v[i] -= mu;
      q += v[i][0] * v[i][0] + v[i][1] * v[i][1] + v[i][2] * v[i][2] + v[i][3] * v[i][3];
    }
#pragma unroll
    for (int d = 1; d < 64; d <<= 1) q += __shfl_xor(q, d);
    const float rs = rsqrtf(q * (1.f / 1024.f) + 1e-5f);
#pragma unroll
    for (int i = 0; i < 4; ++i) {
      const int c = i * 256 + lane * 4;
      const f32x4 o = v[i] * rs * gg[i] + bv[i];
      if (layer == 3) {
        float* dst = (row < MP) ? (p.out + O_YP + (size_t)row * 1024) : (p.out + O_YS + (size_t)(row - MP) * 1024);
        *(f32x4*)(dst + c) = o;
      } else {
        uint2 ob; ob.x = pack2(o[0], o[1]); ob.y = pack2(o[2], o[3]);
        *(uint2*)(Xb + (size_t)row * 1024 + c) = ob;
      }
    }
  }
}

PH void conv_unit(const Params& p, int layer, int unit) {
  const int tid = opaque_tid();
  const int T = (unit < 128) ? unit : 128, ru = (unit < 128) ? 0 : (unit - 128);
  const bool lru = tid < 96;
  const int oo = lru ? tid : tid - 96;
  const int nch = lru ? 768 : 1280;
  const int srccol = (lru ? C_XL : C_XBC) + 8 * oo;
  const float* cw = (lru ? (p.in[11] + layer * 4 * 768) : (p.in[18] + layer * 4 * 1280)) + 8 * oo;
  const float* cb = (lru ? (p.in[12] + layer * 768) : (p.in[19] + layer * 1280)) + 8 * oo;
  const u16* PROJ = (const u16*)(p.ws + WS_PROJ);
  u16* dst = (u16*)(p.ws + (lru ? WS_XL : WS_XBC)) + 8 * oo;
  float w0[8], w1[8], w2[8], w3[8], bs[8];
#pragma unroll
  for (int h = 0; h < 2; ++h) {
    const float4 a0 = *(const float4*)(cw + 0 * nch + 4 * h), a1 = *(const float4*)(cw + 1 * nch + 4 * h);
    const float4 a2 = *(const float4*)(cw + 2 * nch + 4 * h), a3 = *(const float4*)(cw + 3 * nch + 4 * h);
    const float4 b4 = *(const float4*)(cb + 4 * h);
    w0[4 * h] = a0.x; w0[4 * h + 1] = a0.y; w0[4 * h + 2] = a0.z; w0[4 * h + 3] = a0.w;
    w1[4 * h] = a1.x; w1[4 * h + 1] = a1.y; w1[4 * h + 2] = a1.z; w1[4 * h + 3] = a1.w;
    w2[4 * h] = a2.x; w2[4 * h + 1] = a2.y; w2[4 * h + 2] = a2.z; w2[4 * h + 3] = a2.w;
    w3[4 * h] = a3.x; w3[4 * h + 1] = a3.y; w3[4 * h + 2] = a3.z; w3[4 * h + 3] = a3.w;
    bs[4 * h] = b4.x; bs[4 * h + 1] = b4.y; bs[4 * h + 2] = b4.z; bs[4 * h + 3] = b4.w;
  }
  float xa[8], xb[8], xc[8], xd[8], y[8];
  if (T < 128) {
    const int r0 = T * 128, pos0 = r0 & 2047, b = r0 >> 11;
    if (pos0 == 0) {
#pragma unroll
      for (int c = 0; c < 8; ++c) { xa[c] = 0.f; xb[c] = 0.f; xc[c] = 0.f; }
    } else {
      unpack8(*(const uint4*)(PROJ + (size_t)(r0 - 3) * NPAD + srccol), xa);
      unpack8(*(const uint4*)(PROJ + (size_t)(r0 - 2) * NPAD + srccol), xb);
      unpack8(*(const uint4*)(PROJ + (size_t)(r0 - 1) * NPAD + srccol), xc);
    }
#pragma unroll
    for (int i = 0; i < 3; ++i) {
      const int row = r0 + i;
      unpack8(*(const uint4*)(PROJ + (size_t)row * NPAD + srccol), xd);
#pragma unroll
      for (int c = 0; c < 8; ++c) {
        float v = bs[c] + w0[c] * xa[c] + w1[c] * xb[c] + w2[c] * xc[c] + w3[c] * xd[c];
        y[c] = lru ? v : silu_f(v);
      }
      *(uint4*)(dst + (size_t)row * nch) = pack8(y);
#pragma unroll
      for (int c = 0; c < 8; ++c) { xa[c] = xb[c]; xb[c] = xc[c]; xc[c] = xd[c]; }
    }
    if ((T & 15) == 15) {
#pragma unroll
      for (int j = 0; j < 3; ++j) {
        unpack8(*(const uint4*)(PROJ + (size_t)(b * 2048 + 2045 + j) * NPAD + srccol), xd);
        float* op = p.out + (lru ? (O_PLC + (size_t)((layer * 8 + b) * 3 + j) * 768) : (O_PSC + (size_t)((layer * 8 + b) * 3 + j) * 1280)) + 8 * oo;
        *(float4*)op = make_float4(xd[0], xd[1], xd[2], xd[3]);
        *(float4*)(op + 4) = make_float4(xd[4], xd[5], xd[6], xd[7]);
      }
    }
  } else {
#pragma unroll 2
    for (int i = 0; i < 16; ++i) {
      const int bi = ru * 16 + i, row = MP + bi;
      const float* st = (lru ? (p.in[4] + (size_t)(layer * 128 + bi) * 3 * 768) : (p.in[6] + (size_t)(layer * 128 + bi) * 3 * 1280)) + 8 * oo;
#pragma unroll
      for (int h = 0; h < 2; ++h) {
        const float4 a = *(const float4*)(st + 0 * nch + 4 * h), b4 = *(const float4*)(st + 1 * nch + 4 * h), c4 = *(const float4*)(st + 2 * nch + 4 * h);
        xa[4 * h] = a.x; xa[4 * h + 1] = a.y; xa[4 * h + 2] = a.z; xa[4 * h + 3] = a.w;
        xb[4 * h] = b4.x; xb[4 * h + 1] = b4.y; xb[4 * h + 2] = b4.z; xb[4 * h + 3] = b4.w;
        xc[4 * h] = c4.x; xc[4 * h + 1] = c4.y; xc[4 * h + 2] = c4.z; xc[4 * h + 3] = c4.w;
      }
      unpack8(*(const uint4*)(PROJ + (size_t)row * NPAD + srccol), xd);
#pragma unroll
      for (int c = 0; c < 8; ++c) {
        float v = bs[c] + w0[c] * xa[c] + w1[c] * xb[c] + w2[c] * xc[c] + w3[c] * xd[c];
        y[c] = lru ? v : silu_f(v);
      }
      *(uint4*)(dst + (size_t)row * nch) = pack8(y);
      float* op = p.out + (lru ? (O_SLC + (size_t)(layer * 128 + bi) * 3 * 768) : (O_SSC + (size_t)(layer * 128 + bi) * 3 * 1280)) + 8 * oo;
      *(float4*)(op) = make_float4(xb[0], xb[1], xb[2], xb[3]);
      *(float4*)(op + 4) = make_float4(xb[4], xb[5], xb[6], xb[7]);
      *(float4*)(op + nch) = make_float4(xc[0], xc[1], xc[2], xc[3]);
      *(float4*)(op + nch + 4) = make_float4(xc[4], xc[5], xc[6], xc[7]);
      *(float4*)(op + 2 * nch) = make_float4(xd[0], xd[1], xd[2], xd[3]);
      *(float4*)(op + 2 * nch + 4) = make_float4(xd[4], xd[5], xd[6], xd[7]);
    }
  }
}

PH void attn_prompt_item(const Params& p, int layer, int item) {
  SMEM;
  const int tid = opaque_tid(), lane = tid & 63, w = tid >> 6, quad = lane >> 4, l15 = lane & 15;
  const int b = item >> 5, nb = (item >> 1) & 15, kvh = item & 1;
  u16* Ks = (u16*)smem;
  u16* Vt = (u16*)(smem + 256 * 72 * 2);
  const u16* PROJ = (const u16*)(p.ws + WS_PROJ);
  u16* MIX = (u16*)(p.ws + WS_MIX);
  const float* ROPE = (const float*)(p.ws + WS_ROPE);
  {
    const int j = tid, t = nb * 128 - 128 + j;
    uint4 kq[8], vq[8];
    if (t >= 0) {
      const u16* src = PROJ + (size_t)(b * 2048 + t) * NPAD;
#pragma unroll
      for (int i = 0; i < 8; ++i) {
        kq[i] = *(const uint4*)(src + C_K + kvh * 64 + i * 8);
        vq[i] = *(const uint4*)(src + C_V + kvh * 64 + i * 8);
      }
    } else {
#pragma unroll
      for (int i = 0; i < 8; ++i) { kq[i] = make_uint4(0, 0, 0, 0); vq[i] = make_uint4(0, 0, 0, 0); }
    }
    float x1[8], x2[8];
    unpack8(kq[0], x1); unpack8(kq[1], x2);
    if (t >= 0) {
      const float* cs = ROPE + (size_t)t * 16;
#pragma unroll
      for (int i = 0; i < 8; ++i) {
        const float c = cs[2 * i], s = cs[2 * i + 1];
        const float r1 = x1[i] * c - x2[i] * s, r2 = x2[i] * c + x1[i] * s;
        x1[i] = r1; x2[i] = r2;
      }
    }
    kq[0] = pack8(x1); kq[1] = pack8(x2);
#pragma unroll
    for (int i = 0; i < 8; ++i) *(uint4*)(Ks + j * 72 + i * 8) = kq[i];
#pragma unroll
    for (int i = 0; i < 8; ++i) {
      Vt[(i * 8 + 0) * 264 + j] = (u16)(vq[i].x & 0xffffu); Vt[(i * 8 + 1) * 264 + j] = (u16)(vq[i].x >> 16);
      Vt[(i * 8 + 2) * 264 + j] = (u16)(vq[i].y & 0xffffu); Vt[(i * 8 + 3) * 264 + j] = (u16)(vq[i].y >> 16);
      Vt[(i * 8 + 4) * 264 + j] = (u16)(vq[i].z & 0xffffu); Vt[(i * 8 + 5) * 264 + j] = (u16)(vq[i].z >> 16);
      Vt[(i * 8 + 6) * 264 + j] = (u16)(vq[i].w & 0xffffu); Vt[(i * 8 + 7) * 264 + j] = (u16)(vq[i].w >> 16);
    }
    if (nb == 15 && j >= 128) {
      float* ok = p.out + O_PK + ((size_t)((layer * 8 + b) * 128 + (j - 128)) * 2 + kvh) * 64;
      float* ov = p.out + O_PV + ((size_t)((layer * 8 + b) * 128 + (j - 128)) * 2 + kvh) * 64;
      *(float4*)(ok + 0) = make_float4(x1[0], x1[1], x1[2], x1[3]);
      *(float4*)(ok + 4) = make_float4(x1[4], x1[5], x1[6], x1[7]);
      *(float4*)(ok + 8) = make_float4(x2[0], x2[1], x2[2], x2[3]);
      *(float4*)(ok + 12) = make_float4(x2[4], x2[5], x2[6], x2[7]);
#pragma unroll
      for (int i = 2; i < 8; ++i) {
        float f[8]; unpack8(kq[i], f);
        *(float4*)(ok + i * 8) = make_float4(f[0], f[1], f[2], f[3]);
        *(float4*)(ok + i * 8 + 4) = make_float4(f[4], f[5], f[6], f[7]);
      }
#pragma unroll
      for (int i = 0; i < 8; ++i) {
        float f[8]; unpack8(vq[i], f);
        *(float4*)(ov + i * 8) = make_float4(f[0], f[1], f[2], f[3]);
        *(float4*)(ov + i * 8 + 4) = make_float4(f[4], f[5], f[6], f[7]);
      }
    }
  }
  __syncthreads();
  const int h = kvh * 4 + w;
  const float sink = p.in[10][layer * 8 + h];
  u32x4 nq[2][3];
#pragma unroll
  for (int qt = 0; qt < 2; ++qt) {
    const u16* src = PROJ + (size_t)(b * 2048 + nb * 128 + qt * 16 + l15) * NPAD + h * 64;
    nq[qt][0] = *(const u32x4*)(src + quad * 8);
    nq[qt][1] = *(const u32x4*)(src + 32 + quad * 8);
    nq[qt][2] = *(const u32x4*)(src + (quad ^ 1) * 8);
  }
#pragma unroll 1
  for (int c = 0; c < 4; ++c) {
    const int q0 = 32 * c;
    u32x4 cq[2][3];
#pragma unroll
    for (int qt = 0; qt < 2; ++qt) { cq[qt][0] = nq[qt][0]; cq[qt][1] = nq[qt][1]; cq[qt][2] = nq[qt][2]; }
    {
      const int qn = 32 * ((c < 3) ? (c + 1) : c);
#pragma unroll
      for (int qt = 0; qt < 2; ++qt) {
        const u16* src = PROJ + (size_t)(b * 2048 + nb * 128 + qn + qt * 16 + l15) * NPAD + h * 64;
        nq[qt][0] = *(const u32x4*)(src + quad * 8);
        nq[qt][1] = *(const u32x4*)(src + 32 + quad * 8);
        nq[qt][2] = *(const u32x4*)(src + (quad ^ 1) * 8);
      }
    }
    uint2 gpre[2][4];
#pragma unroll
    for (int qt = 0; qt < 2; ++qt)
#pragma unroll
      for (int dt = 0; dt < 4; ++dt)
        gpre[qt][dt] = *(const uint2*)(PROJ + (size_t)(b * 2048 + nb * 128 + q0 + qt * 16 + l15) * NPAD + C_GA + h * 64 + dt * 16 + quad * 4);
    bf16x8 qf[2][2];
#pragma unroll
    for (int qt = 0; qt < 2; ++qt) {
      const int qi = q0 + qt * 16 + l15;
      const int tpos = nb * 128 + qi;
      float own[8], o1[8];
      unpack8v(cq[qt][0], own);
      unpack8v(cq[qt][1], o1);
      if (quad < 2) {
        float pr[8];
        unpack8v(cq[qt][2], pr);
        const float* cs = ROPE + (size_t)tpos * 16;
        const float sg = (quad == 0) ? -1.f : 1.f;
#pragma unroll
        for (int i = 0; i < 8; ++i) own[i] = own[i] * cs[2 * i] + sg * pr[i] * cs[2 * i + 1];
      }
#pragma unroll
      for (int i = 0; i < 8; ++i) { own[i] *= 0.125f; o1[i] *= 0.125f; }
      qf[qt][0] = __builtin_bit_cast(bf16x8, pack8(own));
      qf[qt][1] = __builtin_bit_cast(bf16x8, pack8(o1));
    }
    f32x4 s[10][2];
#pragma unroll
    for (int kt = 0; kt < 10; ++kt) { s[kt][0] = (f32x4){0.f, 0.f, 0.f, 0.f}; s[kt][1] = (f32x4){0.f, 0.f, 0.f, 0.f}; }
#pragma unroll
    for (int ks = 0; ks < 2; ++ks)
#pragma unroll
      for (int kt = 0; kt < 10; ++kt) {
        const bf16x8 af = ldfrag(Ks, 72, q0 + kt * 16, ks * 32, lane);
        s[kt][0] = mfma16(af, qf[0][ks], s[kt][0]);
        s[kt][1] = mfma16(af, qf[1][ks], s[kt][1]);
      }
    float inv[2];
    bf16x8 pf[5][2];
#pragma unroll
    for (int qt = 0; qt < 2; ++qt) {
      const int i = q0 + qt * 16 + l15;
      float mx = -INFINITY;
#pragma unroll
      for (int kt = 0; kt < 10; ++kt)
#pragma unroll
        for (int r = 0; r < 4; ++r) {
          const int j = q0 + kt * 16 + quad * 4 + r;
          const bool valid = (j >= i) && (j <= i + 128) && (nb > 0 || j >= 128);
          const float v = valid ? s[kt][qt][r] : -INFINITY;
          s[kt][qt][r] = v;
          mx = fmaxf(mx, v);
        }
      mx = fmaxf(mx, __shfl_xor(mx, 16));
      mx = fmaxf(mx, __shfl_xor(mx, 32));
      mx = fmaxf(mx, sink);
      float sum = 0.f;
#pragma unroll
      for (int kt = 0; kt < 10; ++kt)
#pragma unroll
        for (int r = 0; r < 4; ++r) {
          const float e = __expf(s[kt][qt][r] - mx);
          s[kt][qt][r] = e;
          sum += e;
        }
      sum += __shfl_xor(sum, 16);
      sum += __shfl_xor(sum, 32);
      inv[qt] = 1.f / (sum + __expf(sink - mx));
#pragma unroll
      for (int kk = 0; kk < 5; ++kk) pf[kk][qt] = packfrag(s[2 * kk][qt], s[2 * kk + 1][qt]);
    }
    f32x4 o[4][2];
#pragma unroll
    for (int dt = 0; dt < 4; ++dt) { o[dt][0] = (f32x4){0.f, 0.f, 0.f, 0.f}; o[dt][1] = (f32x4){0.f, 0.f, 0.f, 0.f}; }
#pragma unroll
    for (int kk = 0; kk < 5; ++kk)
#pragma unroll
      for (int dt = 0; dt < 4; ++dt) {
        const bf16x8 vf = ldfrag_perm(Vt, 264, dt * 16, q0 + kk * 32, lane);
        o[dt][0] = mfma16(vf, pf[kk][0], o[dt][0]);
        o[dt][1] = mfma16(vf, pf[kk][1], o[dt][1]);
      }
#pragma unroll
    for (int qt = 0; qt < 2; ++qt) {
      const int qi = q0 + qt * 16 + l15;
      const size_t row = (size_t)(b * 2048 + nb * 128 + qi);
#pragma unroll
      for (int dt = 0; dt < 4; ++dt) {
        const int col = h * 64 + dt * 16 + quad * 4;
        const uint2 gv = gpre[qt][dt];
        const float g0 = bflo(gv.x), g1 = bfhi(gv.x), g2 = bflo(gv.y), g3 = bfhi(gv.y);
        uint2 ov;
        ov.x = pack2(o[dt][qt][0] * inv[qt] * silu_f(g0), o[dt][qt][1] * inv[qt] * silu_f(g1));
        ov.y = pack2(o[dt][qt][2] * inv[qt] * silu_f(g2), o[dt][qt][3] * inv[qt] * silu_f(g3));
        *(uint2*)(MIX + row * 2048 + col) = ov;
      }
    }
  }
}

PH void attn_decode_item(const Params& p, int layer, int item) {
  SMEM;
  const int tid = opaque_tid(), lane = tid & 63, w = tid >> 6;
  const int b = item >> 1, kvh = item & 1;
  float* Kd = (float*)smem;
  float* Vd = Kd + 129 * 65;
  float* qs = Vd + 129 * 64;
  float* ps = qs + 256;
  const u16* PROJ = (const u16*)(p.ws + WS_PROJ);
  u16* MIX = (u16*)(p.ws + WS_MIX);
  const float* ROPE = (const float*)(p.ws + WS_ROPE) + (size_t)2048 * 16;
  const size_t row = (size_t)(MP + b);
  const float* ck = p.in[2] + (size_t)(layer * 128 + b) * 128 * 128;
  const float* cv = p.in[3] + (size_t)(layer * 128 + b) * 128 * 128;
  float* ok = p.out + O_SK + (size_t)(layer * 128 + b) * 128 * 128;
  float* ov = p.out + O_SV + (size_t)(layer * 128 + b) * 128 * 128;
#pragma unroll
  for (int i = 0; i < 8; ++i) {
    const int idx = tid + 256 * i, wi = idx >> 4, c4 = idx & 15;
    const float4 kv = *(const float4*)(ck + (size_t)(wi * 2 + kvh) * 64 + c4 * 4);
    const float4 vv = *(const float4*)(cv + (size_t)(wi * 2 + kvh) * 64 + c4 * 4);
    Kd[wi * 65 + c4 * 4 + 0] = kv.x; Kd[wi * 65 + c4 * 4 + 1] = kv.y; Kd[wi * 65 + c4 * 4 + 2] = kv.z; Kd[wi * 65 + c4 * 4 + 3] = kv.w;
    *(float4*)(Vd + wi * 64 + c4 * 4) = vv;
    if (wi >= 1) {
      *(float4*)(ok + (size_t)((wi - 1) * 2 + kvh) * 64 + c4 * 4) = kv;
      *(float4*)(ov + (size_t)((wi - 1) * 2 + kvh) * 64 + c4 * 4) = vv;
    }
  }
  if (tid < 64) {
    const int d = tid;
    float kx = bf2f(PROJ[row * NPAD + C_K + kvh * 64 + d]);
    if (d < 16) {
      const float pr = bf2f(PROJ[row * NPAD + C_K + kvh * 64 + (d ^ 8)]);
      const float c = ROPE[2 * (d & 7)], s = ROPE[2 * (d & 7) + 1];
      kx = (d < 8) ? (kx * c - pr * s) : (kx * c + pr * s);
    }
    const float vx = bf2f(PROJ[row * NPAD + C_V + kvh * 64 + d]);
    Kd[128 * 65 + d] = kx; Vd[128 * 64 + d] = vx;
    ok[(size_t)(127 * 2 + kvh) * 64 + d] = kx;
    ov[(size_t)(127 * 2 + kvh) * 64 + d] = vx;
  }
  {
    const int g = tid >> 6, d = tid & 63, h = kvh * 4 + g;
    float qx = bf2f(PROJ[row * NPAD + h * 64 + d]);
    if (d < 16) {
      const float pr = bf2f(PROJ[row * NPAD + h * 64 + (d ^ 8)]);
      const float c = ROPE[2 * (d & 7)], s = ROPE[2 * (d & 7) + 1];
      qx = (d < 8) ? (qx * c - pr * s) : (qx * c + pr * s);
    }
    qs[g * 64 + d] = qx * 0.125f;
  }
  __syncthreads();
  const int h = kvh * 4 + w;
  const float sink = p.in[10][layer * 8 + h];
  float s0 = 0.f, s1 = 0.f, s2 = 0.f;
  for (int d = 0; d < 64; ++d) {
    const float qv = qs[w * 64 + d];
    s0 += qv * Kd[lane * 65 + d];
    s1 += qv * Kd[(lane + 64) * 65 + d];
    s2 += qv * Kd[128 * 65 + d];
  }
  float mx = fmaxf(fmaxf(s0, s1), s2);
#pragma unroll
  for (int d = 1; d < 64; d <<= 1) mx = fmaxf(mx, __shfl_xor(mx, d));
  mx = fmaxf(mx, sink);
  const float e0 = __expf(s0 - mx), e1 = __expf(s1 - mx), e2 = __expf(s2 - mx);
  float sum = e0 + e1;
#pragma unroll
  for (int d = 1; d < 64; d <<= 1) sum += __shfl_xor(sum, d);
  const float inv = 1.f / (sum + e2 + __expf(sink - mx));
  ps[w * 132 + lane] = e0 * inv;
  ps[w * 132 + 64 + lane] = e1 * inv;
  if (lane == 0) ps[w * 132 + 128] = e2 * inv;
  __syncthreads();
  float o = 0.f;
  for (int k = 0; k < 129; ++k) o += ps[w * 132 + k] * Vd[k * 64 + lane];
  const float gt = bf2f(PROJ[row * NPAD + C_GA + h * 64 + lane]);
  MIX[row * 2048 + h * 64 + lane] = f2bf(o * silu_f(gt));
}

PH void lru_item(const Params& p, int layer, int b, int n, int dpart) {
  SMEM;
  const int tid = opaque_tid(), lane = tid & 63, w = tid >> 6, quad = lane >> 4, l15 = lane & 15;
  u16* xls = (u16*)smem;
  float* as_ = (float*)(smem + 26624);
  float* bs_ = (float*)(smem + 26624 + 16896);
  float* Pc = (float*)(smem + 60416);
  float* Hc = (float*)(smem + 61440);
  float* hprev = (float*)(smem + 62464);
  const u16* PROJ = (const u16*)(p.ws + WS_PROJ);
  const u16* XL = (const u16*)(p.ws + WS_XL);
  u16* MIX = (u16*)(p.ws + WS_MIX);
  const u16* WA = (const u16*)(p.ws + WS_WA) + (size_t)(layer * 8 + n) * 9216;
  const u16* WX = (const u16*)(p.ws + WS_WX) + (size_t)(layer * 8 + n) * 9216;
  bf16x8 wa[2][3], wx[2][3];
#pragma unroll
  for (int dt = 0; dt < 2; ++dt)
#pragma unroll
    for (int ks = 0; ks < 3; ++ks) {
      const int d = dpart * 32 + dt * 16 + l15, k = ks * 32 + quad * 8;
      wa[dt][ks] = *(const bf16x8*)(WA + d * 96 + k);
      wx[dt][ks] = *(const bf16x8*)(WX + d * 96 + k);
    }
  const int nchunks = (b >= 0) ? 16 : 1;
  const int sch = tid & 31, sub = tid >> 5;
  const int chg = n * 96 + dpart * 32 + sch;
  const float ba = p.in[14][layer * 768 + chg], bx = p.in[16][layer * 768 + chg];
  const float cl = -8.f * softplus_f(-p.in[17][layer * 768 + chg]);
  u32x4 pxl[6];
  u16 pgt[16];
  {
    const int nb_ = (b >= 0) ? (b * 2048) : MP;
#pragma unroll
    for (int i = 0; i < 6; ++i) {
      const int idx = tid + 256 * i, r = idx / 12, c16 = idx % 12;
      pxl[i] = *(const u32x4*)(XL + (size_t)(nb_ + r) * 768 + n * 96 + c16 * 8);
    }
#pragma unroll
    for (int t = 0; t < 16; ++t) pgt[t] = PROJ[(size_t)(nb_ + sub * 16 + t) * NPAD + C_GL + chg];
  }
#pragma unroll 1
  for (int c = 0; c < nchunks; ++c) {
    const int base = (b >= 0) ? (b * 2048 + c * 128) : MP;
#pragma unroll
    for (int i = 0; i < 6; ++i) {
      const int idx = tid + 256 * i, r = idx / 12, c16 = idx % 12;
      *(u32x4*)(xls + r * 104 + c16 * 8) = pxl[i];
    }
    u16 gcur[16];
#pragma unroll
    for (int t = 0; t < 16; ++t) gcur[t] = pgt[t];
    {
      const int nb_ = (c + 1 < nchunks) ? (base + 128) : base;
#pragma unroll
      for (int i = 0; i < 6; ++i) {
        const int idx = tid + 256 * i, r = idx / 12, c16 = idx % 12;
        pxl[i] = *(const u32x4*)(XL + (size_t)(nb_ + r) * 768 + n * 96 + c16 * 8);
      }
#pragma unroll
      for (int t = 0; t < 16; ++t) pgt[t] = PROJ[(size_t)(nb_ + sub * 16 + t) * NPAD + C_GL + chg];
    }
    __syncthreads();
    {
      f32x4 ra[2][2], rx[2][2];
#pragma unroll
      for (int dt = 0; dt < 2; ++dt)
#pragma unroll
        for (int tt = 0; tt < 2; ++tt) { ra[dt][tt] = (f32x4){0.f, 0.f, 0.f, 0.f}; rx[dt][tt] = (f32x4){0.f, 0.f, 0.f, 0.f}; }
#pragma unroll
      for (int ks = 0; ks < 3; ++ks)
#pragma unroll
        for (int tt = 0; tt < 2; ++tt) {
          const bf16x8 xf = ldfrag(xls, 104, (2 * w + tt) * 16, ks * 32, lane);
#pragma unroll
          for (int dt = 0; dt < 2; ++dt) {
            ra[dt][tt] = mfma16(wa[dt][ks], xf, ra[dt][tt]);
            rx[dt][tt] = mfma16(wx[dt][ks], xf, rx[dt][tt]);
          }
        }
#pragma unroll
      for (int dt = 0; dt < 2; ++dt)
#pragma unroll
        for (int tt = 0; tt < 2; ++tt)
#pragma unroll
          for (int r = 0; r < 4; ++r) {
            const int tok = (2 * w + tt) * 16 + l15, dl = dt * 16 + quad * 4 + r;
            as_[tok * 33 + dl] = ra[dt][tt][r];
            bs_[tok * 33 + dl] = rx[dt][tt][r];
          }
    }
    __syncthreads();
    float P = 1.f, H = 0.f;
#pragma unroll
    for (int t = 0; t < 16; ++t) {
      const int tok = sub * 16 + t;
      const float rg = sigmoid_f(as_[tok * 33 + sch] + ba);
      const float ig = sigmoid_f(bs_[tok * 33 + sch] + bx);
      const float la = cl * rg;
      const float xv = bf2f(xls[tok * 104 + dpart * 32 + sch]);
      const float a = __expf(la);
      const float bb = __builtin_amdgcn_sqrtf(-expm1f(2.f * la)) * ig * xv;
      as_[tok * 33 + sch] = a;
      bs_[tok * 33 + sch] = bb;
      H = a * H + bb; P *= a;
    }
    if (b >= 0) {
      Pc[sub * 32 + sch] = P; Hc[sub * 32 + sch] = H;
      __syncthreads();
      float carry = (c == 0) ? 0.f : hprev[(c & 1) * 32 + sch];
#pragma unroll
      for (int s = 0; s < 8; ++s) if (s < sub) carry = Pc[s * 32 + sch] * carry + Hc[s * 32 + sch];
      float hh = carry;
#pragma unroll
      for (int t = 0; t < 16; ++t) {
        const int tok = sub * 16 + t;
        const float a = as_[tok * 33 + sch], bb = bs_[tok * 33 + sch];
        hh = a * hh + bb;
        const size_t row = (size_t)(base + tok);
        const float g = bf2f(gcur[t]);
        MIX[row * 2048 + 512 + chg] = f2bf(hh * silu_f(g));
      }
      if (sub == 7) {
        hprev[((c + 1) & 1) * 32 + sch] = hh;
        if (c == 15) p.out[O_PLH + (size_t)(layer * 8 + b) * 768 + chg] = hh;
      }
    } else {
#pragma unroll
      for (int t = 0; t < 16; ++t) {
        const int tok = sub * 16 + t;
        const float a = as_[tok * 33 + sch], bb = bs_[tok * 33 + sch];
        const float h0 = p.in[5][(size_t)(layer * 128 + tok) * 768 + chg];
        const float hh = a * h0 + bb;
        const size_t row = (size_t)(MP + tok);
        const float g = bf2f(gcur[t]);
        MIX[row * 2048 + 512 + chg] = f2bf(hh * silu_f(g));
        p.out[O_SLH + (size_t)(layer * 128 + tok) * 768 + chg] = hh;
      }
    }
  }
}

constexpr int NSEG = 3;
template <int PROBE, int SONLY, int CPS>
DI void ssd_chunk_loop(const Params& p, int layer, int b, int e, int c0, f32x4 (&h)[8], float& dtot, bool write_final) {
  SMEM;
  const int tid = opaque_tid(), lane = tid & 63, w = tid >> 6, quad = lane >> 4, l15 = lane & 15;
  const int g = e / 6;
  u16* Cs = (u16*)smem;
  u16* Bs = (u16*)(smem + 17408);
  u16* Bt2 = (u16*)(smem + 34816);
  u16* Xt = (u16*)(smem + 53248);
  u16* Ms = (u16*)(smem + 62464);
  float* dt_s = (float*)(smem + 71680);
  float* acs_s = dt_s + 64;
  float* ssq_s = acs_s + 64;
  const u16* PROJ = (const u16*)(p.ws + WS_PROJ);
  const u16* XBC = (const u16*)(p.ws + WS_XBC);
  u16* MIX = (u16*)(p.ws + WS_MIX);
  float* SSQ = (float*)(p.ws + WS_SSQ);
  const float dtb = p.in[20][layer * 12 + e];
  const float ah = -__expf(p.in[21][layer * 12 + e]);
  const float Dv = p.in[22][layer * 12 + e];
  const bool do_store = !(PROBE & 1) || (dtb == 1234.5f);
  u32x4 pc[4], pb[4], px[2];
  u16 pru;
  {
    const int nb_ = b * 2048 + c0 * 64;
#pragma unroll
    for (int i = 0; i < 4; ++i) {
      const int idx = tid + 256 * i, r = idx >> 4, c16 = idx & 15;
      if (!SONLY) pc[i] = *(const u32x4*)(XBC + (size_t)(nb_ + r) * 1280 + 1024 + g * 128 + c16 * 8);
      pb[i] = *(const u32x4*)(XBC + (size_t)(nb_ + r) * 1280 + 768 + g * 128 + c16 * 8);
    }
#pragma unroll
    for (int i = 0; i < 2; ++i) {
      const int idx = tid + 256 * i, r = idx >> 3, c8 = idx & 7;
      px[i] = *(const u32x4*)(XBC + (size_t)(nb_ + r) * 1280 + e * 64 + c8 * 8);
    }
    pru = PROJ[(size_t)(nb_ + lane) * NPAD + C_DT + e];
  }
#pragma unroll 1
  for (int cc = c0; cc < c0 + CPS; ++cc) {
    const int base = b * 2048 + cc * 64;
#pragma unroll
    for (int i = 0; i < 4; ++i) {
      const int idx = tid + 256 * i, r = idx >> 4, c16 = idx & 15;
      if (!SONLY) *(u32x4*)(Cs + r * 136 + c16 * 8) = pc[i];
      *(u32x4*)(Bs + r * 136 + c16 * 8) = pb[i];
    }
    u32x4 xr[2];
    xr[0] = px[0]; xr[1] = px[1];
    if (w == 0) {
      const float dtv = softplus_f(bf2f(pru) + dtb);
      float a = dtv * ah;
#pragma unroll
      for (int d = 1; d < 64; d <<= 1) { const float t = __shfl_up(a, d); if (lane >= d) a += t; }
      dt_s[lane] = dtv; acs_s[lane] = a;
    }
    {
      const int nb_ = b * 2048 + ((cc + 1 < c0 + CPS) ? (cc + 1) : cc) * 64;
#pragma unroll
      for (int i = 0; i < 4; ++i) {
        const int idx = tid + 256 * i, r = idx >> 4, c16 = idx & 15;
        if (!SONLY) pc[i] = *(const u32x4*)(XBC + (size_t)(nb_ + r) * 1280 + 1024 + g * 128 + c16 * 8);
        pb[i] = *(const u32x4*)(XBC + (size_t)(nb_ + r) * 1280 + 768 + g * 128 + c16 * 8);
      }
#pragma unroll
      for (int i = 0; i < 2; ++i) {
        const int idx = tid + 256 * i, r = idx >> 3, c8 = idx & 7;
        px[i] = *(const u32x4*)(XBC + (size_t)(nb_ + r) * 1280 + e * 64 + c8 * 8);
      }
      pru = PROJ[(size_t)(nb_ + lane) * NPAD + C_DT + e];
    }
    uint2 dx[4], dz[4];
    if (!SONLY)
#pragma unroll
    for (int qt = 0; qt < 4; ++qt) {
      const size_t row = (size_t)(base + qt * 16 + l15);
      const int pcol = w * 16 + quad * 4;
      dx[qt] = *(const uint2*)(XBC + row * 1280 + e * 64 + pcol);
      dz[qt] = *(const uint2*)(PROJ + row * NPAD + C_Z + e * 64 + pcol);
    }
    __syncthreads();
    dtot += acs_s[63];
    if (!(PROBE & 2)) {
#pragma unroll
    for (int i = 0; i < 2; ++i) {
      const int idx = tid + 256 * i, r = idx >> 3, c8 = idx & 7;
      const float dtv = dt_s[r];
      float f[8]; unpack8v(xr[i], f);
#pragma unroll
      for (int j = 0; j < 8; ++j) Xt[(c8 * 8 + j) * 72 + r] = f2bf(f[j] * dtv);
    }
    {
      const int q = tid & 63, ng = tid >> 6;
      const float dte = __expf(acs_s[63] - acs_s[q]);
#pragma unroll
      for (int i = 0; i < 8; ++i) {
        const uint2 v = *(const uint2*)(Bs + q * 136 + ng * 32 + i * 4);
        Bt2[(ng * 32 + i * 4 + 0) * 72 + q] = f2bf(bflo(v.x) * dte);
        Bt2[(ng * 32 + i * 4 + 1) * 72 + q] = f2bf(bfhi(v.x) * dte);
        Bt2[(ng * 32 + i * 4 + 2) * 72 + q] = f2bf(bflo(v.y) * dte);
        Bt2[(ng * 32 + i * 4 + 3) * 72 + q] = f2bf(bfhi(v.y) * dte);
      }
    }
    }
    __syncthreads();
    if (!(PROBE & 4) && !SONLY) {
      const int q = w * 16 + l15;
      const float aq = acs_s[q];
      bf16x8 cfr[4];
#pragma unroll
      for (int ks = 0; ks < 4; ++ks) cfr[ks] = ldfrag(Cs, 136, w * 16, ks * 32, lane);
#pragma unroll
      for (int st = 0; st < 4; ++st) {
        uint2 ov;
        const int s0 = st * 16 + quad * 4;
        {
          f32x4 acc = (f32x4){0.f, 0.f, 0.f, 0.f};
#pragma unroll
          for (int ks = 0; ks < 4; ++ks) acc = mfma16(ldfrag(Bs, 136, st * 16, ks * 32, lane), cfr[ks], acc);
          float v[4];
#pragma unroll
          for (int r = 0; r < 4; ++r) { const int s = s0 + r; v[r] = (s <= q) ? acc[r] * __expf(fminf(aq - acs_s[s], 0.f)) : 0.f; }
          ov.x = pack2(v[0], v[1]); ov.y = pack2(v[2], v[3]);
        }
        *(uint2*)(Ms + q * 72 + s0) = ov;
      }
    }
    f32x4 y[4];
#pragma unroll
    for (int qt = 0; qt < 4; ++qt) y[qt] = (f32x4){0.f, 0.f, 0.f, 0.f};
    if (!(PROBE & 4) && !SONLY)
#pragma unroll
    for (int kk = 0; kk < 4; ++kk) {
      const bf16x8 hf = packfrag(h[2 * kk], h[2 * kk + 1]);
#pragma unroll
      for (int qt = 0; qt < 4; ++qt) y[qt] = mfma16(hf, ldfrag_perm(Cs, 136, qt * 16, kk * 32, lane), y[qt]);
    }
    if (!SONLY) {
#pragma unroll
    for (int qt = 0; qt < 4; ++qt) y[qt] *= __expf(acs_s[qt * 16 + l15]);
    __syncthreads();
    }
    if (!(PROBE & 8) && !SONLY)
#pragma unroll
    for (int qt = 0; qt < 4; ++qt)
#pragma unroll
      for (int ks = 0; ks < 2; ++ks)
        if (ks == 0 || qt >= 2) y[qt] = mfma16(ldfrag(Xt, 72, w * 16, ks * 32, lane), ldfrag(Ms, 72, qt * 16, ks * 32, lane), y[qt]);
    if (!(PROBE & 8)) {
      const float cd = __expf(acs_s[63]);
#pragma unroll
      for (int nt = 0; nt < 8; ++nt) h[nt] *= cd;
#pragma unroll
      for (int ks = 0; ks < 2; ++ks) {
        const bf16x8 xf = ldfrag(Xt, 72, w * 16, ks * 32, lane);
#pragma unroll
        for (int nt = 0; nt < 8; ++nt) h[nt] = mfma16(ldfrag(Bt2, 72, nt * 16, ks * 32, lane), xf, h[nt]);
      }
    }
    if (!SONLY)
#pragma unroll
    for (int qt = 0; qt < 4; ++qt) {
      const int q = qt * 16 + l15;
      const size_t row = (size_t)(base + q);
      const int pcol = w * 16 + quad * 4;
      const uint2 xv = dx[qt];
      const uint2 zv = dz[qt];
      const float y0 = (y[qt][0] + Dv * bflo(xv.x)) * silu_f(bflo(zv.x));
      const float y1 = (y[qt][1] + Dv * bfhi(xv.x)) * silu_f(bfhi(zv.x));
      const float y2 = (y[qt][2] + Dv * bflo(xv.y)) * silu_f(bflo(zv.y));
      const float y3 = (y[qt][3] + Dv * bfhi(xv.y)) * silu_f(bfhi(zv.y));
      uint2 ov; ov.x = pack2(y0, y1); ov.y = pack2(y2, y3);
      if (do_store) *(uint2*)(MIX + row * 2048 + 1280 + e * 64 + pcol) = ov;
      float ss = y0 * y0 + y1 * y1 + y2 * y2 + y3 * y3;
      ss += __shfl_xor(ss, 16);
      ss += __shfl_xor(ss, 32);
      if (quad == 0) ssq_s[w * 64 + q] = ss;
    }
    __syncthreads();
    if (do_store && !SONLY) if (tid < 64) SSQ[(size_t)(base + tid) * 12 + e] = ssq_s[tid] + ssq_s[64 + tid] + ssq_s[128 + tid] + ssq_s[192 + tid];
  }
  if (do_store && write_final) {
    float* oh = p.out + O_PSH + (size_t)((layer * 8 + b) * 12 + e) * 64 * 128;
    const int pidx = w * 16 + l15;
#pragma unroll
    for (int nt = 0; nt < 8; ++nt) {
      const int n = nt * 16 + quad * 4;
      *(float4*)(oh + (size_t)pidx * 128 + n) = make_float4(h[nt][0], h[nt][1], h[nt][2], h[nt][3]);
    }
  }
}


DI unsigned flag_ld(unsigned* f) { return __hip_atomic_load(f, __ATOMIC_RELAXED, __HIP_MEMORY_SCOPE_AGENT); }
template <int PROBE>
PH void ssd_prompt_item(const Params& p, int layer, int b, int e, int seg) {
  const int tid = opaque_tid(), lane = tid & 63, w = tid >> 6, quad = lane >> 4, l15 = lane & 15;
  float* SEND = (float*)(p.ws + WS_SEND) + (size_t)((layer * 96 + b * 12 + e) * NSEG) * 8192;
  unsigned* SFLAG = (unsigned*)(p.ws + WS_SFLAG) + (layer * 96 + b * 12 + e) * NSEG;
  f32x4 h[8];
#pragma unroll
  for (int i = 0; i < 8; ++i) h[i] = (f32x4){0.f, 0.f, 0.f, 0.f};
  float dtot = 0.f;
  const size_t eoff = (size_t)(w * 16 + l15) * 128 + quad * 4;
  if (seg < NSEG - 1) ssd_chunk_loop<PROBE, 1, 10>(p, layer, b, e, seg * 10, h, dtot, false);
  if (seg > 0) {
    if (tid == 0) {
      unsigned sp = 0;
      while (flag_ld(SFLAG + seg - 1) == 0u) { __builtin_amdgcn_s_sleep(2); if (++sp > (1u << 22)) break; }
    }
    __syncthreads();
    __builtin_amdgcn_fence(__ATOMIC_ACQUIRE, "agent");
    asm volatile("s_waitcnt vmcnt(0)" ::: "memory");
    const float* hin = SEND + (size_t)(seg - 1) * 8192 + eoff;
    const float fdec = __expf(dtot);
#pragma unroll
    for (int nt = 0; nt < 8; ++nt) {
      const float4 v = *(const float4*)(hin + nt * 16);
      const f32x4 hv = (f32x4){v.x, v.y, v.z, v.w};
      if (seg < NSEG - 1) {
        const f32x4 he = fdec * hv + h[nt];
        *(float4*)(SEND + (size_t)seg * 8192 + eoff + nt * 16) = make_float4(he[0], he[1], he[2], he[3]);
      }
      h[nt] = hv;
    }
  } else {
#pragma unroll
    for (int nt = 0; nt < 8; ++nt) {
      *(float4*)(SEND + eoff + nt * 16) = make_float4(h[nt][0], h[nt][1], h[nt][2], h[nt][3]);
      h[nt] = (f32x4){0.f, 0.f, 0.f, 0.f};
    }
  }
  if (seg < NSEG - 1) {
    __builtin_amdgcn_fence(__ATOMIC_RELEASE, "agent");
    asm volatile("s_waitcnt vmcnt(0)" ::: "memory");
    __syncthreads();
    if (tid == 0) __hip_atomic_store(SFLAG + seg, 1u, __ATOMIC_RELAXED, __HIP_MEMORY_SCOPE_AGENT);
  }
  float dummy = 0.f;
  if (seg < NSEG - 1) ssd_chunk_loop<PROBE, 0, 10>(p, layer, b, e, seg * 10, h, dummy, false);
  else ssd_chunk_loop<PROBE, 0, 12>(p, layer, b, e, 20, h, dummy, true);
}

PH void ssd_decode_item(const Params& p, int layer, int b, int e) {
  SMEM;
  const int tid = opaque_tid();
  const int g = e / 6;
  float* xs_s = (float*)smem;
  float* Bv = xs_s + 64;
  float* Cv = Bv + 128;
  float* ys = Cv + 128;
  const u16* PROJ = (const u16*)(p.ws + WS_PROJ);
  const u16* XBC = (const u16*)(p.ws + WS_XBC);
  u16* MIX = (u16*)(p.ws + WS_MIX);
  float* SSQ = (float*)(p.ws + WS_SSQ);
  const size_t row = (size_t)(MP + b);
  const float* h0 = p.in[7] + (size_t)((layer * 128 + b) * 12 + e) * 64 * 128;
  float* h1 = p.out + O_SSH + (size_t)((layer * 128 + b) * 12 + e) * 64 * 128;
  const int n4 = tid & 31;
  f32x4 hv[8];
  u16 zv[8];
#pragma unroll
  for (int i = 0; i < 8; ++i) {
    const int pidx = (tid >> 5) + 8 * i;
    hv[i] = *(const f32x4*)(h0 + (size_t)pidx * 128 + n4 * 4);
    zv[i] = PROJ[row * NPAD + C_Z + e * 64 + pidx];
  }
  const u16 xsr = XBC[row * 1280 + e * 64 + (tid & 63)];
  const u16 bvr = XBC[row * 1280 + 768 + g * 128 + (tid & 127)];
  const u16 cvr = XBC[row * 1280 + 1024 + g * 128 + (tid & 127)];
  const float dtv = softplus_f(bf2f(PROJ[row * NPAD + C_DT + e]) + p.in[20][layer * 12 + e]);
  const float dA = __expf(dtv * (-__expf(p.in[21][layer * 12 + e])));
  const float Dv = p.in[22][layer * 12 + e];
  if (tid < 64) xs_s[tid] = bf2f(xsr);
  if (tid < 128) { Bv[tid] = bf2f(bvr); Cv[tid] = bf2f(cvr); }
  __syncthreads();
  const float4 Bq = *(const float4*)(Bv + n4 * 4), Cq = *(const float4*)(Cv + n4 * 4);
#pragma unroll
  for (int i = 0; i < 8; ++i) {
    const int pidx = (tid >> 5) + 8 * i;
    const float xsv = xs_s[pidx];
    const float xdt = dtv * xsv;
    f32x4 hn;
    hn[0] = dA * hv[i][0] + xdt * Bq.x; hn[1] = dA * hv[i][1] + xdt * Bq.y; hn[2] = dA * hv[i][2] + xdt * Bq.z; hn[3] = dA * hv[i][3] + xdt * Bq.w;
    *(f32x4*)(h1 + (size_t)pidx * 128 + n4 * 4) = hn;
    float part = Cq.x * hn[0] + Cq.y * hn[1] + Cq.z * hn[2] + Cq.w * hn[3];
#pragma unroll
    for (int d = 1; d < 32; d <<= 1) part += __shfl_xor(part, d);
    if (n4 == 0) ys[pidx] = (part + Dv * xsv) * silu_f(bf2f(zv[i]));
  }
  __syncthreads();
  if (tid < 64) {
    const float v = ys[tid];
    MIX[row * 2048 + 1280 + e * 64 + tid] = f2bf(v);
    float ss = v * v;
#pragma unroll
    for (int d = 1; d < 64; d <<= 1) ss += __shfl_xor(ss, d);
    if (tid == 0) SSQ[row * 12 + e] = ss;
  }
}

#define XB_TMO      128
#define XB_XCNT(j)  (256  + 64 * (j))
#define XB_XSUB(j)  (1280 + 64 * (j))
#define XB_XGEN(j)  (2304 + 64 * (j))
#define XB_TOP      3328
#define XB_TOPGEN   3392
#define XCD_BAR_WORDS 3456
#define XB_SPIN_CAP (1u << 18)
#define LAS __attribute__((address_space(3)))
DI unsigned xb_ld(unsigned* p)              { return __hip_atomic_load(p, __ATOMIC_RELAXED, __HIP_MEMORY_SCOPE_AGENT); }
DI unsigned xb_add(unsigned* p, unsigned v) { return __hip_atomic_fetch_add(p, v, __ATOMIC_RELAXED, __HIP_MEMORY_SCOPE_AGENT); }
DI unsigned xb_xcc_id() { return (unsigned)__builtin_amdgcn_s_getreg((3 << 11) | 20) & 0xFu; }
#define XB_SPIN(cond, bar) do { unsigned _sp = 0; while (cond) { __builtin_amdgcn_s_sleep(1); \
    if ((++_sp & 255u) == 0u) { if (xb_ld(&(bar)[XB_TMO])) break; if (_sp > XB_SPIN_CAP) { atomicAdd(&(bar)[XB_TMO], 1u); break; } } } } while (0)
struct XcdBarrier { unsigned* bar; unsigned x; volatile LAS unsigned* st; };
DI XcdBarrier xcd_barrier_post(unsigned* bar, volatile LAS unsigned* st) {
  XcdBarrier b; b.bar = bar; b.x = xb_xcc_id(); b.st = st;
  if (threadIdx.x == 0) (void)xb_add(&bar[XB_XCNT(b.x)], 1u);
  return b;
}
DI void xcd_barrier_complete(unsigned* bar, unsigned x, unsigned& nloc, unsigned& nx) {
  const unsigned G = gridDim.x * gridDim.y * gridDim.z;
  unsigned sum, cnt, mine, sp = 0u;
  for (;;) {
    sum = 0u; cnt = 0u; mine = 0u;
#pragma unroll
    for (unsigned j = 0; j < 16; ++j) { const unsigned c = xb_ld(&bar[XB_XCNT(j)]); sum += c; cnt += (c > 0u) ? 1u : 0u; mine = (j == x) ? c : mine; }
    if (sum == G) break;
    __builtin_amdgcn_s_sleep(1);
    if ((++sp & 255u) == 0u) { if (xb_ld(&bar[XB_TMO])) break; if (sp > XB_SPIN_CAP) { atomicAdd(&bar[XB_TMO], 1u); break; } }
  }
  nloc = mine > 0u ? mine : 1u; nx = cnt > 0u ? cnt : 1u;
}
DI void xcd_barrier(const XcdBarrier& b) {
  asm volatile("s_waitcnt vmcnt(0)" ::: "memory");
  __syncthreads();
  if (threadIdx.x == 0) {
    unsigned* bar = b.bar;
    __builtin_amdgcn_s_waitcnt(0);
    unsigned nloc = b.st[0], nx = b.st[1];
    if (nloc == 0u) { xcd_barrier_complete(bar, b.x, nloc, nx); b.st[0] = nloc; b.st[1] = nx; }
    const unsigned old = xb_add(&bar[XB_XSUB(b.x)], 1u);
    const unsigned gen = old / nloc;
    if (old + 1u == (gen + 1u) * nloc) {
      __builtin_amdgcn_fence(__ATOMIC_RELEASE, "agent");
      asm volatile("s_waitcnt vmcnt(0)" ::: "memory");
      const unsigned og = xb_add(&bar[XB_TOP], 1u);
      const unsigned tg = og / nx;
      if (og + 1u == (tg + 1u) * nx) xb_add(&bar[XB_TOPGEN], 1u);
      else XB_SPIN(xb_ld(&bar[XB_TOPGEN]) == tg, bar);
      __builtin_amdgcn_fence(__ATOMIC_ACQUIRE, "agent");
      xb_add(&bar[XB_XGEN(b.x)], 1u);
      asm volatile("s_waitcnt vmcnt(0)" ::: "memory");
    } else {
      XB_SPIN(xb_ld(&bar[XB_XGEN(b.x)]) == gen, bar);
      __builtin_amdgcn_fence(__ATOMIC_ACQUIRE, "agent");
      asm volatile("s_waitcnt vmcnt(0)" ::: "memory");
    }
  }
  __syncthreads();
}

#define REP_PREP 1
#define REP_G0 1
#define REP_2A 1
#define REP_2B 1
#define REP_G1 1
#define REP_LN 1
#define REP_SYNC 0
#define PROBE_SSD 0
#define PROBE_2B_LO 0
#define PROBE_2B_HI 96
__global__ void __launch_bounds__(256, 2) mega(Params p) {
  __shared__ int slot;
  __shared__ uint4 xb_words;
  cg::grid_group grid = cg::this_grid();
  unsigned* ctr = (unsigned*)(p.ws + WS_CTR);
  if (threadIdx.x == 0) xb_words = make_uint4(0u, 0u, 0u, 0u);
  __syncthreads();
  XcdBarrier xb = xcd_barrier_post((unsigned*)(p.ws + WS_BAR), (volatile LAS unsigned*)&xb_words);
  if (p.ws == nullptr) grid.sync();
  for (int rep = 0; rep < REP_PREP; ++rep) { phase_prep(p); xcd_barrier(xb); }
#pragma unroll 1
  for (int layer = 0; layer < 4; ++layer) {
    for (int rep = 0; rep < REP_G0; ++rep) { gemm_phase<0>(p, layer); xcd_barrier(xb); }
    for (int rep = 0; rep < REP_2A; ++rep) {
      bool first = true;
      for (;;) {
        int it;
        if (first) { it = (int)blockIdx.x; first = false; }
        else it = next_item(ctr + layer * 2 + 8 * rep, &slot) + (int)gridDim.x;
        if (it >= 136 + 256) break;
        it = (it < 256) ? (it + 136) : (it - 256);
        if (it < 136) conv_unit(p, layer, it);
        else if (it < 392) attn_prompt_item(p, layer, it - 136);
        else attn_decode_item(p, layer, it - 392);
      }
      xcd_barrier(xb);
    }
    for (int rep = 0; rep < REP_2B; ++rep) {
      bool first = true;
      for (;;) {
        int it;
        if (first) { it = (int)blockIdx.x; first = false; }
        else it = next_item(ctr + layer * 2 + 1 + 8 * rep, &slot) + (int)gridDim.x;
        if (rep > 0) { it += PROBE_2B_LO; if (it >= PROBE_2B_HI) break; }
        if (it >= 288 + 192 + 24 + 256 + 1536) break;
        it = (it < 192) ? (it + 384) : ((it < 480) ? (it - 192) : ((it < 504) ? (it + 608) : ((it < 760) ? (it + 328) : (it + 352))));
        if (it < 384) { const int v = it % 96; ssd_prompt_item<0>(p, layer, v / 12, v % 12, it / 96); }
        else if (it < 576) { const int v = it - 384; lru_item(p, layer, v / 24, (v % 24) / 3, v % 3); }
        else if (it < 832) attn_prompt_item(p, layer, it - 576);
        else if (it < 1088) attn_decode_item(p, layer, it - 832);
        else if (it < 1112) { const int v = it - 1088; lru_item(p, layer, -1, v / 3, v % 3); }
        else { const int v = it - 1112; ssd_decode_item(p, layer, v / 12, v % 12); }
      }
      xcd_barrier(xb);
    }
    for (int rep = 0; rep < REP_G1; ++rep) { gemm_phase<1>(p, layer); xcd_barrier(xb); }
    for (int rep = 0; rep < REP_LN; ++rep) { ln_phase(p, layer); xcd_barrier(xb); }
    for (int rep = 0; rep < REP_SYNC; ++rep) xcd_barrier(xb);
  }
}

extern "C" void kernel_launch(void* const* d_in, const int* in_sizes, int n_in,
                              void* d_out, int out_size, void* d_ws, size_t ws_size,
                              hipStream_t stream) {
  static int grid_blocks = 0;
  if (grid_blocks == 0) {
    if (n_in != 26 || ws_size < WS_END) { fprintf(stderr, "kernel_launch: unexpected n_in %d or ws_size %zu (< %zu)\n", n_in, ws_size, (size_t)WS_END); grid_blocks = -1; return; }
    int dev = 0, cus = 0, per_cu = 0;
    hipGetDevice(&dev);
    hipDeviceGetAttribute(&cus, hipDeviceAttributeMultiprocessorCount, dev);
    if (hipFuncSetAttribute((const void*)mega, hipFuncAttributeMaxDynamicSharedMemorySize, LDS_BYTES) != hipSuccess) { fprintf(stderr, "kernel_launch: hipFuncSetAttribute failed\n"); grid_blocks = -1; return; }
    if (hipOccupancyMaxActiveBlocksPerMultiprocessor(&per_cu, (const void*)mega, 256, LDS_BYTES) != hipSuccess || per_cu < 1) { fprintf(stderr, "kernel_launch: occupancy query failed (%d)\n", per_cu); grid_blocks = -1; return; }
    if (per_cu > 2) per_cu = 2;
    grid_blocks = cus * per_cu;
  }
  if (grid_blocks < 0) return;
  Params p{};
  for (int i = 0; i < 26; ++i) p.in[i] = (const float*)d_in[i];
  p.out = (float*)d_out;
  p.ws = (char*)d_ws;
  if (hipMemsetAsync((char*)d_ws + WS_BAR, 0, 16384, stream) != hipSuccess) { fprintf(stderr, "kernel_launch: memset of barrier words failed\n"); return; }
  void* args[] = {&p};
  hipError_t e = hipLaunchCooperativeKernel((const void*)mega, dim3(grid_blocks), dim3(256), args, LDS_BYTES, stream);
  if (e != hipSuccess) fprintf(stderr, "cooperative launch failed: %s (grid %d)\n", hipGetErrorString(e), grid_blocks);
}
```
